# Optimizing an MI355X kernel written in HIP

```python
import math
import jax
import jax.numpy as jnp
from jax import lax
import numpy as np

D_MODEL = 4096
BATCH = 4
SEQ = 2048
DEPTH = 2

MEM_LEN = 256
HEAD_DIM = 128
BW = D_MODEL // 4
N_BRANCH = 4
A_HEADS = BW // HEAD_DIM
MOBA_BLOCK = 256
MOBA_TOPK = 3
MOBA_Q_BLOCK = 32
B_HEADS = BW // (2 * HEAD_DIM)
B_V_DIM = 2 * HEAD_DIM
ATTN_Q_BLOCK = 128
SGU_CHUNK = 128
SGU_GROUP_CH = 128
SGU_GROUPS = BW // SGU_GROUP_CH
M_HEADS = 4
M_HEAD_DIM = BW // M_HEADS
N_ALIBI_HEADS = A_HEADS + B_HEADS
RMS_EPS = 1e-6
LN_EPS = 1e-5
NEG = -1e30
W_IN_COLS = 13 * BW + N_BRANCH * D_MODEL
SPLIT_POINTS = tuple(BW * i for i in range(1, 14))

kernel_name = "hybrid_moba_diff_sgu_mem_gated"


def rmsnorm(x, g, eps=RMS_EPS):
    xf = x.astype(jnp.float32)
    y = xf * lax.rsqrt(jnp.mean(xf * xf, axis=-1, keepdims=True) + eps)
    return (y * g.astype(jnp.float32)).astype(x.dtype)


def layernorm(x, g, b, eps=LN_EPS):
    xf = x.astype(jnp.float32)
    mu = jnp.mean(xf, axis=-1, keepdims=True)
    var = jnp.mean(jnp.square(xf - mu), axis=-1, keepdims=True)
    y = (xf - mu) * lax.rsqrt(var + eps)
    return (y * g.astype(jnp.float32) + b.astype(jnp.float32)).astype(x.dtype)


def alibi_slopes(n):
    return jnp.exp2(-8.0 * jnp.arange(1, n + 1, dtype=jnp.float32) / n)


def moba_attention(q, k, v, slopes):
    bsz, seq, nh, hd = q.shape
    nb = -(-seq // MOBA_BLOCK)
    pad = nb * MOBA_BLOCK - seq
    padw = ((0, 0), (0, pad), (0, 0), (0, 0))
    kb = jnp.pad(k, padw).reshape(bsz, nb, MOBA_BLOCK, nh, hd).transpose(0, 3, 1, 2, 4)
    vb = jnp.pad(v, padw).reshape(bsz, nb, MOBA_BLOCK, nh, hd).transpose(0, 3, 1, 2, 4)
    k_mean = jnp.mean(kb, axis=3)
    q_blk = jnp.arange(seq) // MOBA_BLOCK
    gate = jnp.einsum('bshd,bhnd->bhsn', q, k_mean).astype(jnp.float32)
    past = jnp.arange(nb)[None, :] < q_blk[:, None]
    gate = jnp.where(past, gate, NEG)
    kk = max(min(MOBA_TOPK, nb - 1), 1)
    _, sel = lax.top_k(gate, kk)
    valid = sel < q_blk[None, None, :, None]

    nq = seq // MOBA_Q_BLOCK
    q_c = q.reshape(bsz, nq, MOBA_Q_BLOCK, nh, hd).transpose(1, 0, 2, 3, 4)
    sel_c = sel.reshape(bsz, nh, nq, MOBA_Q_BLOCK, kk).transpose(2, 0, 1, 3, 4)
    val_c = valid.reshape(bsz, nh, nq, MOBA_Q_BLOCK, kk).transpose(2, 0, 1, 3, 4)
    bi = jnp.arange(bsz)[:, None, None, None]
    hi = jnp.arange(nh)[None, :, None, None]
    offs = jnp.arange(MOBA_BLOCK)
    scale = hd ** -0.5

    def step(args):
        qi, qc, sc_idx, vmask = args
        t = qi * MOBA_Q_BLOCK + jnp.arange(MOBA_Q_BLOCK)
        own = (qi * MOBA_Q_BLOCK) // MOBA_BLOCK
        k_own = lax.dynamic_index_in_dim(kb, own, axis=2, keepdims=False)
        v_own = lax.dynamic_index_in_dim(vb, own, axis=2, keepdims=False)
        d_own = t[:, None] - (own * MOBA_BLOCK + offs)[None, :]
        s_own = (jnp.einsum('bqhd,bhpd->bhqp', qc, k_own).astype(jnp.float32) * scale
                 - slopes[None, :, None, None] * jnp.abs(d_own).astype(jnp.float32))
        s_own = jnp.where(d_own >= 0, s_own, NEG)
        k_sel = kb[bi, hi, sc_idx]
        v_sel = vb[bi, hi, sc_idx]
        d_sel = t[None, None, :, None, None] - (sc_idx[..., None] * MOBA_BLOCK + offs)
        s_sel = (jnp.einsum('bqhd,bhqjpd->bhqjp', qc, k_sel).astype(jnp.float32) * scale
                 - slopes[None, :, None, None, None] * jnp.abs(d_sel).astype(jnp.float32))
        s_sel = jnp.where(vmask[..., None], s_sel, NEG)
        s_all = jnp.concatenate([s_own, s_sel.reshape(bsz, nh, MOBA_Q_BLOCK, kk * MOBA_BLOCK)], axis=-1)
        p = jax.nn.softmax(s_all, axis=-1).astype(v.dtype)
        p_own = p[..., :MOBA_BLOCK]
        p_sel = p[..., MOBA_BLOCK:].reshape(bsz, nh, MOBA_Q_BLOCK, kk, MOBA_BLOCK)
        return (jnp.einsum('bhqp,bhpd->bqhd', p_own, v_own)
                + jnp.einsum('bhqjp,bhqjpd->bqhd', p_sel, v_sel))

    out = lax.map(step, (jnp.arange(nq), q_c, sel_c, val_c))
    return out.transpose(1, 0, 2, 3, 4).reshape(bsz, seq, nh, hd)


def diff_attention(q, k, v, lam, slopes):
    bsz, seq, nh, _, dq = q.shape
    dv = v.shape[-1]
    nq = seq // ATTN_Q_BLOCK
    q_c = q.reshape(bsz, nq, ATTN_Q_BLOCK, nh, 2, dq).transpose(1, 0, 2, 3, 4, 5)
    s_pos = jnp.arange(seq)
    scale = dq ** -0.5

    def step(args):
        qi, qc = args
        t = qi * ATTN_Q_BLOCK + jnp.arange(ATTN_Q_BLOCK)
        d = t[:, None] - s_pos[None, :]
        sc = (jnp.einsum('bqhmd,bshmd->bhmqs', qc, k).astype(jnp.float32) * scale
              - slopes[None, :, None, None, None] * jnp.abs(d).astype(jnp.float32))
        sc = jnp.where(d >= 0, sc, NEG)
        p = jax.nn.softmax(sc, axis=-1)
        w = (p[:, :, 0] - lam * p[:, :, 1]).astype(v.dtype)
        return jnp.einsum('bhqs,bshd->bqhd', w, v)

    out = lax.map(step, (jnp.arange(nq), q_c))
    return out.transpose(1, 0, 2, 3, 4).reshape(bsz, seq, nh, dv)


def spatial_gating(u, v, ln_g, ln_b, w_s, b_s):
    bsz, seq, c = u.shape
    nc = seq // SGU_CHUNK
    vn = layernorm(v, ln_g, ln_b).reshape(bsz, nc, SGU_CHUNK, SGU_GROUPS, SGU_GROUP_CH)
    causal = jnp.tril(jnp.ones((SGU_CHUNK, SGU_CHUNK), dtype=bool))
    w = jnp.where(causal[None], w_s, jnp.zeros_like(w_s))
    mixed = jnp.einsum('gts,bcsge->bctge', w, vn) + b_s.T[None, None, :, :, None]
    return u * mixed.reshape(bsz, seq, c)


def memory_attention(q, mem_k, mem_v):
    scale = q.shape[-1] ** -0.5
    sc = jnp.einsum('bshd,bmhd->bhsm', q, mem_k).astype(jnp.float32) * scale
    p = jax.nn.softmax(sc, axis=-1).astype(mem_v.dtype)
    return jnp.einsum('bhsm,bmhd->bshd', p, mem_v)


def hybrid_layer(x, mem, layer_idx, norm_g, w_in, mem_norm_g, w_mem_kv, lam_q1, lam_k1, lam_q2, lam_k2,
                 diff_subln_g, sgu_ln_g, sgu_ln_b, sgu_w, sgu_b, w_branch, w_out):
    bsz, seq, _ = x.shape
    h = rmsnorm(x, norm_g)
    proj = h @ w_in
    (qa, ka, va, za, qb, kb, vb, zb, uc, vc, zc, qm, zm, gate_logits) = jnp.split(proj, SPLIT_POINTS, axis=-1)
    slopes = alibi_slopes(N_ALIBI_HEADS)

    sa = (bsz, seq, A_HEADS, HEAD_DIM)
    ya = moba_attention(qa.reshape(sa), ka.reshape(sa), va.reshape(sa), slopes[B_HEADS:])
    ya = ya.reshape(bsz, seq, BW) * jax.nn.silu(za)

    lam_init = 0.8 - 0.6 * math.exp(-0.3 * layer_idx)
    lam = (jnp.exp(jnp.sum(lam_q1.astype(jnp.float32) * lam_k1.astype(jnp.float32)))
           - jnp.exp(jnp.sum(lam_q2.astype(jnp.float32) * lam_k2.astype(jnp.float32))) + lam_init)
    sb = (bsz, seq, B_HEADS, 2, HEAD_DIM)
    ob = diff_attention(qb.reshape(sb), kb.reshape(sb), vb.reshape(bsz, seq, B_HEADS, B_V_DIM), lam,
                        slopes[:B_HEADS])
    ob = rmsnorm(ob, diff_subln_g) * (1.0 - lam_init)
    yb = ob.reshape(bsz, seq, BW) * jax.nn.silu(zb)

    yc = spatial_gating(jax.nn.gelu(uc), jax.nn.gelu(vc), sgu_ln_g, sgu_ln_b, sgu_w, sgu_b) * jax.nn.silu(zc)

    mlen = mem.shape[1]
    mk, mv = jnp.split(rmsnorm(mem, mem_norm_g) @ w_mem_kv, 2, axis=-1)
    sm = (bsz, mlen, M_HEADS, M_HEAD_DIM)
    ym = memory_attention(qm.reshape(bsz, seq, M_HEADS, M_HEAD_DIM), mk.reshape(sm), mv.reshape(sm))
    ym = ym.reshape(bsz, seq, BW) * jax.nn.silu(zm)

    gates = jax.nn.sigmoid(gate_logits.reshape(bsz, seq, N_BRANCH, D_MODEL))
    merged = gates[:, :, 0] * (ya @ w_branch[0])
    merged = merged + gates[:, :, 1] * (yb @ w_branch[1])
    merged = merged + gates[:, :, 2] * (yc @ w_branch[2])
    merged = merged + gates[:, :, 3] * (ym @ w_branch[3])
    return x + merged @ w_out


def setup_inputs(seed: int = 0) -> dict:
    key = jax.random.key(seed)
    ks = jax.random.split(key, 20)
    f32 = jnp.float32
    nrm = lambda k, shape, s: jax.random.normal(k, shape, f32) * s
    return {
        "x": nrm(ks[0], (BATCH, SEQ, D_MODEL), 1.0),
        "mem": nrm(ks[1], (BATCH, MEM_LEN, D_MODEL), 1.0),
        "norm_g": 1.0 + nrm(ks[2], (DEPTH, D_MODEL), 0.02),
        "w_in": nrm(ks[3], (DEPTH, D_MODEL, W_IN_COLS), D_MODEL ** -0.5),
        "mem_norm_g": 1.0 + nrm(ks[4], (DEPTH, D_MODEL), 0.02),
        "w_mem_kv": nrm(ks[5], (DEPTH, D_MODEL, 2 * BW), D_MODEL ** -0.5),
        "diff_lam_q1": nrm(ks[6], (DEPTH, HEAD_DIM), 0.1),
        "diff_lam_k1": nrm(ks[7], (DEPTH, HEAD_DIM), 0.1),
        "diff_lam_q2": nrm(ks[8], (DEPTH, HEAD_DIM), 0.1),
        "diff_lam_k2": nrm(ks[9], (DEPTH, HEAD_DIM), 0.1),
        "diff_subln_g": 1.0 + nrm(ks[10], (DEPTH, B_V_DIM), 0.02),
        "sgu_ln_g": 1.0 + nrm(ks[11], (DEPTH, BW), 0.02),
        "sgu_ln_b": nrm(ks[12], (DEPTH, BW), 0.02),
        "sgu_w": nrm(ks[13], (DEPTH, SGU_GROUPS, SGU_CHUNK, SGU_CHUNK), SGU_CHUNK ** -0.5),
        "sgu_b": 1.0 + nrm(ks[14], (DEPTH, SGU_GROUPS, SGU_CHUNK), 0.02),
        "w_branch": nrm(ks[15], (DEPTH, N_BRANCH, BW, D_MODEL), BW ** -0.5),
        "w_out": nrm(ks[16], (DEPTH, D_MODEL, D_MODEL), D_MODEL ** -0.5),
        "final_g": 1.0 + nrm(ks[17], (D_MODEL,), 0.02),
    }


def reference(x, mem, norm_g, w_in, mem_norm_g, w_mem_kv, diff_lam_q1, diff_lam_k1, diff_lam_q2, diff_lam_k2,
              diff_subln_g, sgu_ln_g, sgu_ln_b, sgu_w, sgu_b, w_branch, w_out, final_g):
    for l in range(DEPTH):
        x = hybrid_layer(x, mem, l, norm_g[l], w_in[l], mem_norm_g[l], w_mem_kv[l],
                         diff_lam_q1[l], diff_lam_k1[l], diff_lam_q2[l], diff_lam_k2[l],
                         diff_subln_g[l], sgu_ln_g[l], sgu_ln_b[l], sgu_w[l], sgu_b[l],
                         w_branch[l], w_out[l])
    return rmsnorm(x, final_g)
```

```cpp
#include <hip/hip_runtime.h>
#include <cstdio>
#include <cstdint>

namespace cfg {
constexpr int DM = 4096, NBATCH = 4, SEQ = 2048, MT = NBATCH * SEQ, DEPTH = 2, MEML = 256, MEMR = NBATCH * MEML, BW = 1024;
constexpr int NC = 13 * BW + 4 * DM;
constexpr int C_QA = 0, C_KA = 1024, C_VA = 2048, C_ZA = 3072, C_QB = 4096, C_KB = 5120, C_VB = 6144, C_ZB = 7168, C_UC = 8192, C_VC = 9216, C_ZC = 10240, C_QM = 11264, C_ZM = 12288, C_G = 13312;
constexpr float RMS_EPS = 1e-6f, LN_EPS = 1e-5f;
}
namespace pg8 {
#define PG8_LAS __attribute__((address_space(3)))
typedef unsigned short bf16_t;
typedef short bf16x8 __attribute__((ext_vector_type(8)));
typedef float f32x4 __attribute__((ext_vector_type(4)));
typedef unsigned u32x4 __attribute__((ext_vector_type(4)));
constexpr int BM = 256, BK = 64, HALF = 128, HTB = HALF * BK * 2  , STAGE_BYTES = 8 * HTB, NXCD = 8, WGM = 8;

__host__ __device__ __forceinline__ int lds_byte(int r, int c) { const int st = (r >> 4) * 2 + (c >> 5), rr = r & 15, cc = c & 31, ob = rr * 64 + cc * 2; return st * 1024 + (ob ^ (((ob >> 9) & 1) << 5)); }
__host__ __device__ __forceinline__ void stage_rc(int b, int& R, int& C) { const int st = b / 1024, sb = b % 1024, swz = sb ^ (((sb >> 9) & 1) << 5); R = (st >> 1) * 16 + swz / 64; C = (st & 1) * 32 + (swz % 64) / 2; }
__host__ __device__ __forceinline__ int perm32(int rho) { const int n = rho >> 4, i = rho & 15; return 8 * (i >> 2) + 4 * n + (i & 3); }

struct Unit { int pm, pn; };
struct Gemm { const bf16_t* A; const bf16_t* Bt; int M, N, K; };

struct StaticOrder {
    int nM, nN, nwg, G, c;
    __host__ __device__ void init(int M, int N, int G_, int c_) { nM = M / BM; nN = N / BM; nwg = nM * nN; G = G_; c = c_; }
    __host__ __device__ bool next(int i, Unit& u) const {
        const long L = (long)i * G + c; if (L >= nwg) return false;
        int wgid = (int)L; { const int q = nwg / NXCD, r = nwg % NXCD, xcd = wgid % NXCD, off = wgid / NXCD; wgid = (xcd < r ? xcd * (q + 1) : r * (q + 1) + (xcd - r) * q) + off; }
        const int nig = WGM * nN, gid = wgid / nig, fm = gid * WGM, gsz = (nM - fm) < WGM ? (nM - fm) : WGM;
        u.pm = fm + ((wgid % nig) % gsz); u.pn = (wgid % nig) / gsz; return true;
    }
    __device__ __forceinline__ void a_ready(const Unit&) const {}
    __device__ __forceinline__ void done(const Unit&) const {}
};

__device__ __forceinline__ unsigned cvt_pk_bf16(float lo, float hi) { unsigned r; asm volatile("v_cvt_pk_bf16_f32 %0, %1, %2" : "=v"(r) : "v"(lo), "v"(hi)); return r; }
typedef float f32x2 __attribute__((ext_vector_type(2)));
__device__ __forceinline__ float bf_lo(unsigned w) { return __uint_as_float(w << 16); }
__device__ __forceinline__ float bf_hi(unsigned w) { return __uint_as_float(w & 0xffff0000u); }
__device__ __forceinline__ float sigmoid_f(float x) { return __builtin_amdgcn_rcpf(1.0f + __builtin_amdgcn_exp2f(-1.4426950408889634f * x)); }
template <int ACT> __device__ __forceinline__ float act_f(float v) {
    if (ACT == 1) return v * sigmoid_f(v);
    if (ACT == 2) { const float u2 = 1.5957691216057308f * (v + 0.044715f * v * v * v); return v * sigmoid_f(u2); }
    if (ACT == 3) return sigmoid_f(v);
    return v;
}
struct EpiProj {
    static constexpr bool PERM = true, AFTER_DRAIN = false;
    bf16_t* O; const float* ss;
    template <int ACT> __device__ __forceinline__ void run(const f32x4 (&acc)[2][2][4][2], const Unit& u, int wr, int wc, int fr, int fq) const {
        const int row0 = u.pm * BM + wr * 64 + fr, col0 = u.pn * BM + wc * 32 + 8 * fq;
#pragma unroll
        for (int ai = 0; ai < 2; ++ai)
#pragma unroll
            for (int m = 0; m < 4; ++m) { const int r = row0 + ai * HALF + m * 16; const float rs = 1.0f / sqrtf(ss[r] * (1.0f / cfg::DM) + cfg::RMS_EPS);
                bf16_t* rowp = O + (size_t)r * cfg::NC + col0;
#pragma unroll
                for (int bj = 0; bj < 2; ++bj) { f32x4 v0 = acc[ai][bj][m][0] * rs, v1 = acc[ai][bj][m][1] * rs;
#pragma unroll
                    for (int j = 0; j < 4; ++j) { v0[j] = act_f<ACT>(v0[j]); v1[j] = act_f<ACT>(v1[j]); }
                    u32x4 w; w.x = cvt_pk_bf16(v0[0], v0[1]); w.y = cvt_pk_bf16(v0[2], v0[3]); w.z = cvt_pk_bf16(v1[0], v1[1]); w.w = cvt_pk_bf16(v1[2], v1[3]);
                    *(u32x4*)(rowp + bj * HALF) = w; } }
    }
    __device__ __forceinline__ void operator()(const f32x4 (&acc)[2][2][4][2], const Unit& u, int wr, int wc, int fr, int fq) const {
        const int seg = u.pn >> 2;
        if (seg >= 13) run<3>(acc, u, wr, wc, fr, fq);
        else if (seg == 3 || seg == 7 || seg == 10 || seg == 12) run<1>(acc, u, wr, wc, fr, fq);
        else if (seg == 8 || seg == 9) run<2>(acc, u, wr, wc, fr, fq);
        else run<0>(acc, u, wr, wc, fr, fq);
    }
};
struct EpiMem {
    static constexpr bool PERM = true, AFTER_DRAIN = false;
    bf16_t* O; const float* ss;
    __device__ __forceinline__ void operator()(const f32x4 (&acc)[2][2][4][2], const Unit& u, int wr, int wc, int fr, int fq) const {
        const int row0 = u.pm * BM + wr * 64 + fr, col0 = u.pn * BM + wc * 32 + 8 * fq;
#pragma unroll
        for (int ai = 0; ai < 2; ++ai)
#pragma unroll
            for (int m = 0; m < 4; ++m) { const int r = row0 + ai * HALF + m * 16; const float rs = 1.0f / sqrtf(ss[r] * (1.0f / cfg::DM) + cfg::RMS_EPS);
                bf16_t* rowp = O + (size_t)r * 2048 + col0;
#pragma unroll
                for (int bj = 0; bj < 2; ++bj) { const f32x4 v0 = acc[ai][bj][m][0] * rs, v1 = acc[ai][bj][m][1] * rs;
                    u32x4 w; w.x = cvt_pk_bf16(v0[0], v0[1]); w.y = cvt_pk_bf16(v0[2], v0[3]); w.z = cvt_pk_bf16(v1[0], v1[1]); w.w = cvt_pk_bf16(v1[2], v1[3]);
                    *(u32x4*)(rowp + bj * HALF) = w; } }
    }
};
struct EpiGate {
    static constexpr bool PERM = true, AFTER_DRAIN = false;
    const bf16_t* proj; float* T; bf16_t* merged;
    __device__ __forceinline__ void operator()(const f32x4 (&acc)[2][2][4][2], const Unit& u, int wr, int wc, int fr, int fq) const {
        const int b = u.pm >> 5, pm = u.pm & 31, pn = u.pn & 15;
        const int row0 = pm * BM + wr * 64 + fr, col0 = pn * BM + wc * 32 + 8 * fq;
#pragma unroll
        for (int ai = 0; ai < 2; ++ai)
#pragma unroll
            for (int m = 0; m < 4; ++m) { const int r = row0 + ai * HALF + m * 16;
#pragma unroll
                for (int bj = 0; bj < 2; ++bj) { const int c = col0 + bj * HALF;
                    const u32x4 gw = *(const u32x4*)(proj + (size_t)r * cfg::NC + cfg::C_G + b * cfg::DM + c);
                    f32x4 v0 = acc[ai][bj][m][0], v1 = acc[ai][bj][m][1];
                    v0[0] *= bf_lo(gw.x); v0[1] *= bf_hi(gw.x); v0[2] *= bf_lo(gw.y); v0[3] *= bf_hi(gw.y);
                    v1[0] *= bf_lo(gw.z); v1[1] *= bf_hi(gw.z); v1[2] *= bf_lo(gw.w); v1[3] *= bf_hi(gw.w);
                    float* tp = T + (size_t)r * cfg::DM + c;
                    if (b > 0) { v0 += *(const f32x4*)tp; v1 += *(const f32x4*)(tp + 4); }
                    if (b < 3) { *(f32x4*)tp = v0; *(f32x4*)(tp + 4) = v1; }
                    else { u32x4 w; w.x = cvt_pk_bf16(v0[0], v0[1]); w.y = cvt_pk_bf16(v0[2], v0[3]); w.z = cvt_pk_bf16(v1[0], v1[1]); w.w = cvt_pk_bf16(v1[2], v1[3]);
                        *(u32x4*)(merged + (size_t)r * cfg::DM + c) = w; } } }
    }
};
struct EpiResid {
    static constexpr bool PERM = false, AFTER_DRAIN = false;
    const float* xold; float* xnew; bf16_t* xb; float* ssn;
    __device__ __forceinline__ void operator()(const f32x4 (&acc)[2][2][4][2], const Unit& u, int wr, int wc, int fr, int fq) const {
        typedef unsigned u32x2 __attribute__((ext_vector_type(2)));
        const int row0 = u.pm * BM + wr * 64 + fr, col0 = u.pn * BM + wc * 32 + 4 * fq;
#pragma unroll
        for (int ai = 0; ai < 2; ++ai)
#pragma unroll
            for (int m = 0; m < 4; ++m) { const int r = row0 + ai * HALF + m * 16; const size_t off = (size_t)r * cfg::DM + col0; float s = 0.f;
#pragma unroll
                for (int bj = 0; bj < 2; ++bj)
#pragma unroll
                    for (int n = 0; n < 2; ++n) { const size_t o = off + bj * HALF + n * 16; const f32x4 xn = *(const f32x4*)(xold + o) + acc[ai][bj][m][n];
                        *(f32x4*)(xnew + o) = xn; u32x2 w; w.x = cvt_pk_bf16(xn[0], xn[1]); w.y = cvt_pk_bf16(xn[2], xn[3]); *(u32x2*)(xb + o) = w;
                        s += (xn[0] * xn[0] + xn[1] * xn[1]) + (xn[2] * xn[2] + xn[3] * xn[3]); }
                s += __shfl_xor(s, 16); s += __shfl_xor(s, 32);
                if (fq == 0) unsafeAtomicAdd(ssn + r, s); }
    }
};
template <class Epi, class Sched, bool ALIGN_EPI = false, bool SP2 = false>
__device__ __forceinline__ void gemm_phase(PG8_LAS unsigned char* lds, const Gemm g, const Sched& S, const Epi& E) {
    const int tid = threadIdx.x, wid = __builtin_amdgcn_readfirstlane(tid >> 6), lane = tid & 63, wr = wid >> 2, wc = wid & 3, fr = lane & 15, fq = lane >> 4;
    const int K = g.K, nt = K / BK;
    unsigned voffA[2], voffB[2];
#pragma unroll
    for (int i = 0; i < 2; ++i) { int R, C; stage_rc(tid * 16 + i * 8192, R, C); const int Rb = Epi::PERM ? ((R & ~31) + perm32(R & 31)) : R;
        voffA[i] = (unsigned)(R * K + C) * 2u; voffB[i] = (unsigned)(Rb * K + C) * 2u; }
    const size_t kstep = (size_t)(BK * 2);
    const size_t hstep = (size_t)HALF * K * 2;
    const size_t tstep = 2 * hstep;
    const unsigned ldsw = (unsigned)wid * 1024u;
    const int aoff = lds_byte(wr * 64 + fr, fq * 8), boff = lds_byte(wc * 32 + fr, fq * 8);
#define PG8_SA(b, h) (((b) * 2 + (h)) * HTB)
#define PG8_SB(b, h) ((4 + (b) * 2 + (h)) * HTB)
#define PG8_STAGE(bufoff, gbase, voff) do { _Pragma("unroll") for (int _i = 0; _i < 2; ++_i) \
        __builtin_amdgcn_global_load_lds((const unsigned*)((const char*)(gbase) + (voff)[_i]), (PG8_LAS unsigned*)(lds + (bufoff) + ldsw + _i * 8192), 16, 0, 0); } while (0)
#define PG8_LDA(dst, b, h) do { _Pragma("unroll") for (int m = 0; m < 4; ++m) _Pragma("unroll") for (int k = 0; k < 2; ++k) dst[m][k] = *(const PG8_LAS bf16x8*)(lds + PG8_SA(b, h) + aoff + m * 2048 + k * 1024); } while (0)
#define PG8_LDB(dst, b, h) do { _Pragma("unroll") for (int n = 0; n < 2; ++n) _Pragma("unroll") for (int k = 0; k < 2; ++k) dst[n][k] = *(const PG8_LAS bf16x8*)(lds + PG8_SB(b, h) + boff + n * 2048 + k * 1024); } while (0)
#define PG8_MMA(ai, bj, At, Bt) do { __builtin_amdgcn_s_setprio(1); _Pragma("unroll") for (int m = 0; m < 4; ++m) _Pragma("unroll") for (int n = 0; n < 2; ++n) _Pragma("unroll") for (int k = 0; k < 2; ++k) \
        acc[ai][bj][m][n] = __builtin_amdgcn_mfma_f32_16x16x32_bf16(Bt[n][k], At[m][k], acc[ai][bj][m][n], 0, 0, 0); __builtin_amdgcn_s_setprio(0); } while (0)
#define PG8_WAIT_V(n) asm volatile("s_waitcnt vmcnt(" #n ")" ::: "memory")
#define PG8_WAIT_L(n) asm volatile("s_waitcnt lgkmcnt(" #n ")" ::: "memory")
#define PG8_BAR __builtin_amdgcn_s_barrier()
#define PG8_SCHED __builtin_amdgcn_sched_barrier(0)
    Unit cur, nxt; int ui = 0;
    if (!S.next(0, cur)) return;
    f32x4 acc[2][2][4][2];
#pragma unroll
    for (int a = 0; a < 2; ++a)
#pragma unroll
        for (int b = 0; b < 2; ++b)
#pragma unroll
            for (int m = 0; m < 4; ++m)
#pragma unroll
                for (int n = 0; n < 2; ++n) acc[a][b][m][n] = (f32x4){0.f, 0.f, 0.f, 0.f};
    bf16x8 At[4][2], B0[2][2], B1[2][2];
    const char* cA = (const char*)g.A + (size_t)cur.pm * tstep; const char* cB = (const char*)g.Bt + (size_t)cur.pn * tstep;
    S.a_ready(cur);
    if constexpr (SP2) {
        PG8_STAGE(PG8_SB(0, 0), cB, voffB); PG8_STAGE(PG8_SB(0, 1), cB + hstep, voffB); PG8_STAGE(PG8_SA(0, 0), cA, voffA); PG8_STAGE(PG8_SA(0, 1), cA + hstep, voffA);
        if (wr == 1) PG8_BAR;
        PG8_WAIT_V(2); PG8_BAR;
        PG8_STAGE(PG8_SB(1, 0), cB + kstep, voffB); PG8_STAGE(PG8_SA(1, 0), cA + kstep, voffA); PG8_STAGE(PG8_SB(1, 1), cB + hstep + kstep, voffB);
        PG8_WAIT_V(6); PG8_BAR;
    } else {
        PG8_STAGE(PG8_SB(0, 0), cB, voffB); PG8_STAGE(PG8_SA(0, 0), cA, voffA); PG8_STAGE(PG8_SB(0, 1), cB + hstep, voffB); PG8_STAGE(PG8_SA(0, 1), cA + hstep, voffA);
        if (wr == 1) PG8_BAR;
        PG8_WAIT_V(4); PG8_BAR;
        PG8_STAGE(PG8_SB(1, 0), cB + kstep, voffB); PG8_STAGE(PG8_SA(1, 0), cA + kstep, voffA); PG8_STAGE(PG8_SB(1, 1), cB + hstep + kstep, voffB);
        PG8_WAIT_V(6); PG8_BAR;
    }
    for (;;) {
        const bool has_next = S.next(ui + 1, nxt);
        const char* nA = has_next ? (const char*)g.A + (size_t)nxt.pm * tstep : cA; const char* nB = has_next ? (const char*)g.Bt + (size_t)nxt.pn * tstep : cB;
        for (int t = 0; t < nt; t += 2) {
            const bool last = (t == nt - 2);
            const char* a1 = cA + (size_t)(t + 1) * kstep;
            const char* a2 = last ? nA : cA + (size_t)(t + 2) * kstep; const char* b2 = last ? nB : cB + (size_t)(t + 2) * kstep;
            const char* a3 = a2 + kstep; const char* b3 = b2 + kstep;
            if (last && has_next) S.a_ready(nxt);
            if constexpr (SP2) {
            PG8_LDB(B0, 0, 0); PG8_LDB(B1, 0, 1); PG8_SCHED; PG8_LDA(At, 0, 0); PG8_STAGE(PG8_SA(1, 1), a1 + hstep, voffA);
            PG8_WAIT_V(8); PG8_WAIT_L(0); PG8_BAR; PG8_MMA(0, 0, At, B0); PG8_MMA(0, 1, At, B1); PG8_BAR; PG8_SCHED;
            PG8_LDA(At, 0, 1); PG8_STAGE(PG8_SB(0, 0), b2, voffB); PG8_STAGE(PG8_SB(0, 1), b2 + hstep, voffB); PG8_STAGE(PG8_SA(0, 0), a2, voffA);
            PG8_WAIT_V(8); PG8_WAIT_L(0); PG8_BAR; PG8_MMA(1, 0, At, B0); PG8_MMA(1, 1, At, B1); PG8_BAR; PG8_SCHED;
            PG8_LDB(B0, 1, 0); PG8_LDB(B1, 1, 1); PG8_SCHED; PG8_LDA(At, 1, 0); PG8_STAGE(PG8_SA(0, 1), a2 + hstep, voffA);
            PG8_WAIT_V(8); PG8_WAIT_L(0); PG8_BAR; PG8_MMA(0, 0, At, B0); PG8_MMA(0, 1, At, B1); PG8_BAR; PG8_SCHED;
            PG8_LDA(At, 1, 1); PG8_STAGE(PG8_SB(1, 0), b3, voffB); PG8_STAGE(PG8_SB(1, 1), b3 + hstep, voffB); PG8_STAGE(PG8_SA(1, 0), a3, voffA);
            PG8_WAIT_V(8); PG8_WAIT_L(0); PG8_BAR; PG8_MMA(1, 0, At, B0); PG8_MMA(1, 1, At, B1); PG8_BAR; PG8_SCHED;
            } else {
            PG8_LDB(B0, 0, 0); PG8_SCHED; PG8_LDA(At, 0, 0); PG8_STAGE(PG8_SA(1, 1), a1 + hstep, voffA);
            PG8_WAIT_L(8); PG8_BAR; PG8_WAIT_L(0); PG8_MMA(0, 0, At, B0); PG8_BAR; PG8_SCHED;
            PG8_LDB(B1, 0, 1); PG8_STAGE(PG8_SB(0, 0), b2, voffB);
            PG8_BAR; PG8_WAIT_L(0); PG8_MMA(0, 1, At, B1); PG8_BAR;
            PG8_LDA(At, 0, 1); PG8_STAGE(PG8_SA(0, 0), a2, voffA);
            PG8_BAR; PG8_WAIT_L(0); PG8_MMA(1, 0, At, B0); PG8_BAR; PG8_SCHED;
            PG8_STAGE(PG8_SB(0, 1), b2 + hstep, voffB);
            PG8_WAIT_V(6); PG8_BAR; PG8_MMA(1, 1, At, B1); PG8_BAR;
            PG8_LDB(B0, 1, 0); PG8_SCHED; PG8_LDA(At, 1, 0); PG8_STAGE(PG8_SA(0, 1), a2 + hstep, voffA);
            PG8_WAIT_L(8); PG8_BAR; PG8_WAIT_L(0); PG8_MMA(0, 0, At, B0); PG8_BAR; PG8_SCHED;
            PG8_LDB(B1, 1, 1); PG8_STAGE(PG8_SB(1, 0), b3, voffB);
            PG8_BAR; PG8_WAIT_L(0); PG8_MMA(0, 1, At, B1); PG8_BAR;
            PG8_LDA(At, 1, 1); PG8_STAGE(PG8_SA(1, 0), a3, voffA);
            PG8_BAR; PG8_WAIT_L(0); PG8_MMA(1, 0, At, B0); PG8_BAR; PG8_SCHED;
            PG8_STAGE(PG8_SB(1, 1), b3 + hstep, voffB);
            PG8_WAIT_V(6); PG8_BAR; PG8_MMA(1, 1, At, B1); PG8_BAR;
            }
        }
        if constexpr (ALIGN_EPI) { if (wr == 0) PG8_BAR; }
        if constexpr (!Epi::AFTER_DRAIN) { E(acc, cur, wr, wc, fr, fq); S.done(cur); }
        if (!has_next) break;
#pragma unroll
        for (int a = 0; a < 2; ++a)
#pragma unroll
            for (int b = 0; b < 2; ++b)
#pragma unroll
                for (int m = 0; m < 4; ++m)
#pragma unroll
                    for (int n = 0; n < 2; ++n) acc[a][b][m][n] = (f32x4){0.f, 0.f, 0.f, 0.f};
        cur = nxt; cA = nA; cB = nB; ++ui;
        if constexpr (ALIGN_EPI) { if (wr == 1) PG8_BAR; }
    }
    PG8_WAIT_V(0);
    if constexpr (!ALIGN_EPI) { if (wr == 0) PG8_BAR; }
    PG8_BAR;
    if constexpr (Epi::AFTER_DRAIN) { E.fused(acc, cur, wr, wc, fr, fq, lds, wid, lane); S.done(cur); }
#undef PG8_SA
#undef PG8_SB
#undef PG8_STAGE
#undef PG8_LDA
#undef PG8_LDB
#undef PG8_MMA
#undef PG8_WAIT_V
#undef PG8_WAIT_L
#undef PG8_BAR
#undef PG8_SCHED
}
}

struct GateOrder {
    pg8::StaticOrder base;
    __host__ __device__ void init(int G_, int c_) { base.init(cfg::MT, cfg::DM, G_, c_); }
    __host__ __device__ bool next(int i, pg8::Unit& u) const { pg8::Unit t; if (!base.next(i >> 2, t)) return false; const int b = i & 3; u.pm = b * 32 + t.pm; u.pn = b * 16 + t.pn; return true; }
    __device__ __forceinline__ void a_ready(const pg8::Unit&) const {}
    __device__ __forceinline__ void done(const pg8::Unit&) const {}
};

typedef unsigned short bf16_t;
typedef unsigned u32x4 __attribute__((ext_vector_type(4)));
typedef unsigned u32x2 __attribute__((ext_vector_type(2)));
typedef float f32x4 __attribute__((ext_vector_type(4)));
#define LAS __attribute__((address_space(3)))
using namespace cfg;

__device__ __forceinline__ float bf2f(unsigned short b) { return __uint_as_float(((unsigned)b) << 16); }
__device__ __forceinline__ float bflo(unsigned w) { return __uint_as_float(w << 16); }
__device__ __forceinline__ float bfhi(unsigned w) { return __uint_as_float(w & 0xffff0000u); }
__device__ __forceinline__ unsigned f2bf(float f) { unsigned u = __float_as_uint(f); return (u + 0x7fffu + ((u >> 16) & 1u)) >> 16; }
__device__ __forceinline__ unsigned pk2(float lo, float hi) { return f2bf(lo) | (f2bf(hi) << 16); }
__device__ __forceinline__ float wave_sum(float v) {
#pragma unroll
    for (int o = 1; o < 64; o <<= 1) v += __shfl_xor(v, o);
    return v;
}
__device__ __forceinline__ float wave_max(float v) {
#pragma unroll
    for (int o = 1; o < 64; o <<= 1) v = fmaxf(v, __shfl_xor(v, o));
    return v;
}

__device__ __forceinline__ void transpose_item(const float* W, const float* g, int K, int N, bf16_t* WT, LAS float* scr, int item, int lane) {
    const int nblk = N / 32, kb = item / nblk, nb = item % nblk, k0 = 64 * kb, n0 = 32 * nb;
#pragma unroll 8
    for (int i = 0; i < 32; ++i) { const int kk = 2 * i + (lane >> 5); const float s = g ? g[k0 + kk] : 1.0f; scr[kk * 33 + (lane & 31)] = W[(size_t)(k0 + kk) * N + n0 + (lane & 31)] * s; }
    asm volatile("s_waitcnt lgkmcnt(0)" ::: "memory");
    const int c = lane & 7;
#pragma unroll
    for (int j = 0; j < 4; ++j) { const int n = (lane >> 3) + 8 * j; const LAS float* s = scr + (8 * c) * 33 + n;
        u32x4 o; o.x = pk2(s[0 * 33], s[1 * 33]); o.y = pk2(s[2 * 33], s[3 * 33]); o.z = pk2(s[4 * 33], s[5 * 33]); o.w = pk2(s[6 * 33], s[7 * 33]);
        *(u32x4*)(WT + (size_t)(n0 + n) * K + k0 + 8 * c) = o; }
    asm volatile("s_waitcnt lgkmcnt(0)" ::: "memory");
}
__global__ __launch_bounds__(256) void k_wt(const float* W, const float* g, bf16_t* WT, int K, int N) {
    __shared__ float scr[4][64 * 33];
    const int wave = threadIdx.x >> 6, lane = threadIdx.x & 63, nitems = (K / 64) * (N / 32);
    for (int it = blockIdx.x * 4 + wave; it < nitems; it += gridDim.x * 4) transpose_item(W, g, K, N, WT, (LAS float*)scr[wave], it, lane);
}
__global__ __launch_bounds__(256) void k_rows(const float* x, bf16_t* xb, float* ss, int rows) {
    const int wave = threadIdx.x >> 6, lane = threadIdx.x & 63;
    for (int r = blockIdx.x * 4 + wave; r < rows; r += gridDim.x * 4) {
        const f32x4* xr = (const f32x4*)(x + (size_t)r * DM) + lane; u32x2* o = (u32x2*)(xb + (size_t)r * DM) + lane; float s = 0.f;
#pragma unroll 4
        for (int j = 0; j < 16; ++j) { const f32x4 v = xr[64 * j]; s += (v[0] * v[0] + v[1] * v[1]) + (v[2] * v[2] + v[3] * v[3]); u32x2 w; w.x = pk2(v[0], v[1]); w.y = pk2(v[2], v[3]); o[64 * j] = w; }
        s = wave_sum(s); if (lane == 0) ss[r] = s;
    }
}
template <class Epi> __global__ __launch_bounds__(512, 2) void k_gemm(const bf16_t* A, const bf16_t* Bt, int Mr, int Nc, int K, int pad_, Epi E) {
    extern __shared__ __attribute__((aligned(16))) unsigned char shm[];
    pg8::Gemm g{A, Bt, Mr, Nc, K}; pg8::StaticOrder S; S.init(Mr, Nc, (int)gridDim.x, (int)blockIdx.x);
    pg8::gemm_phase<Epi, pg8::StaticOrder, true, true>((PG8_LAS unsigned char*)shm, g, S, E);
}
__global__ __launch_bounds__(512, 2) void k_gemm_gate(const bf16_t* A, const bf16_t* Bt, pg8::EpiGate E) {
    extern __shared__ __attribute__((aligned(16))) unsigned char shm[];
    pg8::Gemm g{A, Bt, 4 * MT, 4 * DM, BW}; GateOrder S; S.init((int)gridDim.x, (int)blockIdx.x);
    pg8::gemm_phase<pg8::EpiGate, GateOrder, true, true>((PG8_LAS unsigned char*)shm, g, S, E);
}

__global__ __launch_bounds__(128) void k_kmean(const bf16_t* proj, float* kmean) {
    const int id = blockIdx.x, n = id & 7, h = (id >> 3) & 7, b = id >> 6, d = threadIdx.x;
    const bf16_t* p = proj + (size_t)(b * SEQ + n * 256) * NC + C_KA + h * 128 + d; float s = 0.f;
    for (int t = 0; t < 256; ++t) s += bf2f(p[(size_t)t * NC]);
    kmean[(size_t)id * 128 + d] = s * (1.0f / 256.0f);
}
__device__ __forceinline__ float dot8(const u32x4 kk, const float* q) {
    return bflo(kk.x) * q[0] + bfhi(kk.x) * q[1] + bflo(kk.y) * q[2] + bfhi(kk.y) * q[3] + bflo(kk.z) * q[4] + bfhi(kk.z) * q[5] + bflo(kk.w) * q[6] + bfhi(kk.w) * q[7];
}
__global__ __launch_bounds__(256) void k_moba(const bf16_t* proj, const float* kmean, bf16_t* Y0) {
    __shared__ float qs[4][128];
    __shared__ float sc[4][1024];
    const int wave = threadIdx.x >> 6, lane = threadIdx.x & 63;
    const int id = blockIdx.x * 4 + wave, h = id & 7, bt = id >> 3, b = bt >> 11, t = bt & 2047, j = t >> 8;
    const unsigned qq = *(const unsigned*)(proj + (size_t)bt * NC + C_QA + h * 128 + 2 * lane);
    const float q0 = bflo(qq), q1 = bfhi(qq);
    qs[wave][2 * lane] = q0; qs[wave][2 * lane + 1] = q1;
    float g[8];
#pragma unroll
    for (int n = 0; n < 8; ++n) { const float* km = kmean + (size_t)((b * 8 + h) * 8 + n) * 128; g[n] = wave_sum(q0 * km[2 * lane] + q1 * km[2 * lane + 1]); }
    unsigned sel = 0;
#pragma unroll
    for (int n = 0; n < 8; ++n) { int rank = 0;
#pragma unroll
        for (int m = 0; m < 8; ++m) if (m != n) rank += (m < j && (g[m] > g[n] || (g[m] == g[n] && m < n))) ? 1 : 0;
        if (n < j && rank < 3) sel |= 1u << n; }
    sel |= 1u << j;
    __syncthreads();
    const float scale = 0.08838834764831845f, slope = exp2f(-8.0f * (float)(h + 5) / 12.0f);
    float mx = -INFINITY; int nslots = 0;
    for (int n = 0; n <= j; ++n) { if (!((sel >> n) & 1u)) continue;
        for (int c = 0; c < 4; ++c) { const int key = n * 256 + c * 64 + lane; float s = -INFINITY;
            if (key <= t) { const bf16_t* kr = proj + (size_t)(b * SEQ + key) * NC + C_KA + h * 128; float d = 0.f;
#pragma unroll 4
                for (int i = 0; i < 16; ++i) d += dot8(*(const u32x4*)(kr + 8 * i), &qs[wave][8 * i]);
                s = d * scale - slope * (float)(t - key); }
            sc[wave][nslots * 256 + c * 64 + lane] = s; mx = fmaxf(mx, s); }
        ++nslots; }
    mx = wave_max(mx);
    __syncthreads();
    float l = 0.f;
    for (int i = lane; i < nslots * 256; i += 64) { const float p = __expf(sc[wave][i] - mx); sc[wave][i] = p; l += p; }
    l = wave_sum(l);
    __syncthreads();
    float o0 = 0.f, o1 = 0.f; int slot = 0;
    for (int n = 0; n <= j; ++n) { if (!((sel >> n) & 1u)) continue;
        const int kend = (n == j) ? (t - n * 256) : 255;
        const bf16_t* vr = proj + (size_t)(b * SEQ + n * 256) * NC + C_VA + h * 128 + 2 * lane;
        for (int k = 0; k <= kend; ++k) { const float p = sc[wave][slot * 256 + k]; const unsigned vv = *(const unsigned*)(vr + (size_t)k * NC); o0 += p * bflo(vv); o1 += p * bfhi(vv); }
        ++slot; }
    const float inv = 1.0f / l;
    const unsigned zz = *(const unsigned*)(proj + (size_t)bt * NC + C_ZA + h * 128 + 2 * lane);
    *(unsigned*)(Y0 + (size_t)bt * BW + h * 128 + 2 * lane) = pk2(o0 * inv * bflo(zz), o1 * inv * bfhi(zz));
}
__global__ __launch_bounds__(256) void k_diff(const bf16_t* proj, float* scr) {
    __shared__ float qs[4][128];
    __shared__ float sc[4][2048];
    const int wave = threadIdx.x >> 6, lane = threadIdx.x & 63;
    const int id = blockIdx.x * 4 + wave, mp = id & 1, h = (id >> 1) & 3, bt = id >> 3, b = bt >> 11, t = bt & 2047;
    const unsigned qq = *(const unsigned*)(proj + (size_t)bt * NC + C_QB + h * 256 + mp * 128 + 2 * lane);
    qs[wave][2 * lane] = bflo(qq); qs[wave][2 * lane + 1] = bfhi(qq);
    __syncthreads();
    const float scale = 0.08838834764831845f, slope = exp2f(-8.0f * (float)(h + 1) / 12.0f);
    float mx = -INFINITY; const int nch = t / 64 + 1;
    for (int c = 0; c < nch; ++c) { const int key = c * 64 + lane; float s = -INFINITY;
        if (key <= t) { const bf16_t* kr = proj + (size_t)(b * SEQ + key) * NC + C_KB + h * 256 + mp * 128; float d = 0.f;
#pragma unroll 4
            for (int i = 0; i < 16; ++i) d += dot8(*(const u32x4*)(kr + 8 * i), &qs[wave][8 * i]);
            s = d * scale - slope * (float)(t - key); }
        sc[wave][key] = s; mx = fmaxf(mx, s); }
    mx = wave_max(mx);
    __syncthreads();
    float l = 0.f;
    for (int i = lane; i < nch * 64; i += 64) { const float p = __expf(sc[wave][i] - mx); sc[wave][i] = p; l += p; }
    l = wave_sum(l);
    __syncthreads();
    float o[4] = {0.f, 0.f, 0.f, 0.f};
    const bf16_t* vr = proj + (size_t)(b * SEQ) * NC + C_VB + h * 256 + 4 * lane;
    for (int k = 0; k <= t; ++k) { const float p = sc[wave][k]; const u32x2 vv = *(const u32x2*)(vr + (size_t)k * NC);
        o[0] += p * bflo(vv.x); o[1] += p * bfhi(vv.x); o[2] += p * bflo(vv.y); o[3] += p * bfhi(vv.y); }
    const float inv = 1.0f / l;
    *(f32x4*)(scr + ((size_t)(bt * 4 + h) * 2 + mp) * 256 + 4 * lane) = (f32x4){o[0] * inv, o[1] * inv, o[2] * inv, o[3] * inv};
}
__global__ __launch_bounds__(256) void k_diff_combine(const float* scr, const bf16_t* proj, const float* lq1, const float* lk1, const float* lq2, const float* lk2, const float* subg, float lam_init, bf16_t* Y1) {
    const int wave = threadIdx.x >> 6, lane = threadIdx.x & 63, id = blockIdx.x * 4 + wave, h = id & 3, bt = id >> 2;
    const float s1 = wave_sum(lq1[lane] * lk1[lane] + lq1[lane + 64] * lk1[lane + 64]), s2 = wave_sum(lq2[lane] * lk2[lane] + lq2[lane + 64] * lk2[lane + 64]);
    const float lam = expf(s1) - expf(s2) + lam_init;
    const f32x4 a = *(const f32x4*)(scr + ((size_t)(bt * 4 + h) * 2 + 0) * 256 + 4 * lane), c = *(const f32x4*)(scr + ((size_t)(bt * 4 + h) * 2 + 1) * 256 + 4 * lane);
    const f32x4 o = a - c * lam;
    const float ms = wave_sum((o[0] * o[0] + o[1] * o[1]) + (o[2] * o[2] + o[3] * o[3])) * (1.0f / 256.0f);
    const float rs = (1.0f / sqrtf(ms + RMS_EPS)) * (1.0f - lam_init);
    const f32x4 gg = *(const f32x4*)(subg + 4 * lane);
    const u32x2 zz = *(const u32x2*)(proj + (size_t)bt * NC + C_ZB + h * 256 + 4 * lane);
    u32x2 w; w.x = pk2(o[0] * rs * gg[0] * bflo(zz.x), o[1] * rs * gg[1] * bfhi(zz.x)); w.y = pk2(o[2] * rs * gg[2] * bflo(zz.y), o[3] * rs * gg[3] * bfhi(zz.y));
    *(u32x2*)(Y1 + (size_t)bt * BW + h * 256 + 4 * lane) = w;
}
__global__ __launch_bounds__(256) void k_sgu_ln(const bf16_t* proj, const float* lng, const float* lnb, float* VN) {
    const int wave = threadIdx.x >> 6, lane = threadIdx.x & 63, bt = blockIdx.x * 4 + wave;
    float v[16]; float s = 0.f;
#pragma unroll
    for (int i = 0; i < 16; ++i) { v[i] = bf2f(proj[(size_t)bt * NC + C_VC + lane + 64 * i]); s += v[i]; }
    const float mu = wave_sum(s) * (1.0f / 1024.0f); float q = 0.f;
#pragma unroll
    for (int i = 0; i < 16; ++i) { v[i] -= mu; q += v[i] * v[i]; }
    const float rstd = 1.0f / sqrtf(wave_sum(q) * (1.0f / 1024.0f) + LN_EPS);
#pragma unroll
    for (int i = 0; i < 16; ++i) { const int c = lane + 64 * i; VN[(size_t)bt * BW + c] = v[i] * rstd * lng[c] + lnb[c]; }
}
__global__ __launch_bounds__(256) void k_sgu_mix(const bf16_t* proj, const float* VN, const float* sw, const float* sb, bf16_t* Y2) {
    const int idx = blockIdx.x * 256 + threadIdx.x, c = idx & 1023, bt = idx >> 10, g = c >> 7, t = bt & 2047, tl = t & 127, r0 = bt - tl;
    const float* wrow = sw + ((size_t)g * 128 + tl) * 128; float acc = 0.f;
    for (int s = 0; s <= tl; ++s) acc += wrow[s] * VN[(size_t)(r0 + s) * BW + c];
    acc += sb[g * 128 + tl];
    const float u = bf2f(proj[(size_t)bt * NC + C_UC + c]), z = bf2f(proj[(size_t)bt * NC + C_ZC + c]);
    Y2[(size_t)bt * BW + c] = (bf16_t)f2bf(u * acc * z);
}
__global__ __launch_bounds__(256) void k_memattn(const bf16_t* proj, const bf16_t* mkv, bf16_t* Y3) {
    __shared__ float qs[4][256];
    __shared__ float sc[4][256];
    const int wave = threadIdx.x >> 6, lane = threadIdx.x & 63, id = blockIdx.x * 4 + wave, h = id & 3, bt = id >> 2, b = bt >> 11;
    const u32x2 qq = *(const u32x2*)(proj + (size_t)bt * NC + C_QM + h * 256 + 4 * lane);
    qs[wave][4 * lane] = bflo(qq.x); qs[wave][4 * lane + 1] = bfhi(qq.x); qs[wave][4 * lane + 2] = bflo(qq.y); qs[wave][4 * lane + 3] = bfhi(qq.y);
    __syncthreads();
    float mx = -INFINITY;
    for (int c = 0; c < 4; ++c) { const int key = c * 64 + lane; const bf16_t* kr = mkv + (size_t)(b * MEML + key) * 2048 + h * 256; float d = 0.f;
#pragma unroll 4
        for (int i = 0; i < 32; ++i) d += dot8(*(const u32x4*)(kr + 8 * i), &qs[wave][8 * i]);
        const float s = d * 0.0625f; sc[wave][key] = s; mx = fmaxf(mx, s); }
    mx = wave_max(mx);
    __syncthreads();
    float l = 0.f;
    for (int i = lane; i < 256; i += 64) { const float p = __expf(sc[wave][i] - mx); sc[wave][i] = p; l += p; }
    l = wave_sum(l);
    __syncthreads();
    float o[4] = {0.f, 0.f, 0.f, 0.f};
    const bf16_t* vr = mkv + (size_t)(b * MEML) * 2048 + 1024 + h * 256 + 4 * lane;
    for (int k = 0; k < 256; ++k) { const float p = sc[wave][k]; const u32x2 vv = *(const u32x2*)(vr + (size_t)k * 2048);
        o[0] += p * bflo(vv.x); o[1] += p * bfhi(vv.x); o[2] += p * bflo(vv.y); o[3] += p * bfhi(vv.y); }
    const float inv = 1.0f / l;
    const u32x2 zz = *(const u32x2*)(proj + (size_t)bt * NC + C_ZM + h * 256 + 4 * lane);
    u32x2 w; w.x = pk2(o[0] * inv * bflo(zz.x), o[1] * inv * bfhi(zz.x)); w.y = pk2(o[2] * inv * bflo(zz.y), o[3] * inv * bfhi(zz.y));
    *(u32x2*)(Y3 + (size_t)bt * BW + h * 256 + 4 * lane) = w;
}
__global__ __launch_bounds__(256) void k_final(const float* x, const float* ss, const float* g, float* out) {
    const int wave = threadIdx.x >> 6, lane = threadIdx.x & 63, r = blockIdx.x * 4 + wave;
    const float rs = 1.0f / sqrtf(ss[r] * (1.0f / DM) + RMS_EPS);
    const f32x4* xr = (const f32x4*)(x + (size_t)r * DM) + lane; const f32x4* gr = (const f32x4*)g + lane; f32x4* o = (f32x4*)(out + (size_t)r * DM) + lane;
#pragma unroll 4
    for (int j = 0; j < 16; ++j) o[64 * j] = xr[64 * j] * rs * gr[64 * j];
}

constexpr size_t MiB = 1u << 20;
constexpr size_t al256(size_t x) { return (x + 255) / 256 * 256; }
constexpr size_t WS_CTL = 0, CTL_ZERO_BYTES = 1 * MiB;
constexpr size_t CTL_SS1 = 512 * 1024, CTL_SS2 = 512 * 1024 + 65536;
constexpr size_t SZ_WIN = (size_t)NC * DM * 2, SZ_WMEM = (size_t)2048 * DM * 2, SZ_WBR = (size_t)4 * DM * BW * 2, SZ_WOUT = (size_t)DM * DM * 2;
constexpr size_t WS_WIN = 1 * MiB, WS_WMEM = WS_WIN + 2 * SZ_WIN, WS_WBR = WS_WMEM + 2 * SZ_WMEM, WS_WOUT = WS_WBR + 2 * SZ_WBR;
constexpr size_t WS_XB = WS_WOUT + 2 * SZ_WOUT, WS_X1 = WS_XB + (size_t)MT * DM * 2, WS_X2 = WS_X1 + (size_t)MT * DM * 4, WS_SS0 = WS_X2 + (size_t)MT * DM * 4;
constexpr size_t WS_MEMB = WS_SS0 + 65536, WS_MEMSS = WS_MEMB + (size_t)MEMR * DM * 2, WS_MKV = WS_MEMSS + 65536, WS_PROJ = WS_MKV + 2 * (size_t)MEMR * 2048 * 2;
constexpr size_t WS_KMEAN = WS_PROJ + (size_t)MT * NC * 2, WS_Y = WS_KMEAN + 256 * 128 * 4, WS_BSCR = WS_Y + (size_t)4 * MT * BW * 2, WS_VN = WS_BSCR + (size_t)MT * 2048 * 4;
constexpr size_t WS_T = WS_VN + (size_t)MT * BW * 4, WS_MERGED = WS_T + (size_t)MT * DM * 4, WS_END = WS_MERGED + (size_t)MT * DM * 2;

extern "C" void kernel_launch(void* const* d_in, const int* in_sizes, int n_in, void* d_out, int out_size, void* d_ws, size_t ws_size, hipStream_t stream) {
    static int ok = 0;
    if (ok == 0) {
        if (n_in != 18 || in_sizes[0] != MT * DM || out_size != MT * DM || ws_size < WS_END) { fprintf(stderr, "kernel_launch: unexpected shapes (n_in %d in0 %d out %d ws %zu need %zu)\n", n_in, n_in > 0 ? in_sizes[0] : -1, out_size, ws_size, (size_t)WS_END); ok = -1; return; }
        hipError_t e = hipSuccess;
        e = hipFuncSetAttribute((const void*)k_gemm<pg8::EpiProj>, hipFuncAttributeMaxDynamicSharedMemorySize, pg8::STAGE_BYTES); if (e != hipSuccess) fprintf(stderr, "attr1 %s\n", hipGetErrorName(e));
        e = hipFuncSetAttribute((const void*)k_gemm<pg8::EpiMem>, hipFuncAttributeMaxDynamicSharedMemorySize, pg8::STAGE_BYTES); if (e != hipSuccess) fprintf(stderr, "attr2 %s\n", hipGetErrorName(e));
        e = hipFuncSetAttribute((const void*)k_gemm<pg8::EpiResid>, hipFuncAttributeMaxDynamicSharedMemorySize, pg8::STAGE_BYTES); if (e != hipSuccess) fprintf(stderr, "attr3 %s\n", hipGetErrorName(e));
        e = hipFuncSetAttribute((const void*)k_gemm_gate, hipFuncAttributeMaxDynamicSharedMemorySize, pg8::STAGE_BYTES); if (e != hipSuccess) fprintf(stderr, "attr4 %s\n", hipGetErrorName(e));
        ok = 1;
    }
    if (ok < 0) return;
    const float* x = (const float*)d_in[0]; const float* mem = (const float*)d_in[1]; const float* norm_g = (const float*)d_in[2]; const float* w_in = (const float*)d_in[3];
    const float* mem_norm_g = (const float*)d_in[4]; const float* w_mem_kv = (const float*)d_in[5]; const float* lq1 = (const float*)d_in[6]; const float* lk1 = (const float*)d_in[7];
    const float* lq2 = (const float*)d_in[8]; const float* lk2 = (const float*)d_in[9]; const float* subg = (const float*)d_in[10]; const float* lng = (const float*)d_in[11];
    const float* lnb = (const float*)d_in[12]; const float* sgw = (const float*)d_in[13]; const float* sgb = (const float*)d_in[14]; const float* w_br = (const float*)d_in[15];
    const float* w_out = (const float*)d_in[16]; const float* final_g = (const float*)d_in[17];
    unsigned char* ws = (unsigned char*)d_ws;
    bf16_t* WIN = (bf16_t*)(ws + WS_WIN); bf16_t* WMEM = (bf16_t*)(ws + WS_WMEM); bf16_t* WBR = (bf16_t*)(ws + WS_WBR); bf16_t* WOUT = (bf16_t*)(ws + WS_WOUT);
    bf16_t* XB = (bf16_t*)(ws + WS_XB); float* X1 = (float*)(ws + WS_X1); float* X2 = (float*)(ws + WS_X2); float* SS0 = (float*)(ws + WS_SS0);
    float* SS1 = (float*)(ws + WS_CTL + CTL_SS1); float* SS2 = (float*)(ws + WS_CTL + CTL_SS2);
    bf16_t* MEMB = (bf16_t*)(ws + WS_MEMB); float* MEMSS = (float*)(ws + WS_MEMSS); bf16_t* MKV = (bf16_t*)(ws + WS_MKV); bf16_t* PROJ = (bf16_t*)(ws + WS_PROJ);
    float* KMEAN = (float*)(ws + WS_KMEAN); bf16_t* Y = (bf16_t*)(ws + WS_Y); float* BSCR = (float*)(ws + WS_BSCR); float* VN = (float*)(ws + WS_VN);
    float* T = (float*)(ws + WS_T); bf16_t* MERGED = (bf16_t*)(ws + WS_MERGED);
    (void)hipMemsetAsync(ws + WS_CTL, 0, CTL_ZERO_BYTES, stream);
    for (int l = 0; l < DEPTH; ++l) {
        k_wt<<<2048, 256, 0, stream>>>(w_in + (size_t)l * DM * NC, norm_g + (size_t)l * DM, WIN + (size_t)l * NC * DM, DM, NC);
        k_wt<<<1024, 256, 0, stream>>>(w_mem_kv + (size_t)l * DM * 2048, mem_norm_g + (size_t)l * DM, WMEM + (size_t)l * 2048 * DM, DM, 2048);
        for (int b = 0; b < 4; ++b) k_wt<<<1024, 256, 0, stream>>>(w_br + ((size_t)l * 4 + b) * BW * DM, nullptr, WBR + ((size_t)l * 4 + b) * DM * BW, BW, DM);
        k_wt<<<1024, 256, 0, stream>>>(w_out + (size_t)l * DM * DM, nullptr, WOUT + (size_t)l * DM * DM, DM, DM);
    }
    k_rows<<<2048, 256, 0, stream>>>(x, XB, SS0, MT);
    k_rows<<<256, 256, 0, stream>>>(mem, MEMB, MEMSS, MEMR);
    const int G = 256;
    for (int l = 0; l < DEPTH; ++l) {
        const float* xold = l == 0 ? x : X1; float* xnew = l == 0 ? X1 : X2; const float* ssc = l == 0 ? SS0 : SS1; float* ssn = l == 0 ? SS1 : SS2;
        bf16_t* mkv = MKV + (size_t)l * MEMR * 2048;
        { pg8::EpiMem E{}; E.O = mkv; E.ss = MEMSS; k_gemm<pg8::EpiMem><<<G, 512, pg8::STAGE_BYTES, stream>>>(MEMB, WMEM + (size_t)l * 2048 * DM, MEMR, 2048, DM, 0, E); }
        { pg8::EpiProj E{}; E.O = PROJ; E.ss = ssc; k_gemm<pg8::EpiProj><<<G, 512, pg8::STAGE_BYTES, stream>>>(XB, WIN + (size_t)l * NC * DM, MT, NC, DM, 0, E); }
        k_kmean<<<256, 128, 0, stream>>>(PROJ, KMEAN);
        k_moba<<<MT * 8 / 4, 256, 0, stream>>>(PROJ, KMEAN, Y);
        k_diff<<<MT * 8 / 4, 256, 0, stream>>>(PROJ, BSCR);
        const float lam_init = l == 0 ? 0.2f : 0.35550907f;
        k_diff_combine<<<MT * 4 / 4, 256, 0, stream>>>(BSCR, PROJ, lq1 + l * 128, lk1 + l * 128, lq2 + l * 128, lk2 + l * 128, subg + l * 256, lam_init, Y + (size_t)MT * BW);
        k_sgu_ln<<<MT / 4, 256, 0, stream>>>(PROJ, lng + l * BW, lnb + l * BW, VN);
        k_sgu_mix<<<MT * BW / 256, 256, 0, stream>>>(PROJ, VN, sgw + (size_t)l * 8 * 128 * 128, sgb + l * 8 * 128, Y + (size_t)2 * MT * BW);
        k_memattn<<<MT * 4 / 4, 256, 0, stream>>>(PROJ, mkv, Y + (size_t)3 * MT * BW);
        { pg8::EpiGate E{}; E.proj = PROJ; E.T = T; E.merged = MERGED; k_gemm_gate<<<G, 512, pg8::STAGE_BYTES, stream>>>(Y, WBR + (size_t)l * 4 * DM * BW, E); }
        { pg8::EpiResid E{}; E.xold = xold; E.xnew = xnew; E.xb = XB; E.ssn = ssn; k_gemm<pg8::EpiResid><<<G, 512, pg8::STAGE_BYTES, stream>>>(MERGED, WOUT + (size_t)l * DM * DM, MT, DM, DM, 0, E); }
    }
    k_final<<<MT / 4, 256, 0, stream>>>(X2, SS2, final_g, (float*)d_out);
    const hipError_t le = hipPeekAtLastError();
    if (le != hipSuccess) fprintf(stderr, "kernel_launch: launch failed: %s\n", hipGetErrorName(le));
}
```

```cpp
#include <hip/hip_runtime.h>
#include <cstdio>
#include <cstdint>

namespace cfg {
constexpr int DM = 4096, NBATCH = 4, SEQ = 2048, MT = NBATCH * SEQ, DEPTH = 2, MEML = 256, MEMR = NBATCH * MEML, BW = 1024;
constexpr int NC = 13 * BW + 4 * DM;
constexpr int C_QA = 0, C_KA = 1024, C_VA = 2048, C_ZA = 3072, C_QB = 4096, C_KB = 5120, C_VB = 6144, C_ZB = 7168, C_UC = 8192, C_VC = 9216, C_ZC = 10240, C_QM = 11264, C_ZM = 12288, C_G = 13312;
constexpr float RMS_EPS = 1e-6f, LN_EPS = 1e-5f;
}
namespace pg8 {
#define PG8_LAS __attribute__((address_space(3)))
typedef unsigned short bf16_t;
typedef short bf16x8 __attribute__((ext_vector_type(8)));
typedef float f32x4 __attribute__((ext_vector_type(4)));
typedef unsigned u32x4 __attribute__((ext_vector_type(4)));
constexpr int BM = 256, BK = 64, HALF = 128, HTB = HALF * BK * 2  , STAGE_BYTES = 8 * HTB, NXCD = 8, WGM = 4;

__host__ __device__ __forceinline__ int lds_byte(int r, int c) { const int st = (r >> 4) * 2 + (c >> 5), rr = r & 15, cc = c & 31, ob = rr * 64 + cc * 2; return st * 1024 + (ob ^ (((ob >> 9) & 1) << 5)); }
__host__ __device__ __forceinline__ void stage_rc(int b, int& R, int& C) { const int st = b / 1024, sb = b % 1024, swz = sb ^ (((sb >> 9) & 1) << 5); R = (st >> 1) * 16 + swz / 64; C = (st & 1) * 32 + (swz % 64) / 2; }
__host__ __device__ __forceinline__ int perm32(int rho) { const int n = rho >> 4, i = rho & 15; return 8 * (i >> 2) + 4 * n + (i & 3); }

struct Unit { int pm, pn; };
struct Gemm { const bf16_t* A; const bf16_t* Bt; int M, N, K; };

struct StaticOrder {
    int nM, nN, nwg, G, c;
    __host__ __device__ void init(int M, int N, int G_, int c_) { nM = M / BM; nN = N / BM; nwg = nM * nN; G = G_; c = c_; }
    __host__ __device__ bool next(int i, Unit& u) const {
        const long L = (long)i * G + c; if (L >= nwg) return false;
        int wgid = (int)L; { const int q = nwg / NXCD, r = nwg % NXCD, xcd = wgid % NXCD, off = wgid / NXCD; wgid = (xcd < r ? xcd * (q + 1) : r * (q + 1) + (xcd - r) * q) + off; }
        const int nig = WGM * nN, gid = wgid / nig, fm = gid * WGM, gsz = (nM - fm) < WGM ? (nM - fm) : WGM;
        u.pm = fm + ((wgid % nig) % gsz); u.pn = (wgid % nig) / gsz; return true;
    }
    __device__ __forceinline__ void a_ready(const Unit&) const {}
    __device__ __forceinline__ void done(const Unit&) const {}
};

typedef float f32x2_t __attribute__((ext_vector_type(2))); typedef __bf16 bf16x2_t __attribute__((ext_vector_type(2)));
__device__ __forceinline__ unsigned cvt_pk_bf16(float lo, float hi) { f32x2_t v = {lo, hi}; bf16x2_t b = __builtin_convertvector(v, bf16x2_t); return __builtin_bit_cast(unsigned, b); }
typedef float f32x2 __attribute__((ext_vector_type(2)));
typedef unsigned u32x2 __attribute__((ext_vector_type(2)));
__device__ __forceinline__ float bf_lo(unsigned w) { return __uint_as_float(w << 16); }
__device__ __forceinline__ float bf_hi(unsigned w) { return __uint_as_float(w & 0xffff0000u); }
__device__ __forceinline__ float sigmoid_f(float x) { return __builtin_amdgcn_rcpf(1.0f + __builtin_amdgcn_exp2f(-1.4426950408889634f * x)); }
template <int ACT> __device__ __forceinline__ float act_f(float v) {
    if (ACT == 1) return v * sigmoid_f(v);
    if (ACT == 2) { const float u2 = 1.5957691216057308f * (v + 0.044715f * v * v * v); return v * sigmoid_f(u2); }
    if (ACT == 3) return sigmoid_f(v);
    return v;
}
struct EpiProj {
    static constexpr bool PERM = true, AFTER_DRAIN = false, HAS_MID = false;
    bf16_t* O; const float* ss;
    unsigned char* g8;
    float* kms; float* kn2; float* st2;
    template <int ACT, int AUX> __device__ __forceinline__ void run(const f32x4 (&acc)[2][2][4][2], const Unit& u, int wr, int wc, int fr, int fq) const {
        const int row0 = u.pm * BM + wr * 64 + fr, col0 = u.pn * BM + wc * 32 + 8 * fq;
        float rsv[8];
#pragma unroll
        for (int i = 0; i < 8; ++i) rsv[i] = ss[row0 + (i >> 2) * HALF + (i & 3) * 16];
        asm volatile("" ::: "memory");
#pragma unroll
        for (int i = 0; i < 8; ++i) rsv[i] = __builtin_amdgcn_rsqf(rsv[i] * (1.0f / cfg::DM) + cfg::RMS_EPS);
        float cs[2][8]; float mx[2][2];
        if (AUX == 1) {
#pragma unroll
            for (int i = 0; i < 16; ++i) cs[i >> 3][i & 7] = 0.f; }
        if (AUX == 2) { mx[0][0] = mx[0][1] = mx[1][0] = mx[1][1] = 0.f; }
#pragma unroll
        for (int ai = 0; ai < 2; ++ai)
#pragma unroll
            for (int m = 0; m < 4; ++m) { const int r = row0 + ai * HALF + m * 16; const float rs = rsv[ai * 4 + m];
                bf16_t* rowp = O + (size_t)r * cfg::NC + col0; float s1 = 0.f, s2 = 0.f;
#pragma unroll
                for (int bj = 0; bj < 2; ++bj) { f32x4 v0 = acc[ai][bj][m][0] * rs, v1 = acc[ai][bj][m][1] * rs;
#pragma unroll
                    for (int j = 0; j < 4; ++j) { v0[j] = act_f<ACT>(v0[j]); v1[j] = act_f<ACT>(v1[j]); }
                    if (AUX == 4) {
                        unsigned q[8];
#pragma unroll
                        for (int j = 0; j < 4; ++j) { q[j] = (unsigned)fminf(fmaxf(fmaf(v0[j], 255.0f, 0.5f), 1.0f), 255.0f); q[4 + j] = (unsigned)fminf(fmaxf(fmaf(v1[j], 255.0f, 0.5f), 1.0f), 255.0f); }
                        u32x2 w8; w8.x = q[0] | (q[1] << 8) | (q[2] << 16) | (q[3] << 24); w8.y = q[4] | (q[5] << 8) | (q[6] << 16) | (q[7] << 24);
                        __builtin_nontemporal_store(w8, (u32x2*)(g8 + ((size_t)((u.pn - 52) >> 4) * cfg::MT + r) * cfg::DM + ((u.pn - 52) & 15) * BM + wc * 32 + 8 * fq + bj * HALF));
                    } else {
                    u32x4 w; w.x = cvt_pk_bf16(v0[0], v0[1]); w.y = cvt_pk_bf16(v0[2], v0[3]); w.z = cvt_pk_bf16(v1[0], v1[1]); w.w = cvt_pk_bf16(v1[2], v1[3]);
                    __builtin_nontemporal_store(w, (u32x4*)(rowp + bj * HALF)); }
                    if (AUX == 1) {
#pragma unroll
                        for (int j = 0; j < 4; ++j) { cs[bj][j] += v0[j]; cs[bj][4 + j] += v1[j]; } }
                    if (AUX == 2) { float p = (v0[0] * v0[0] + v0[1] * v0[1]) + (v0[2] * v0[2] + v0[3] * v0[3]) + (v1[0] * v1[0] + v1[1] * v1[1]) + (v1[2] * v1[2] + v1[3] * v1[3]);
                        p += __shfl_xor(p, 16); p += __shfl_xor(p, 32); mx[ai][bj] = fmaxf(mx[ai][bj], p); }
                    if (AUX == 3) { s1 += (v0[0] + v0[1]) + (v0[2] + v0[3]) + (v1[0] + v1[1]) + (v1[2] + v1[3]);
                        s2 += (v0[0] * v0[0] + v0[1] * v0[1]) + (v0[2] * v0[2] + v0[3] * v0[3]) + (v1[0] * v1[0] + v1[1] * v1[1]) + (v1[2] * v1[2] + v1[3] * v1[3]); } }
                if (AUX == 3) { s1 += __shfl_xor(s1, 16); s1 += __shfl_xor(s1, 32); s2 += __shfl_xor(s2, 16); s2 += __shfl_xor(s2, 32);
                    if (fq == 0) *(float2*)(st2 + ((size_t)r * 16 + (u.pn - 36) * 4 + wc) * 2) = make_float2(s1, s2); } }
        if (AUX == 1) {
#pragma unroll
            for (int i = 0; i < 16; ++i) { float x = cs[i >> 3][i & 7]; x += __shfl_xor(x, 1); x += __shfl_xor(x, 2); x += __shfl_xor(x, 4); x += __shfl_xor(x, 8); cs[i >> 3][i & 7] = x; }
            if (fr == 0) {
#pragma unroll
                for (int bj = 0; bj < 2; ++bj) { float* o = kms + ((size_t)(((u.pm >> 3) * 8 + (u.pn - 4) * 2 + bj) * 8 + (u.pm & 7)) * 2 + wr) * 128 + wc * 32 + 8 * fq;
                    *(f32x4*)o = (f32x4){cs[bj][0], cs[bj][1], cs[bj][2], cs[bj][3]}; *(f32x4*)(o + 4) = (f32x4){cs[bj][4], cs[bj][5], cs[bj][6], cs[bj][7]}; } }
        }
        if (AUX == 2) {
#pragma unroll
            for (int i = 0; i < 4; ++i) { float x = mx[i >> 1][i & 1]; x = fmaxf(x, __shfl_xor(x, 1)); x = fmaxf(x, __shfl_xor(x, 2)); x = fmaxf(x, __shfl_xor(x, 4)); x = fmaxf(x, __shfl_xor(x, 8));
                if (fr == 0 && fq == 0) kn2[((size_t)((((u.pm >> 3) * 4 + (u.pn - 20)) * 2 + (i & 1)) * 32 + (u.pm & 7) * 4 + (i >> 1) * 2 + wr)) * 4 + wc] = x; }
        }
    }
    __device__ __forceinline__ void operator()(const f32x4 (&acc)[2][2][4][2], const Unit& u, int wr, int wc, int fr, int fq) const {
        const int seg = u.pn >> 2;
        if (seg >= 13) run<3, 4>(acc, u, wr, wc, fr, fq);
        else if (seg == 3 || seg == 7 || seg == 10 || seg == 12) run<1, 0>(acc, u, wr, wc, fr, fq);
        else if (seg == 8) run<2, 0>(acc, u, wr, wc, fr, fq);
        else if (seg == 9) run<2, 3>(acc, u, wr, wc, fr, fq);
        else if (seg == 1) run<0, 1>(acc, u, wr, wc, fr, fq);
        else if (seg == 5) run<0, 2>(acc, u, wr, wc, fr, fq);
        else run<0, 0>(acc, u, wr, wc, fr, fq);
    }
};
struct EpiMem {
    static constexpr bool PERM = true, AFTER_DRAIN = false, HAS_MID = false;
    bf16_t* O; const float* ss; bf16_t* VT;
    __device__ __forceinline__ void operator()(const f32x4 (&acc)[2][2][4][2], const Unit& u, int wr, int wc, int fr, int fq) const {
        const int row0 = u.pm * BM + wr * 64 + fr, col0 = u.pn * BM + wc * 32 + 8 * fq;
        float rsv[8];
#pragma unroll
        for (int i = 0; i < 8; ++i) rsv[i] = ss[row0 + (i >> 2) * HALF + (i & 3) * 16];
        asm volatile("" ::: "memory");
#pragma unroll
        for (int i = 0; i < 8; ++i) rsv[i] = __builtin_amdgcn_rsqf(rsv[i] * (1.0f / cfg::DM) + cfg::RMS_EPS);
        if (u.pn < 4) {
#pragma unroll
            for (int ai = 0; ai < 2; ++ai)
#pragma unroll
                for (int m = 0; m < 4; ++m) { const int r = row0 + ai * HALF + m * 16; const float rs = rsv[ai * 4 + m];
                    bf16_t* rowp = O + (size_t)r * 2048 + col0;
#pragma unroll
                    for (int bj = 0; bj < 2; ++bj) { const f32x4 v0 = acc[ai][bj][m][0] * rs, v1 = acc[ai][bj][m][1] * rs;
                        u32x4 w; w.x = cvt_pk_bf16(v0[0], v0[1]); w.y = cvt_pk_bf16(v0[2], v0[3]); w.z = cvt_pk_bf16(v1[0], v1[1]); w.w = cvt_pk_bf16(v1[2], v1[3]);
                        *(u32x4*)(rowp + bj * HALF) = w; } }
        } else {
            bf16_t* vt = VT + (size_t)((u.pm * 4 + (u.pn - 4)) * 256) * 256;
#pragma unroll
            for (int ai = 0; ai < 2; ++ai)
#pragma unroll
                for (int m = 0; m < 4; ++m) { const int key = wr * 64 + fr + ai * HALF + m * 16; const float rs = rsv[ai * 4 + m];
#pragma unroll
                    for (int bj = 0; bj < 2; ++bj) { const f32x4 v0 = acc[ai][bj][m][0] * rs, v1 = acc[ai][bj][m][1] * rs; const int dv = bj * HALF + wc * 32 + 8 * fq;
                        const unsigned w0 = cvt_pk_bf16(v0[0], v0[1]), w1 = cvt_pk_bf16(v0[2], v0[3]), w2 = cvt_pk_bf16(v1[0], v1[1]), w3 = cvt_pk_bf16(v1[2], v1[3]);
                        bf16_t* p = vt + (size_t)dv * 256 + key;
                        p[0 * 256] = (bf16_t)(w0 & 0xffffu); p[1 * 256] = (bf16_t)(w0 >> 16); p[2 * 256] = (bf16_t)(w1 & 0xffffu); p[3 * 256] = (bf16_t)(w1 >> 16);
                        p[4 * 256] = (bf16_t)(w2 & 0xffffu); p[5 * 256] = (bf16_t)(w2 >> 16); p[6 * 256] = (bf16_t)(w3 & 0xffffu); p[7 * 256] = (bf16_t)(w3 >> 16); } }
        }
    }
};
struct EpiGate2 {
    static constexpr bool PERM = true, AFTER_DRAIN = false, HAS_MID = true; static constexpr int MID_EVERY = 16;
    const unsigned char* g8; bf16_t* merged;
    static __device__ __forceinline__ float ub(unsigned w, int k) { return (float)((w >> (8 * k)) & 0xffu); }
    __device__ __forceinline__ void mid(f32x4 (&acc)[2][2][4][2], const Unit& u, int b, int wr, int wc, int fr, int fq) const {
        const unsigned char* pa = g8 + ((size_t)(b - 1) * cfg::MT + u.pm * BM + wr * 64 + fr) * cfg::DM + u.pn * BM + wc * 32 + 8 * fq; const unsigned char* pb = pa + (size_t)cfg::MT * cfg::DM;
        u32x2 ga[16], gb[16];
#pragma unroll
        for (int i = 0; i < 16; ++i) { const size_t o = (size_t)(((i >> 3) & 1) * HALF + ((i >> 1) & 3) * 16) * cfg::DM + (i & 1) * HALF;
            ga[i] = *(const u32x2*)(pa + o); gb[i] = *(const u32x2*)(pb + o); }
        asm volatile("" ::: "memory");
#pragma unroll
        for (int i = 0; i < 16; ++i) { const int ai = (i >> 3) & 1, m = (i >> 1) & 3, bj = i & 1;
            f32x4 r0, r1;
#pragma unroll
            for (int j = 0; j < 4; ++j) { r0[j] = ub(ga[i].x, j) * __builtin_amdgcn_rcpf(ub(gb[i].x, j)); r1[j] = ub(ga[i].y, j) * __builtin_amdgcn_rcpf(ub(gb[i].y, j)); }
            acc[ai][bj][m][0] *= r0; acc[ai][bj][m][1] *= r1; }
    }
    __device__ __forceinline__ void operator()(const f32x4 (&acc)[2][2][4][2], const Unit& u, int wr, int wc, int fr, int fq) const {
        const int row0 = u.pm * BM + wr * 64 + fr, col0 = u.pn * BM + wc * 32 + 8 * fq;
        const unsigned char* pa = g8 + ((size_t)3 * cfg::MT + row0) * cfg::DM + col0;
        u32x2 ga[16];
#pragma unroll
        for (int i = 0; i < 16; ++i) ga[i] = *(const u32x2*)(pa + (size_t)(((i >> 3) & 1) * HALF + ((i >> 1) & 3) * 16) * cfg::DM + (i & 1) * HALF);
        asm volatile("" ::: "memory");
#pragma unroll
        for (int i = 0; i < 16; ++i) { const int ai = (i >> 3) & 1, m = (i >> 1) & 3, bj = i & 1; const int r = row0 + ai * HALF + m * 16, c = col0 + bj * HALF;
            f32x4 s0, s1;
#pragma unroll
            for (int j = 0; j < 4; ++j) { s0[j] = ub(ga[i].x, j) * (1.0f / 255.0f); s1[j] = ub(ga[i].y, j) * (1.0f / 255.0f); }
            const f32x4 v0 = acc[ai][bj][m][0] * s0, v1 = acc[ai][bj][m][1] * s1;
            u32x4 w; w.x = cvt_pk_bf16(v0[0], v0[1]); w.y = cvt_pk_bf16(v0[2], v0[3]); w.z = cvt_pk_bf16(v1[0], v1[1]); w.w = cvt_pk_bf16(v1[2], v1[3]);
            *(u32x4*)(merged + (size_t)r * cfg::DM + c) = w; }
    }
};
template <bool OLD_BF16, bool W_F32, bool W_BF16> struct EpiResid {
    static constexpr bool PERM = false, AFTER_DRAIN = false, HAS_MID = false;
    const float* xold; const bf16_t* xoldb; float* xnew; bf16_t* xb; float* ssn; PG8_LAS float* red;
    __device__ __forceinline__ void operator()(const f32x4 (&acc)[2][2][4][2], const Unit& u, int wr, int wc, int fr, int fq) const {
        typedef unsigned u32x2 __attribute__((ext_vector_type(2)));
        const int row0 = u.pm * BM + wr * 64 + fr, col0 = u.pn * BM + wc * 32 + 4 * fq;
#pragma unroll
        for (int ai = 0; ai < 2; ++ai) {
            f32x4 xo[16];
#pragma unroll
            for (int i = 0; i < 16; ++i) { const int m = i >> 2, bj = (i >> 1) & 1, n = i & 1; const size_t o = (size_t)(row0 + ai * HALF + m * 16) * cfg::DM + col0 + bj * HALF + n * 16;
                if (OLD_BF16) { const u32x2 ww = *(const u32x2*)(xoldb + o); xo[i] = (f32x4){bf_lo(ww.x), bf_hi(ww.x), bf_lo(ww.y), bf_hi(ww.y)}; } else xo[i] = *(const f32x4*)(xold + o); }
            asm volatile("" ::: "memory");
#pragma unroll
            for (int m = 0; m < 4; ++m) { const int r = row0 + ai * HALF + m * 16; float s = 0.f;
#pragma unroll
                for (int bj = 0; bj < 2; ++bj)
#pragma unroll
                    for (int n = 0; n < 2; ++n) { const size_t o = (size_t)r * cfg::DM + col0 + bj * HALF + n * 16; const f32x4 xn = xo[m * 4 + bj * 2 + n] + acc[ai][bj][m][n];
                        if (W_F32) *(f32x4*)(xnew + o) = xn;
                        if (W_BF16) { u32x2 w; w.x = cvt_pk_bf16(xn[0], xn[1]); w.y = cvt_pk_bf16(xn[2], xn[3]); *(u32x2*)(xb + o) = w; }
                        s += (xn[0] * xn[0] + xn[1] * xn[1]) + (xn[2] * xn[2] + xn[3] * xn[3]); }
                s += __shfl_xor(s, 16); s += __shfl_xor(s, 32);
                if (fq == 0) red[wc * 256 + (r - u.pm * BM)] = s; }
        }
        asm volatile("s_waitcnt lgkmcnt(0)" ::: "memory"); __builtin_amdgcn_s_barrier();
        if (wr == 0) { const int t = (wc * 4 + fq) * 16 + fr; unsafeAtomicAdd(ssn + u.pm * BM + t, (red[t] + red[256 + t]) + (red[512 + t] + red[768 + t])); }
    }
};
template <class Epi, class Sched, bool ALIGN_EPI = false, bool SP2 = false>
__device__ __forceinline__ void gemm_phase(PG8_LAS unsigned char* lds, const Gemm g, const Sched& S, const Epi& E) {
    int tid_l = threadIdx.x; asm volatile("" : "+v"(tid_l));
    const int tid = tid_l, wid = __builtin_amdgcn_readfirstlane(tid >> 6), lane = tid & 63, wr = wid >> 2, wc = wid & 3, fr = lane & 15, fq = lane >> 4;
    const int K = g.K, nt = K / BK;
    unsigned voffA[2], voffB[2];
#pragma unroll
    for (int i = 0; i < 2; ++i) { int R, C; stage_rc(tid * 16 + i * 8192, R, C); const int Rb = Epi::PERM ? ((R & ~31) + perm32(R & 31)) : R;
        voffA[i] = (unsigned)(R * K + C) * 2u; voffB[i] = (unsigned)(Rb * K + C) * 2u; }
    const size_t kstep = (size_t)(BK * 2);
    const size_t hstep = (size_t)HALF * K * 2;
    const size_t tstep = 2 * hstep;
    const unsigned ldsw = (unsigned)wid * 1024u;
    const int aoff = lds_byte(wr * 64 + fr, fq * 8), boff = lds_byte(wc * 32 + fr, fq * 8);
#define PG8_SA(b, h) (((b) * 2 + (h)) * HTB)
#define PG8_SB(b, h) ((4 + (b) * 2 + (h)) * HTB)
#define PG8_STAGE(bufoff, gbase, voff) do { _Pragma("unroll") for (int _i = 0; _i < 2; ++_i) \
        __builtin_amdgcn_global_load_lds((const unsigned*)((const char*)(gbase) + (voff)[_i]), (PG8_LAS unsigned*)(lds + (bufoff) + ldsw + _i * 8192), 16, 0, 0); } while (0)
#define PG8_LDA(dst, b, h) do { _Pragma("unroll") for (int m = 0; m < 4; ++m) _Pragma("unroll") for (int k = 0; k < 2; ++k) dst[m][k] = *(const PG8_LAS bf16x8*)(lds + PG8_SA(b, h) + aoff + m * 2048 + k * 1024); } while (0)
#define PG8_LDB(dst, b, h) do { _Pragma("unroll") for (int n = 0; n < 2; ++n) _Pragma("unroll") for (int k = 0; k < 2; ++k) dst[n][k] = *(const PG8_LAS bf16x8*)(lds + PG8_SB(b, h) + boff + n * 2048 + k * 1024); } while (0)
#define PG8_MMA(ai, bj, At, Bt) do { __builtin_amdgcn_s_setprio(1); _Pragma("unroll") for (int m = 0; m < 4; ++m) _Pragma("unroll") for (int n = 0; n < 2; ++n) _Pragma("unroll") for (int k = 0; k < 2; ++k) \
        acc[ai][bj][m][n] = __builtin_amdgcn_mfma_f32_16x16x32_bf16(Bt[n][k], At[m][k], acc[ai][bj][m][n], 0, 0, 0); __builtin_amdgcn_s_setprio(0); } while (0)
#define PG8_WAIT_V(n) asm volatile("s_waitcnt vmcnt(" #n ")" ::: "memory")
#define PG8_WAIT_L(n) asm volatile("s_waitcnt lgkmcnt(" #n ")" ::: "memory")
#define PG8_BAR __builtin_amdgcn_s_barrier()
#define PG8_SCHED __builtin_amdgcn_sched_barrier(0)
    Unit cur, nxt; int ui = 0;
    if (!S.next(0, cur)) return;
    f32x4 acc[2][2][4][2];
#pragma unroll
    for (int a = 0; a < 2; ++a)
#pragma unroll
        for (int b = 0; b < 2; ++b)
#pragma unroll
            for (int m = 0; m < 4; ++m)
#pragma unroll
                for (int n = 0; n < 2; ++n) acc[a][b][m][n] = (f32x4){0.f, 0.f, 0.f, 0.f};
    bf16x8 At[4][2], B0[2][2], B1[2][2];
    const char* cA = (const char*)g.A + (size_t)cur.pm * tstep; const char* cB = (const char*)g.Bt + (size_t)cur.pn * tstep;
    S.a_ready(cur);
    if constexpr (SP2) {
        PG8_STAGE(PG8_SB(0, 0), cB, voffB); PG8_STAGE(PG8_SB(0, 1), cB + hstep, voffB); PG8_STAGE(PG8_SA(0, 0), cA, voffA); PG8_STAGE(PG8_SA(0, 1), cA + hstep, voffA);
        if (wr == 1) PG8_BAR;
        PG8_WAIT_V(2); PG8_BAR;
        PG8_STAGE(PG8_SB(1, 0), cB + kstep, voffB); PG8_STAGE(PG8_SA(1, 0), cA + kstep, voffA); PG8_STAGE(PG8_SB(1, 1), cB + hstep + kstep, voffB);
        PG8_WAIT_V(6); PG8_BAR;
    } else {
        PG8_STAGE(PG8_SB(0, 0), cB, voffB); PG8_STAGE(PG8_SA(0, 0), cA, voffA); PG8_STAGE(PG8_SB(0, 1), cB + hstep, voffB); PG8_STAGE(PG8_SA(0, 1), cA + hstep, voffA);
        if (wr == 1) PG8_BAR;
        PG8_WAIT_V(4); PG8_BAR;
        PG8_STAGE(PG8_SB(1, 0), cB + kstep, voffB); PG8_STAGE(PG8_SA(1, 0), cA + kstep, voffA); PG8_STAGE(PG8_SB(1, 1), cB + hstep + kstep, voffB);
        PG8_WAIT_V(6); PG8_BAR;
    }
    for (;;) {
        const bool has_next = S.next(ui + 1, nxt);
        const char* nA = has_next ? (const char*)g.A + (size_t)nxt.pm * tstep : cA; const char* nB = has_next ? (const char*)g.Bt + (size_t)nxt.pn * tstep : cB;
        for (int t = 0; t < nt; t += 2) {
            const bool last = (t == nt - 2);
            const char* a1 = cA + (size_t)(t + 1) * kstep;
            const char* a2 = last ? nA : cA + (size_t)(t + 2) * kstep; const char* b2 = last ? nB : cB + (size_t)(t + 2) * kstep;
            const char* a3 = a2 + kstep; const char* b3 = b2 + kstep;
            if (last && has_next) S.a_ready(nxt);
            if constexpr (Epi::HAS_MID) { if (t != 0 && (t & (Epi::MID_EVERY - 1)) == 0) E.mid(acc, cur, t / Epi::MID_EVERY, wr, wc, fr, fq); }
            if constexpr (SP2) {
            PG8_LDB(B0, 0, 0); PG8_LDB(B1, 0, 1); PG8_SCHED; PG8_LDA(At, 0, 0); PG8_STAGE(PG8_SA(1, 1), a1 + hstep, voffA);
            PG8_WAIT_V(8); PG8_WAIT_L(0); PG8_BAR; PG8_MMA(0, 0, At, B0); PG8_MMA(0, 1, At, B1); PG8_BAR; PG8_SCHED;
            PG8_LDA(At, 0, 1); PG8_STAGE(PG8_SB(0, 0), b2, voffB); PG8_STAGE(PG8_SB(0, 1), b2 + hstep, voffB); PG8_STAGE(PG8_SA(0, 0), a2, voffA);
            PG8_WAIT_V(8); PG8_WAIT_L(0); PG8_BAR; PG8_MMA(1, 0, At, B0); PG8_MMA(1, 1, At, B1); PG8_BAR; PG8_SCHED;
            PG8_LDB(B0, 1, 0); PG8_LDB(B1, 1, 1); PG8_SCHED; PG8_LDA(At, 1, 0); PG8_STAGE(PG8_SA(0, 1), a2 + hstep, voffA);
            PG8_WAIT_V(8); PG8_WAIT_L(0); PG8_BAR; PG8_MMA(0, 0, At, B0); PG8_MMA(0, 1, At, B1); PG8_BAR; PG8_SCHED;
            PG8_LDA(At, 1, 1); PG8_STAGE(PG8_SB(1, 0), b3, voffB); PG8_STAGE(PG8_SB(1, 1), b3 + hstep, voffB); PG8_STAGE(PG8_SA(1, 0), a3, voffA);
            PG8_WAIT_V(8); PG8_WAIT_L(0); PG8_BAR; PG8_MMA(1, 0, At, B0); PG8_MMA(1, 1, At, B1); PG8_BAR; PG8_SCHED;
            } else {
            PG8_LDB(B0, 0, 0); PG8_SCHED; PG8_LDA(At, 0, 0); PG8_STAGE(PG8_SA(1, 1), a1 + hstep, voffA);
            PG8_WAIT_L(8); PG8_BAR; PG8_WAIT_L(0); PG8_MMA(0, 0, At, B0); PG8_BAR; PG8_SCHED;
            PG8_LDB(B1, 0, 1); PG8_STAGE(PG8_SB(0, 0), b2, voffB);
            PG8_BAR; PG8_WAIT_L(0); PG8_MMA(0, 1, At, B1); PG8_BAR;
            PG8_LDA(At, 0, 1); PG8_STAGE(PG8_SA(0, 0), a2, voffA);
            PG8_BAR; PG8_WAIT_L(0); PG8_MMA(1, 0, At, B0); PG8_BAR; PG8_SCHED;
            PG8_STAGE(PG8_SB(0, 1), b2 + hstep, voffB);
            PG8_WAIT_V(6); PG8_BAR; PG8_MMA(1, 1, At, B1); PG8_BAR;
            PG8_LDB(B0, 1, 0); PG8_SCHED; PG8_LDA(At, 1, 0); PG8_STAGE(PG8_SA(0, 1), a2 + hstep, voffA);
            PG8_WAIT_L(8); PG8_BAR; PG8_WAIT_L(0); PG8_MMA(0, 0, At, B0); PG8_BAR; PG8_SCHED;
            PG8_LDB(B1, 1, 1); PG8_STAGE(PG8_SB(1, 0), b3, voffB);
            PG8_BAR; PG8_WAIT_L(0); PG8_MMA(0, 1, At, B1); PG8_BAR;
            PG8_LDA(At, 1, 1); PG8_STAGE(PG8_SA(1, 0), a3, voffA);
            PG8_BAR; PG8_WAIT_L(0); PG8_MMA(1, 0, At, B0); PG8_BAR; PG8_SCHED;
            PG8_STAGE(PG8_SB(1, 1), b3 + hstep, voffB);
            PG8_WAIT_V(6); PG8_BAR; PG8_MMA(1, 1, At, B1); PG8_BAR;
            }
        }
        if constexpr (ALIGN_EPI) { if (wr == 0) PG8_BAR; }
        if constexpr (!Epi::AFTER_DRAIN) { E(acc, cur, wr, wc, fr, fq); S.done(cur); }
        if (!has_next) break;
#pragma unroll
        for (int a = 0; a < 2; ++a)
#pragma unroll
            for (int b = 0; b < 2; ++b)
#pragma unroll
                for (int m = 0; m < 4; ++m)
#pragma unroll
                    for (int n = 0; n < 2; ++n) acc[a][b][m][n] = (f32x4){0.f, 0.f, 0.f, 0.f};
        cur = nxt; cA = nA; cB = nB; ++ui;
        if constexpr (ALIGN_EPI) { if (wr == 1) PG8_BAR; }
    }
    PG8_WAIT_V(0);
    if constexpr (!ALIGN_EPI) { if (wr == 0) PG8_BAR; }
    PG8_BAR;
    if constexpr (Epi::AFTER_DRAIN) { E.fused(acc, cur, wr, wc, fr, fq, lds, wid, lane); S.done(cur); }
#undef PG8_SA
#undef PG8_SB
#undef PG8_STAGE
#undef PG8_LDA
#undef PG8_LDB
#undef PG8_MMA
#undef PG8_WAIT_V
#undef PG8_WAIT_L
#undef PG8_BAR
#undef PG8_SCHED
}
}

typedef unsigned short bf16_t;
typedef unsigned u32x4 __attribute__((ext_vector_type(4)));
typedef unsigned u32x2 __attribute__((ext_vector_type(2)));
typedef float f32x4 __attribute__((ext_vector_type(4)));
#define LAS __attribute__((address_space(3)))
#define GAS __attribute__((address_space(1)))
typedef GAS unsigned gu32;
#define RLX_AGENT __ATOMIC_RELAXED, __HIP_MEMORY_SCOPE_AGENT
#define WFENCE() asm volatile("s_waitcnt lgkmcnt(0)" ::: "memory")
using namespace cfg;

__device__ __forceinline__ float bf2f(unsigned short b) { return __uint_as_float(((unsigned)b) << 16); }
__device__ __forceinline__ float bflo(unsigned w) { return __uint_as_float(w << 16); }
__device__ __forceinline__ float bfhi(unsigned w) { return __uint_as_float(w & 0xffff0000u); }
__device__ __forceinline__ unsigned f2bf(float f) { unsigned u = __float_as_uint(f); return (u + 0x7fffu + ((u >> 16) & 1u)) >> 16; }
__device__ __forceinline__ unsigned pk2(float lo, float hi) { return f2bf(lo) | (f2bf(hi) << 16); }
__device__ __forceinline__ float wave_sum(float v) {
#pragma unroll
    for (int o = 1; o < 64; o <<= 1) v += __shfl_xor(v, o);
    return v;
}
__device__ __forceinline__ float wave_max(float v) {
#pragma unroll
    for (int o = 1; o < 64; o <<= 1) v = fmaxf(v, __shfl_xor(v, o));
    return v;
}

constexpr size_t MiB = 1u << 20;
constexpr size_t WS_CTL = 0, CTL_ZERO_BYTES = 1 * MiB;
constexpr int CW_BAR = 4096, CW_Q = 2048, CW_CONV = 3072;
constexpr size_t CTL_SS1 = 512 * 1024, CTL_SS2 = 512 * 1024 + 65536;
constexpr size_t SZ_WIN = (size_t)NC * DM * 2, SZ_WMEM = (size_t)2048 * DM * 2, SZ_WBR = (size_t)4 * DM * BW * 2, SZ_WOUT = (size_t)DM * DM * 2;
constexpr size_t WS_WIN = 1 * MiB, WS_WMEM = WS_WIN + 2 * SZ_WIN, WS_WBR = WS_WMEM + 2 * SZ_WMEM, WS_WOUT = WS_WBR + 2 * SZ_WBR;
constexpr size_t WS_XB = WS_WOUT + 2 * SZ_WOUT, WS_X1 = WS_XB + (size_t)MT * DM * 2, WS_X2 = WS_X1 + (size_t)MT * DM * 4, WS_SS0 = WS_X2 + (size_t)MT * DM * 4;
constexpr size_t WS_MEMB = WS_SS0 + 65536, WS_MEMSS = WS_MEMB + (size_t)MEMR * DM * 2, WS_MKV = WS_MEMSS + 65536, WS_PROJ = WS_MKV + 2 * (size_t)MEMR * 2048 * 2;
constexpr size_t WS_KMEAN = WS_PROJ + (size_t)MT * NC * 2, WS_Y = WS_KMEAN + 2 * 256 * 128 * 4, WS_BSCR = WS_Y + (size_t)4 * MT * BW * 2, WS_VN = WS_BSCR + (size_t)MT * 2048 * 4;
constexpr size_t WS_T = WS_VN + (size_t)MT * BW * 4, WS_G8 = WS_T  , WS_MERGED = WS_T + (size_t)MT * DM * 4, WS_MVT = WS_MERGED + (size_t)MT * DM * 2, WS_STATS = WS_MVT + 2 * (size_t)MEMR * 1024 * 2, WS_KN = WS_STATS + (size_t)MT * 16 * 8, WS_PSAVE = WS_KN + 4 * 1024 * 4, PSAVE_MAP = (size_t)32 * (512 * 80) + 512 * 64  , PSAVE_WG = 2 * PSAVE_MAP, WS_END = WS_PSAVE + 320 * PSAVE_WG;

constexpr int NWAVES = 8;
constexpr int YS = 4 * BW;
constexpr int RING_BYTES = 131072;
constexpr int LDSCTL_OFF = RING_BYTES, MISC_OFF = LDSCTL_OFF + 320;
constexpr int LDS_BYTES = 147456;
static_assert(MISC_OFF + 128 <= LDS_BYTES, "LDS map");

struct TPItem { const float* W; const float* g; bf16_t* WT; int K, N, idx, nt; };
__device__ __forceinline__ void tp_load(const TPItem& t, f32x4 (&v)[16], float2 (&gv)[8], int lane) {
    const int nblk = t.N / 64, kb = t.idx / nblk, nb = t.idx - kb * nblk, kq = lane >> 4, p = lane & 15;
    const GAS float* src = (const GAS float*)(t.W + (size_t)(64 * kb + 2 * kq) * t.N + 64 * nb + 4 * p); const size_t s1 = (size_t)t.N, s7 = (size_t)7 * t.N;
#pragma unroll
    for (int i = 0; i < 16; ++i) { v[i] = __builtin_nontemporal_load((const GAS f32x4*)src); src += (i & 1) ? s7 : s1; asm volatile("" : "+v"(src)); }
    if (t.g) {
#pragma unroll
        for (int ii = 0; ii < 8; ++ii) gv[ii] = *(const float2*)(t.g + 64 * kb + 2 * kq + 8 * ii);
    } else {
#pragma unroll
        for (int ii = 0; ii < 8; ++ii) gv[ii] = make_float2(1.0f, 1.0f);
    }
    asm volatile("" ::: "memory");
}
__device__ __forceinline__ void tp_store(const TPItem& t, const f32x4 (&v)[16], const float2 (&gv)[8], LAS unsigned char* scr, int lane) {
    const int nblk = t.N / 64, kb = t.idx / nblk, nb = t.idx - kb * nblk, k0 = 64 * kb, n0 = 64 * nb, kq = lane >> 4, p = lane & 15;
#pragma unroll
    for (int ii = 0; ii < 8; ++ii) { const float sa = gv[ii].x, sb = gv[ii].y;
#pragma unroll
        for (int j = 0; j < 4; ++j) { const int n = 4 * p + j;
            *(LAS unsigned*)(scr + n * 128 + (((ii ^ (p & 7)) << 4) | (kq << 2))) = pg8::cvt_pk_bf16(v[2 * ii][j] * sa, v[2 * ii + 1][j] * sb); } }
    WFENCE();
    const int c = lane & 7;
    GAS bf16_t* dst = (GAS bf16_t*)(t.WT + (size_t)(n0 + (lane >> 3)) * t.K + k0 + 8 * c); const size_t dstep = (size_t)8 * t.K;
#pragma unroll
    for (int j = 0; j < 8; ++j) { const int n = (lane >> 3) + 8 * j; const u32x4 o = *(LAS const u32x4*)(scr + n * 128 + ((c ^ ((n >> 2) & 7)) << 4));
        if (t.nt) __builtin_nontemporal_store(o, (GAS u32x4*)dst); else *(GAS u32x4*)dst = o;
        dst += dstep; asm volatile("" : "+v"(dst)); }
    WFENCE();
}
__device__ __forceinline__ void row_item(const float* x, bf16_t* xb, float* ss, int r, int lane) {
    const f32x4* xr = (const f32x4*)(x + (size_t)r * DM) + lane; u32x2* o = (u32x2*)(xb + (size_t)r * DM) + lane; float s = 0.f;
    f32x4 v[16];
#pragma unroll
    for (int j = 0; j < 16; ++j) v[j] = xr[64 * j];
    asm volatile("" ::: "memory");
#pragma unroll
    for (int j = 0; j < 16; ++j) { s += (v[j][0] * v[j][0] + v[j][1] * v[j][1]) + (v[j][2] * v[j][2] + v[j][3] * v[j][3]); u32x2 w; w.x = pk2(v[j][0], v[j][1]); w.y = pk2(v[j][2], v[j][3]); o[64 * j] = w; }
    s = wave_sum(s); if (lane == 0) ss[r] = s;
}

__device__ __forceinline__ float dot8(const u32x4 kk, const LAS float* q) {
    return bflo(kk.x) * q[0] + bfhi(kk.x) * q[1] + bflo(kk.y) * q[2] + bfhi(kk.y) * q[3] + bflo(kk.z) * q[4] + bfhi(kk.z) * q[5] + bflo(kk.w) * q[6] + bfhi(kk.w) * q[7];
}
__device__ __forceinline__ void kmean_task(const bf16_t* proj, float* kmean, int id, int lane) {
    const int n = id & 7, h = (id >> 3) & 7, b = id >> 6, rg = lane >> 4, c8 = lane & 15;
    const bf16_t* p = proj + (size_t)(b * SEQ + n * 256 + rg) * NC + C_KA + h * 128 + c8 * 8; float s[8] = {0.f, 0.f, 0.f, 0.f, 0.f, 0.f, 0.f, 0.f};
#pragma unroll
    for (int q = 0; q < 4; ++q) { u32x4 w[16];
#pragma unroll
        for (int i = 0; i < 16; ++i) w[i] = *(const u32x4*)(p + (size_t)(4 * (q * 16 + i)) * NC);
        asm volatile("" ::: "memory");
#pragma unroll
        for (int i = 0; i < 16; ++i) { s[0] += bflo(w[i].x); s[1] += bfhi(w[i].x); s[2] += bflo(w[i].y); s[3] += bfhi(w[i].y); s[4] += bflo(w[i].z); s[5] += bfhi(w[i].z); s[6] += bflo(w[i].w); s[7] += bfhi(w[i].w); } }
#pragma unroll
    for (int j = 0; j < 8; ++j) { s[j] += __shfl_xor(s[j], 16); s[j] += __shfl_xor(s[j], 32); }
    if (lane < 16) { float* o = kmean + (size_t)id * 128 + c8 * 8; *(f32x4*)o = (f32x4){s[0], s[1], s[2], s[3]} * (1.0f / 256.0f); *(f32x4*)(o + 4) = (f32x4){s[4], s[5], s[6], s[7]} * (1.0f / 256.0f); }
}
__device__ __forceinline__ void knorm_task(const bf16_t* proj, float* kn, int id, int lane) {
    const int tile = id & 31, mp = (id >> 5) & 1, h = (id >> 6) & 3, b = id >> 8;
    const bf16_t* p = proj + (size_t)(b * SEQ + tile * 64 + lane) * NC + C_KB + h * 256 + mp * 128; float s = 0.f;
    { u32x4 w[16];
#pragma unroll
      for (int i = 0; i < 16; ++i) w[i] = *(const u32x4*)(p + 8 * i);
      asm volatile("" ::: "memory");
#pragma unroll
      for (int i = 0; i < 16; ++i) s += (bflo(w[i].x) * bflo(w[i].x) + bfhi(w[i].x) * bfhi(w[i].x)) + (bflo(w[i].y) * bflo(w[i].y) + bfhi(w[i].y) * bfhi(w[i].y)) + (bflo(w[i].z) * bflo(w[i].z) + bfhi(w[i].z) * bfhi(w[i].z)) + (bflo(w[i].w) * bflo(w[i].w) + bfhi(w[i].w) * bfhi(w[i].w)); }
    s = wave_max(s);
    if (lane == 0) kn[id] = sqrtf(s) * 1.0001f;
}
__device__ __forceinline__ void sgu_stats_task(const bf16_t* proj, float* stats, int bt, int lane) {
    const u32x4 a = *(const u32x4*)(proj + (size_t)bt * NC + C_VC + lane * 8), b = *(const u32x4*)(proj + (size_t)bt * NC + C_VC + 512 + lane * 8);
    float v[16] = {bflo(a.x), bfhi(a.x), bflo(a.y), bfhi(a.y), bflo(a.z), bfhi(a.z), bflo(a.w), bfhi(a.w), bflo(b.x), bfhi(b.x), bflo(b.y), bfhi(b.y), bflo(b.z), bfhi(b.z), bflo(b.w), bfhi(b.w)};
    float s = 0.f;
#pragma unroll
    for (int i = 0; i < 16; ++i) s += v[i];
    const float mu = wave_sum(s) * (1.0f / 1024.0f); float q = 0.f;
#pragma unroll
    for (int i = 0; i < 16; ++i) { const float d = v[i] - mu; q += d * d; }
    const float rstd = 1.0f / sqrtf(wave_sum(q) * (1.0f / 1024.0f) + LN_EPS);
    if (lane == 0) { stats[2 * bt] = mu; stats[2 * bt + 1] = rstd; }
}
__device__ __forceinline__ void moba_task(const bf16_t* proj, const float* kmean, bf16_t* Y0, int id, int lane, LAS float* wl) {
    LAS float* qs = wl; LAS float* sc = wl + 128;
    const int h = id & 7, bt = id >> 3, b = bt >> 11, t = bt & 2047, j = t >> 8;
    const unsigned qq = *(const unsigned*)(proj + (size_t)bt * NC + C_QA + h * 128 + 2 * lane);
    const float q0 = bflo(qq), q1 = bfhi(qq);
    qs[2 * lane] = q0; qs[2 * lane + 1] = q1;
    float g[8];
#pragma unroll
    for (int n = 0; n < 8; ++n) { const float* km = kmean + (size_t)((b * 8 + h) * 8 + n) * 128; g[n] = wave_sum(q0 * km[2 * lane] + q1 * km[2 * lane + 1]); }
    unsigned sel = 0;
#pragma unroll
    for (int n = 0; n < 8; ++n) { int rank = 0;
#pragma unroll
        for (int m = 0; m < 8; ++m) if (m != n) rank += (m < j && (g[m] > g[n] || (g[m] == g[n] && m < n))) ? 1 : 0;
        if (n < j && rank < 3) sel |= 1u << n; }
    sel |= 1u << j;
    WFENCE();
    const float scale = 0.08838834764831845f, slope = exp2f(-8.0f * (float)(h + 5) / 12.0f);
    float mx = -INFINITY; int nslots = 0;
    for (int n = 0; n <= j; ++n) { if (!((sel >> n) & 1u)) continue;
        for (int c = 0; c < 4; ++c) { const int key = n * 256 + c * 64 + lane; float s = -INFINITY;
            if (key <= t) { const bf16_t* kr = proj + (size_t)(b * SEQ + key) * NC + C_KA + h * 128; float d = 0.f;
#pragma unroll 4
                for (int i = 0; i < 16; ++i) d += dot8(*(const u32x4*)(kr + 8 * i), qs + 8 * i);
                s = d * scale - slope * (float)(t - key); }
            sc[nslots * 256 + c * 64 + lane] = s; mx = fmaxf(mx, s); }
        ++nslots; }
    mx = wave_max(mx);
    WFENCE();
    float l = 0.f;
    for (int i = lane; i < nslots * 256; i += 64) { const float p = __expf(sc[i] - mx); sc[i] = p; l += p; }
    l = wave_sum(l);
    WFENCE();
    float o0 = 0.f, o1 = 0.f; int slot = 0;
    for (int n = 0; n <= j; ++n) { if (!((sel >> n) & 1u)) continue;
        const int kend = (n == j) ? (t - n * 256) : 255;
        const bf16_t* vr = proj + (size_t)(b * SEQ + n * 256) * NC + C_VA + h * 128 + 2 * lane;
        for (int k = 0; k <= kend; ++k) { const float p = sc[slot * 256 + k]; const unsigned vv = *(const unsigned*)(vr + (size_t)k * NC); o0 += p * bflo(vv); o1 += p * bfhi(vv); }
        ++slot; }
    const float inv = 1.0f / l;
    const unsigned zz = *(const unsigned*)(proj + (size_t)bt * NC + C_ZA + h * 128 + 2 * lane);
    *(unsigned*)(Y0 + (size_t)bt * BW + h * 128 + 2 * lane) = pk2(o0 * inv * bflo(zz), o1 * inv * bfhi(zz));
    WFENCE();
}
__device__ __forceinline__ f32x4 diff_task(const bf16_t* proj, int id, int lane, LAS float* wl) {
    LAS float* qs = wl; LAS float* sc = wl + 128;
    const int mp = id & 1, h = (id >> 1) & 3, bt = id >> 3, b = bt >> 11, t = bt & 2047;
    const unsigned qq = *(const unsigned*)(proj + (size_t)bt * NC + C_QB + h * 256 + mp * 128 + 2 * lane);
    qs[2 * lane] = bflo(qq); qs[2 * lane + 1] = bfhi(qq);
    WFENCE();
    const float scale = 0.08838834764831845f, slope = exp2f(-8.0f * (float)(h + 1) / 12.0f);
    float mx = -INFINITY; const int nch = t / 64 + 1;
    for (int c = 0; c < nch; ++c) { const int key = c * 64 + lane; float s = -INFINITY;
        if (key <= t) { const bf16_t* kr = proj + (size_t)(b * SEQ + key) * NC + C_KB + h * 256 + mp * 128; float d = 0.f;
#pragma unroll 4
            for (int i = 0; i < 16; ++i) d += dot8(*(const u32x4*)(kr + 8 * i), qs + 8 * i);
            s = d * scale - slope * (float)(t - key); }
        sc[key] = s; mx = fmaxf(mx, s); }
    mx = wave_max(mx);
    WFENCE();
    float l = 0.f;
    for (int i = lane; i < nch * 64; i += 64) { const float p = __expf(sc[i] - mx); sc[i] = p; l += p; }
    l = wave_sum(l);
    WFENCE();
    float o0 = 0.f, o1 = 0.f, o2 = 0.f, o3 = 0.f;
    const bf16_t* vr = proj + (size_t)(b * SEQ) * NC + C_VB + h * 256 + 4 * lane;
    for (int k = 0; k <= t; ++k) { const float p = sc[k]; const u32x2 vv = *(const u32x2*)(vr + (size_t)k * NC);
        o0 += p * bflo(vv.x); o1 += p * bfhi(vv.x); o2 += p * bflo(vv.y); o3 += p * bfhi(vv.y); }
    const float inv = 1.0f / l;
    WFENCE();
    return (f32x4){o0 * inv, o1 * inv, o2 * inv, o3 * inv};
}
__device__ __forceinline__ void diff_combine_task(const float* scr, const bf16_t* proj, float lam, float lam_init, const float* subg, bf16_t* Y1, int id, int lane) {
    const int h = id & 3, bt = id >> 2;
    const f32x4 a = *(const f32x4*)(scr + ((size_t)(bt * 4 + h) * 2 + 0) * 256 + 4 * lane), c = *(const f32x4*)(scr + ((size_t)(bt * 4 + h) * 2 + 1) * 256 + 4 * lane);
    const f32x4 o = a - c * lam;
    const float ms = wave_sum((o[0] * o[0] + o[1] * o[1]) + (o[2] * o[2] + o[3] * o[3])) * (1.0f / 256.0f);
    const float rs = (1.0f / sqrtf(ms + RMS_EPS)) * (1.0f - lam_init);
    const f32x4 gg = *(const f32x4*)(subg + 4 * lane);
    const u32x2 zz = *(const u32x2*)(proj + (size_t)bt * NC + C_ZB + h * 256 + 4 * lane);
    u32x2 w; w.x = pk2(o[0] * rs * gg[0] * bflo(zz.x), o[1] * rs * gg[1] * bfhi(zz.x)); w.y = pk2(o[2] * rs * gg[2] * bflo(zz.y), o[3] * rs * gg[3] * bfhi(zz.y));
    *(u32x2*)(Y1 + (size_t)bt * YS + h * 256 + 4 * lane) = w;
}
__device__ __forceinline__ void sgu_ln_task(const bf16_t* proj, const float* lng, const float* lnb, float* VN, int bt, int lane) {
    float v[16]; float s = 0.f;
#pragma unroll
    for (int i = 0; i < 16; ++i) { v[i] = bf2f(proj[(size_t)bt * NC + C_VC + lane + 64 * i]); s += v[i]; }
    const float mu = wave_sum(s) * (1.0f / 1024.0f); float q = 0.f;
#pragma unroll
    for (int i = 0; i < 16; ++i) { v[i] -= mu; q += v[i] * v[i]; }
    const float rstd = 1.0f / sqrtf(wave_sum(q) * (1.0f / 1024.0f) + LN_EPS);
#pragma unroll
    for (int i = 0; i < 16; ++i) { const int c = lane + 64 * i; VN[(size_t)bt * BW + c] = v[i] * rstd * lng[c] + lnb[c]; }
}
__device__ __forceinline__ void sgu_mix_elem(const bf16_t* proj, const float* VN, const float* sw, const float* sb, bf16_t* Y2, int idx) {
    const int c = idx & 1023, bt = idx >> 10, g = c >> 7, t = bt & 2047, tl = t & 127, r0 = bt - tl;
    const float* wrow = sw + ((size_t)g * 128 + tl) * 128; float acc = 0.f;
    for (int s = 0; s <= tl; ++s) acc += wrow[s] * VN[(size_t)(r0 + s) * BW + c];
    acc += sb[g * 128 + tl];
    const float u = bf2f(proj[(size_t)bt * NC + C_UC + c]), z = bf2f(proj[(size_t)bt * NC + C_ZC + c]);
    Y2[(size_t)bt * BW + c] = (bf16_t)f2bf(u * acc * z);
}
__device__ __forceinline__ void memattn_task(const bf16_t* proj, const bf16_t* mkv, bf16_t* Y3, int id, int lane, LAS float* wl) {
    LAS float* qs = wl; LAS float* sc = wl + 256;
    const int h = id & 3, bt = id >> 2, b = bt >> 11;
    const u32x2 qq = *(const u32x2*)(proj + (size_t)bt * NC + C_QM + h * 256 + 4 * lane);
    qs[4 * lane] = bflo(qq.x); qs[4 * lane + 1] = bfhi(qq.x); qs[4 * lane + 2] = bflo(qq.y); qs[4 * lane + 3] = bfhi(qq.y);
    WFENCE();
    float mx = -INFINITY;
    for (int c = 0; c < 4; ++c) { const int key = c * 64 + lane; const bf16_t* kr = mkv + (size_t)(b * MEML + key) * 2048 + h * 256; float d = 0.f;
#pragma unroll 4
        for (int i = 0; i < 32; ++i) d += dot8(*(const u32x4*)(kr + 8 * i), qs + 8 * i);
        const float s = d * 0.0625f; sc[key] = s; mx = fmaxf(mx, s); }
    mx = wave_max(mx);
    WFENCE();
    float l = 0.f;
    for (int i = lane; i < 256; i += 64) { const float p = __expf(sc[i] - mx); sc[i] = p; l += p; }
    l = wave_sum(l);
    WFENCE();
    float o0 = 0.f, o1 = 0.f, o2 = 0.f, o3 = 0.f;
    const bf16_t* vr = mkv + (size_t)(b * MEML) * 2048 + 1024 + h * 256 + 4 * lane;
    for (int k = 0; k < 256; ++k) { const float p = sc[k]; const u32x2 vv = *(const u32x2*)(vr + (size_t)k * 2048);
        o0 += p * bflo(vv.x); o1 += p * bfhi(vv.x); o2 += p * bflo(vv.y); o3 += p * bfhi(vv.y); }
    const float inv = 1.0f / l;
    const u32x2 zz = *(const u32x2*)(proj + (size_t)bt * NC + C_ZM + h * 256 + 4 * lane);
    u32x2 w; w.x = pk2(o0 * inv * bflo(zz.x), o1 * inv * bfhi(zz.x)); w.y = pk2(o2 * inv * bflo(zz.y), o3 * inv * bfhi(zz.y));
    *(u32x2*)(Y3 + (size_t)bt * BW + h * 256 + 4 * lane) = w;
    WFENCE();
}
__device__ __forceinline__ void final_rows(const bf16_t* x, const float* ss, const float* g, float* out, int r0, int step, int lane) {
    f32x4 gv[16]; u32x4 va[8], vb[8];
#pragma unroll
    for (int j = 0; j < 8; ++j) { gv[2 * j] = ((const f32x4*)g)[2 * (64 * j + lane)]; gv[2 * j + 1] = ((const f32x4*)g)[2 * (64 * j + lane) + 1]; }
    float sa = 0.f, sb = 0.f;
    if (r0 < MT) { sa = ss[r0];
#pragma unroll
        for (int j = 0; j < 8; ++j) va[j] = ((const u32x4*)(x + (size_t)r0 * DM))[64 * j + lane]; }
    asm volatile("" ::: "memory");
#define FIN_STORE(V, S, R) do { const float rs = __builtin_amdgcn_rsqf((S) * (1.0f / DM) + RMS_EPS); f32x4* o = (f32x4*)(out + (size_t)(R) * DM); \
        _Pragma("unroll") for (int j = 0; j < 8; ++j) { \
            o[2 * (64 * j + lane)]     = (f32x4){bflo(V[j].x), bfhi(V[j].x), bflo(V[j].y), bfhi(V[j].y)} * rs * gv[2 * j]; \
            o[2 * (64 * j + lane) + 1] = (f32x4){bflo(V[j].z), bfhi(V[j].z), bflo(V[j].w), bfhi(V[j].w)} * rs * gv[2 * j + 1]; } } while (0)
    for (int r = r0; r < MT; r += 2 * step) {
        const int r1 = r + step, r2 = r + 2 * step;
        if (r1 < MT) { sb = ss[r1];
#pragma unroll
            for (int j = 0; j < 8; ++j) vb[j] = ((const u32x4*)(x + (size_t)r1 * DM))[64 * j + lane]; }
        asm volatile("" ::: "memory");
        FIN_STORE(va, sa, r);
        if (r1 >= MT) break;
        if (r2 < MT) { sa = ss[r2];
#pragma unroll
            for (int j = 0; j < 8; ++j) va[j] = ((const u32x4*)(x + (size_t)r2 * DM))[64 * j + lane]; }
        asm volatile("" ::: "memory");
        FIN_STORE(vb, sb, r1);
    }
#undef FIN_STORE
}

namespace att {
typedef short bf16x8 __attribute__((ext_vector_type(8)));
typedef short s16x4 __attribute__((ext_vector_type(4)));
typedef float f32x16 __attribute__((ext_vector_type(16)));
typedef short v4i16_t __attribute__((ext_vector_type(4)));
constexpr int KVBLK = 64, QBLK = 32, SHM_V = KVBLK * 128 * 2, SHM_K = KVBLK * 128 * 2;
constexpr int OFF_K = 2 * SHM_V, OFF_WS = 2 * SHM_V + 2 * SHM_K, OFF_KM = OFF_WS + 8 * 64 * 4, LDS_NEED = OFF_KM + 8 * 128 * 4;
constexpr float LOG2E = 1.4426950408889634f, SCALE = 0.08838834764831845f, CS = SCALE * LOG2E, THRL = 8.0f * LOG2E;
#define ATT_KSWZ(row, colB) ((row) * 256 + ((colB) ^ (((row) & 7) << 4)))
#define ATT_SBAR() __builtin_amdgcn_sched_barrier(0)
__device__ __forceinline__ int crow(int r, int hi) { return (r & 3) + 8 * (r >> 2) + 4 * hi; }
__device__ __forceinline__ unsigned cvtpk(float lo, float hi) { return pg8::cvt_pk_bf16(lo, hi); }
__device__ __forceinline__ int v_st(int k, int c) { const int kk = (k & ~0xC) | ((k & 4) << 1) | ((k & 8) >> 1); return ((kk >> 3) * 4 + (c >> 5)) * 512 + ((kk & 7) * 32 + (c & 31)) * 2; }
__device__ __forceinline__ int v_rd_base(int lane) { return ((lane & 3) << 3) | (((lane >> 2) & 3) << 6) | (((lane >> 4) & 1) << 5) | (((lane >> 5) & 1) << 8); }
constexpr int v_rd_off(int d0, int ks, int half) { return d0 * 512 + ks * 4096 + half * 2048; }
__device__ __forceinline__ s16x4 tr_read(LAS const unsigned char* p) { return __builtin_bit_cast(s16x4, __builtin_amdgcn_ds_read_tr16_b64_v4i16((LAS v4i16_t*)p)); }

__device__ __forceinline__ void qkt(f32x16& p0, f32x16& p1, LAS const unsigned char* Ks, const bf16x8* qr, int r32, int hi) {
    p0 = f32x16{}; p1 = f32x16{};
#pragma unroll
    for (int d0 = 0; d0 < 8; ++d0) { const int cb = (d0 * 16 + hi * 8) * 2;
        const bf16x8 b0 = *(LAS const bf16x8*)(Ks + ATT_KSWZ(r32, cb));
        const bf16x8 b1 = *(LAS const bf16x8*)(Ks + ATT_KSWZ(32 + r32, cb));
        p0 = __builtin_amdgcn_mfma_f32_32x32x16_bf16(b0, qr[d0], p0, 0, 0, 0);
        p1 = __builtin_amdgcn_mfma_f32_32x32x16_bf16(b1, qr[d0], p1, 0, 0, 0); }
}
__device__ __forceinline__ void partialSM(f32x16& p0, f32x16& p1, float& m_reg, float& mn, float& alpha, int dq, float slopeL, bool diag, bool rowmasked) {
    const float NEG = -__builtin_inff(); const float a0 = -slopeL * (float)dq;
#pragma unroll
    for (int r = 0; r < 16; ++r) { const int c = (r & 3) + 8 * (r >> 2);
        p0[r] = fmaf(p0[r], CS, fmaf(slopeL, (float)c, a0)); p1[r] = fmaf(p1[r], CS, fmaf(slopeL, (float)(c + 32), a0)); }
    if (diag) { asm volatile("" ::: "memory");
#pragma unroll
        for (int r = 0; r < 16; ++r) { const int c = (r & 3) + 8 * (r >> 2); if (c > dq) p0[r] = NEG; if (c + 32 > dq) p1[r] = NEG; } }
    if (rowmasked) {
#pragma unroll
        for (int r = 0; r < 16; ++r) { p0[r] = NEG; p1[r] = NEG; } }
    float pmax = p0[0];
#pragma unroll
    for (int r = 1; r < 16; ++r) pmax = fmaxf(pmax, p0[r]);
#pragma unroll
    for (int r = 0; r < 16; ++r) pmax = fmaxf(pmax, p1[r]);
    { auto rr = __builtin_amdgcn_permlane32_swap(__float_as_uint(pmax), __float_as_uint(pmax), false, false);
      pmax = fmaxf(__uint_as_float(rr[0]), __uint_as_float(rr[1])); }
    if (__builtin_expect(__all(pmax - m_reg <= THRL), 1)) { mn = m_reg; alpha = 1.f; }
    else { mn = fmaxf(m_reg, pmax); alpha = __builtin_amdgcn_exp2f(m_reg - mn); m_reg = mn; }
#pragma unroll
    for (int r = 0; r < 16; ++r) { p0[r] = p0[r] - mn; p1[r] = p1[r] - mn; }
#pragma unroll
    for (int r = 0; r < 16; ++r) p0[r] = __builtin_amdgcn_exp2f(p0[r]);
}
__device__ __forceinline__ void finishSM(f32x16& p0, f32x16& p1, float alpha, float& l_reg, bf16x8& pa0, bf16x8& pa1, bf16x8& pa2, bf16x8& pa3) {
#pragma unroll
    for (int r = 0; r < 16; ++r) p1[r] = __builtin_amdgcn_exp2f(p1[r]);
    float ps = 0;
#pragma unroll
    for (int r = 0; r < 16; ++r) ps += p0[r];
#pragma unroll
    for (int r = 0; r < 16; ++r) ps += p1[r];
    { auto rr = __builtin_amdgcn_permlane32_swap(__float_as_uint(ps), __float_as_uint(ps), false, false);
      ps = __uint_as_float(rr[0]) + __uint_as_float(rr[1]); }
    l_reg = l_reg * alpha + ps;
#define ATT_PK4(P, BASE, OUT) do { const unsigned a0_ = cvtpk(P[BASE + 0], P[BASE + 1]), a1_ = cvtpk(P[BASE + 2], P[BASE + 3]);   \
    const unsigned b0_ = cvtpk(P[BASE + 4], P[BASE + 5]), b1_ = cvtpk(P[BASE + 6], P[BASE + 7]);                              \
    auto r0_ = __builtin_amdgcn_permlane32_swap(a0_, b0_, false, false); auto r1_ = __builtin_amdgcn_permlane32_swap(a1_, b1_, false, false); \
    u32x4 w_ = {r0_[0], r1_[0], r0_[1], r1_[1]}; OUT = __builtin_bit_cast(bf16x8, w_); } while (0)
    ATT_PK4(p0, 0, pa0); ATT_PK4(p0, 8, pa1); ATT_PK4(p1, 0, pa2); ATT_PK4(p1, 8, pa3);
#undef ATT_PK4
}
template <int D0> __device__ __forceinline__ void pv_one(f32x16& od, LAS const unsigned char* vb, bf16x8 pa0, bf16x8 pa1, bf16x8 pa2, bf16x8 pa3) {
    const s16x4 l0 = tr_read(vb + v_rd_off(D0, 0, 0)), h0 = tr_read(vb + v_rd_off(D0, 0, 1)), l1 = tr_read(vb + v_rd_off(D0, 1, 0)), h1 = tr_read(vb + v_rd_off(D0, 1, 1));
    const s16x4 l2 = tr_read(vb + v_rd_off(D0, 2, 0)), h2 = tr_read(vb + v_rd_off(D0, 2, 1)), l3 = tr_read(vb + v_rd_off(D0, 3, 0)), h3 = tr_read(vb + v_rd_off(D0, 3, 1));
#define ATT_PK(L, H) (bf16x8){L[0], L[1], L[2], L[3], H[0], H[1], H[2], H[3]}
    od = __builtin_amdgcn_mfma_f32_32x32x16_bf16(pa0, ATT_PK(l0, h0), od, 0, 0, 0);
    od = __builtin_amdgcn_mfma_f32_32x32x16_bf16(pa1, ATT_PK(l1, h1), od, 0, 0, 0);
    od = __builtin_amdgcn_mfma_f32_32x32x16_bf16(pa2, ATT_PK(l2, h2), od, 0, 0, 0);
    od = __builtin_amdgcn_mfma_f32_32x32x16_bf16(pa3, ATT_PK(l3, h3), od, 0, 0, 0);
#undef ATT_PK
}
template <int D0> __device__ __forceinline__ void pv_one_z(f32x16& od, LAS const unsigned char* vb, bf16x8 pa0, bf16x8 pa1, bf16x8 pa2, bf16x8 pa3) {
    const s16x4 l0 = tr_read(vb + v_rd_off(D0, 0, 0)), h0 = tr_read(vb + v_rd_off(D0, 0, 1)), l1 = tr_read(vb + v_rd_off(D0, 1, 0)), h1 = tr_read(vb + v_rd_off(D0, 1, 1));
    const s16x4 l2 = tr_read(vb + v_rd_off(D0, 2, 0)), h2 = tr_read(vb + v_rd_off(D0, 2, 1)), l3 = tr_read(vb + v_rd_off(D0, 3, 0)), h3 = tr_read(vb + v_rd_off(D0, 3, 1));
#define ATT_PK(L, H) (bf16x8){L[0], L[1], L[2], L[3], H[0], H[1], H[2], H[3]}
    float z_ = 0.f; asm volatile("" : "+v"(z_));
    const f32x16 zz_ = {z_, z_, z_, z_, z_, z_, z_, z_, z_, z_, z_, z_, z_, z_, z_, z_};
    od = __builtin_amdgcn_mfma_f32_32x32x16_bf16(pa0, ATT_PK(l0, h0), zz_, 0, 0, 0);
    od = __builtin_amdgcn_mfma_f32_32x32x16_bf16(pa1, ATT_PK(l1, h1), od, 0, 0, 0);
    od = __builtin_amdgcn_mfma_f32_32x32x16_bf16(pa2, ATT_PK(l2, h2), od, 0, 0, 0);
    od = __builtin_amdgcn_mfma_f32_32x32x16_bf16(pa3, ATT_PK(l3, h3), od, 0, 0, 0);
#undef ATT_PK
}
__device__ __forceinline__ void pv_d0(f32x16* o, LAS const unsigned char* vb, bf16x8 pa0, bf16x8 pa1, bf16x8 pa2, bf16x8 pa3) {
    pv_one<0>(o[0], vb, pa0, pa1, pa2, pa3); pv_one<1>(o[1], vb, pa0, pa1, pa2, pa3); pv_one<2>(o[2], vb, pa0, pa1, pa2, pa3); pv_one<3>(o[3], vb, pa0, pa1, pa2, pa3);
}

__device__ __forceinline__ float knt(const float* kn2, int t) { const f32x4 p = *(const f32x4*)(kn2 + 4 * t); return sqrtf((p[0] + p[1]) + (p[2] + p[3])) * 1.005f; }
struct UnitDesc {
    const bf16_t* Q;
    const bf16_t* K;
    const bf16_t* V;
    int q0;
    int nt;
    float slopeL;
    int moba_j;
    const float* kmean;
    unsigned char* psave;
    LAS unsigned* kt0_out;
    const float* knorm;
};
constexpr int PS_TILE = 512 * 80;
template <bool MOBA, bool SAVE = false>
__device__ __forceinline__ void run_unit(const UnitDesc& U, LAS unsigned char* lds, f32x16 (&o)[4], float (&rli)[16]) {
    int tid_l = threadIdx.x; asm volatile("" : "+v"(tid_l));
    const int tid = tid_l, wid = __builtin_amdgcn_readfirstlane(tid >> 6), lane = tid & 63, r32 = lane & 31, hi = lane >> 5;
    LAS unsigned char* V_lds = lds; LAS unsigned char* K_lds = lds + OFF_K;
    LAS float* wsf = (LAS float*)(lds + OFF_WS) + wid * 64; LAS float* li_l = wsf; LAS float* al_l = wsf + 32;
    float m_reg = -1e30f, l_reg = 0.f; bf16x8 qr[8];
#pragma unroll
    for (int d = 0; d < 4; ++d) o[d] = f32x16{};
    const bf16_t* Qw = U.Q + (size_t)(wid * QBLK + r32) * NC + hi * 8;
#pragma unroll
    for (int d0 = 0; d0 < 8; ++d0) qr[d0] = *(const bf16x8*)(Qw + d0 * 16);
    int qpos = U.q0 + wid * QBLK + r32, qlo = U.q0 + wid * QBLK;
    unsigned sel = 0xffffffffu;
    if (MOBA && U.moba_j > 3) {
        const int j = U.moba_j; LAS float* km = (LAS float*)(lds + OFF_KM);
        for (int i = tid; i < j * 128; i += 512) { const float* kp = U.kmean + (i >> 7) * 256 + (i & 127); km[i] = kp[0] + kp[128]; }
        __syncthreads();
        float g[8];
#pragma unroll
        for (int n = 0; n < 8; ++n) { g[n] = 0.f;
            if (n < j) { float s = 0.f;
#pragma unroll
                for (int d0 = 0; d0 < 8; ++d0) { const LAS float* kp = km + n * 128 + d0 * 16 + hi * 8; const f32x4 k0 = *(LAS const f32x4*)kp, k1 = *(LAS const f32x4*)(kp + 4);
                    const u32x4 qq = __builtin_bit_cast(u32x4, qr[d0]);
                    s += bflo(qq.x) * k0[0] + bfhi(qq.x) * k0[1] + bflo(qq.y) * k0[2] + bfhi(qq.y) * k0[3] + bflo(qq.z) * k1[0] + bfhi(qq.z) * k1[1] + bflo(qq.w) * k1[2] + bfhi(qq.w) * k1[3]; }
                auto rr = __builtin_amdgcn_permlane32_swap(__float_as_uint(s), __float_as_uint(s), false, false);
                g[n] = __uint_as_float(rr[0]) + __uint_as_float(rr[1]); } }
        sel = 0u;
#pragma unroll
        for (int n = 0; n < 8; ++n) { int rank = 0;
#pragma unroll
            for (int m = 0; m < 8; ++m) if (m != n) rank += (m < j && (g[m] > g[n] || (g[m] == g[n] && m < n))) ? 1 : 0;
            if (n < j && rank < 3) sel |= 1u << n; }
        sel |= 1u << j;
        __syncthreads();
    }
    int kt0 = 0;
    if (!MOBA && U.knorm != nullptr) {
        LAS float* wm = (LAS float*)(lds + OFF_KM); LAS int* tmin = (LAS int*)(lds + OFF_KM + 64);
        float q2 = 0.f;
#pragma unroll
        for (int d0 = 0; d0 < 8; ++d0) { const u32x4 qq = __builtin_bit_cast(u32x4, qr[d0]);
            q2 += (bflo(qq.x) * bflo(qq.x) + bfhi(qq.x) * bfhi(qq.x)) + (bflo(qq.y) * bflo(qq.y) + bfhi(qq.y) * bfhi(qq.y)) + (bflo(qq.z) * bflo(qq.z) + bfhi(qq.z) * bfhi(qq.z)) + (bflo(qq.w) * bflo(qq.w) + bfhi(qq.w) * bfhi(qq.w)); }
        q2 += __shfl_xor(q2, 32);
#pragma unroll
        for (int off = 1; off < 32; off <<= 1) q2 = fmaxf(q2, __shfl_xor(q2, off));
        if (lane == 0) wm[wid] = q2;
        __syncthreads();
        if (wid == 0) {
            float qm = wm[0];
#pragma unroll
            for (int w = 1; w < 8; ++w) qm = fmaxf(qm, wm[w]);
            const float qc = sqrtf(qm) * (CS * 1.0005f); const int NTd = U.nt - 4;
            const float kown = fmaxf(fmaxf(knt(U.knorm, NTd), knt(U.knorm, NTd + 1)), fmaxf(knt(U.knorm, NTd + 2), knt(U.knorm, NTd + 3)));
            bool ns = false;
            if (lane < NTd) ns = !(U.slopeL * (float)(U.q0 - KVBLK * lane - (KVBLK - 1)) > fmaf(qc, knt(U.knorm, lane) + kown, 40.0f));
            const unsigned long long mk = __ballot(ns);
            if (lane == 0) *tmin = (mk ? (int)__builtin_ctzll(mk) : NTd) & ~1;
        }
        __syncthreads();
        kt0 = *tmin;
        __syncthreads();
    }
    if (SAVE) { if (tid == 0) *U.kt0_out = (unsigned)kt0; }
    const int sr = tid >> 4, sc = (tid & 15) * 8, vst0 = v_st(sr, sc), vst1 = v_st(32 + sr, sc), kst0 = ATT_KSWZ(sr, sc * 2), kst1 = ATT_KSWZ(32 + sr, sc * 2);
    LAS const unsigned char* vb0 = V_lds + v_rd_base(lane);
    const bf16_t* Kh = U.K + (size_t)(sr + kt0 * KVBLK) * NC + sc; const bf16_t* Vh = U.V + (size_t)(sr + kt0 * KVBLK) * NC + sc;
    qpos -= kt0 * KVBLK; qlo -= kt0 * KVBLK;
    bf16x8 sA_v0, sA_v1, sA_k0, sA_k1, sB_v0, sB_v1, sB_k0, sB_k1;
#define ATT_SLOAD(S, k0) do { S##_v0 = *(const bf16x8*)(Vh + (size_t)(k0) * NC); S##_v1 = *(const bf16x8*)(Vh + (size_t)((k0) + 32) * NC); \
    S##_k0 = *(const bf16x8*)(Kh + (size_t)(k0) * NC); S##_k1 = *(const bf16x8*)(Kh + (size_t)((k0) + 32) * NC); } while (0)
#define ATT_SWRITE(b, S) do { *(LAS bf16x8*)(V_lds + (b) * SHM_V + vst0) = S##_v0; *(LAS bf16x8*)(V_lds + (b) * SHM_V + vst1) = S##_v1; \
    *(LAS bf16x8*)(K_lds + (b) * SHM_K + kst0) = S##_k0; *(LAS bf16x8*)(K_lds + (b) * SHM_K + kst1) = S##_k1; } while (0)
#define ATT_SWAIT() asm volatile("s_waitcnt vmcnt(4)" ::: "memory")
#define ATT_RESC(a) do { if (__any((a) < 1.f)) { if (hi == 0) al_l[r32] = (a); asm volatile("s_waitcnt lgkmcnt(0)" ::: "memory"); \
    _Pragma("unroll") for (int d_ = 0; d_ < 4; ++d_) _Pragma("unroll") for (int r = 0; r < 16; ++r) o[d_][r] *= al_l[crow(r, hi)]; } } while (0)
#define ATT_PSM(P0, P1, MN, AL, t) partialSM(P0, P1, m_reg, MN, AL, qpos - (t) * KVBLK - 4 * hi, U.slopeL, (t) * KVBLK + KVBLK - 1 > qlo, MOBA && ((t) >> 2) < U.moba_j && !((sel >> ((t) >> 2)) & 1u))
    f32x16 pA0, pA1, pB0, pB1; float mnA, mnB, alA, alB; bf16x8 pa0, pa1, pa2, pa3; const int NT = U.nt - kt0;
    GAS unsigned char* psw = SAVE ? (GAS unsigned char*)U.psave + (size_t)tid * 80 : nullptr;
#define ATT_SAVE(AL) do { if (SAVE) { asm volatile("" : "+v"(psw)); *(GAS u32x4*)psw = __builtin_bit_cast(u32x4, pa0); *(GAS u32x4*)(psw + 16) = __builtin_bit_cast(u32x4, pa1); *(GAS u32x4*)(psw + 32) = __builtin_bit_cast(u32x4, pa2); \
    *(GAS u32x4*)(psw + 48) = __builtin_bit_cast(u32x4, pa3); *(GAS float*)(psw + 64) = (AL); psw += PS_TILE; } } while (0)
    ATT_SLOAD(sA, 0); asm volatile("s_waitcnt vmcnt(0)" ::: "memory"); ATT_SWRITE(0, sA); __syncthreads();
    qkt(pA0, pA1, K_lds, qr, r32, hi); ATT_PSM(pA0, pA1, mnA, alA, 0);
    ATT_SLOAD(sB, KVBLK); if (2 < NT) ATT_SLOAD(sA, 2 * KVBLK);
    ATT_SWAIT(); ATT_SWRITE(1, sB); __syncthreads();
    for (int j = 1; j + 1 < NT; j += 2) {
        ATT_SBAR(); qkt(pB0, pB1, K_lds + SHM_K, qr, r32, hi);
        finishSM(pA0, pA1, alA, l_reg, pa0, pa1, pa2, pa3); ATT_SAVE(alA); ATT_SBAR();
        ATT_SLOAD(sB, (j + 2) * KVBLK); ATT_SBAR();
        pv_d0(o, vb0, pa0, pa1, pa2, pa3); ATT_PSM(pB0, pB1, mnB, alB, j);
        __syncthreads(); ATT_SWAIT(); ATT_SWRITE(0, sA);
        ATT_RESC(alB); __syncthreads();
        ATT_SBAR(); qkt(pA0, pA1, K_lds, qr, r32, hi);
        finishSM(pB0, pB1, alB, l_reg, pa0, pa1, pa2, pa3); ATT_SAVE(alB); ATT_SBAR();
        if (j + 3 < NT) ATT_SLOAD(sA, (j + 3) * KVBLK);
        ATT_SBAR();
        pv_d0(o, vb0 + SHM_V, pa0, pa1, pa2, pa3); ATT_PSM(pA0, pA1, mnA, alA, j + 1);
        __syncthreads(); ATT_SWAIT(); ATT_SWRITE(1, sB);
        ATT_RESC(alA); __syncthreads();
    }
    ATT_SBAR(); qkt(pB0, pB1, K_lds + SHM_K, qr, r32, hi);
    finishSM(pA0, pA1, alA, l_reg, pa0, pa1, pa2, pa3); ATT_SAVE(alA); ATT_SBAR();
    pv_d0(o, vb0, pa0, pa1, pa2, pa3); ATT_PSM(pB0, pB1, mnB, alB, NT - 1);
    __syncthreads(); ATT_RESC(alB);
    finishSM(pB0, pB1, alB, l_reg, pa0, pa1, pa2, pa3); ATT_SAVE(alB); ATT_SBAR();
    pv_d0(o, vb0 + SHM_V, pa0, pa1, pa2, pa3);
    if (hi == 0) li_l[r32] = l_reg;
    asm volatile("s_waitcnt lgkmcnt(0)" ::: "memory");
#pragma unroll
    for (int r = 0; r < 16; ++r) rli[r] = 1.0f / li_l[crow(r, hi)];
    __syncthreads();
#undef ATT_SLOAD
#undef ATT_SWRITE
#undef ATT_SWAIT
#undef ATT_RESC
#undef ATT_PSM
#undef ATT_SAVE
}

__device__ __forceinline__ void run_light(const bf16_t* V, int kt0, int NT, const unsigned char* psv, LAS unsigned char* lds, f32x16 (&o)[4]) {
    int tid_l = threadIdx.x; asm volatile("" : "+v"(tid_l));
    const int tid = tid_l, wid = __builtin_amdgcn_readfirstlane(tid >> 6), lane = tid & 63, r32 = lane & 31, hi = lane >> 5;
    LAS unsigned char* V_lds = lds; LAS float* al_l = (LAS float*)(lds + OFF_WS) + wid * 64 + 32;
    const int sr = tid >> 4, sc = (tid & 15) * 8, vst0 = v_st(sr, sc), vst1 = v_st(32 + sr, sc);
    LAS const unsigned char* vb0 = V_lds + v_rd_base(lane);
    const bf16_t* Vh = V + (size_t)(sr + kt0 * KVBLK) * NC + sc;
    const GAS unsigned char* pp = (const GAS unsigned char*)psv + (size_t)tid * 80;
    bf16x8 v0_0, v1_0, v0_1, v1_1, v0_2, v1_2, v0_3, v1_3; u32x4 p0_0, p1_0, p2_0, p3_0, p0_1, p1_1, p2_1, p3_1, p0_2, p1_2, p2_2, p3_2, p0_3, p1_3, p2_3, p3_3; float al_0, al_1, al_2, al_3;
#define L_FILL(s, t) do { const int tt_ = (t) < NT ? (t) : NT - 1; const bf16_t* vq_ = Vh + (size_t)(tt_ * KVBLK) * NC; const GAS unsigned char* q_ = pp + (size_t)tt_ * PS_TILE; \
    v0_##s = *(const bf16x8*)vq_; v1_##s = *(const bf16x8*)(vq_ + (size_t)32 * NC); p0_##s = *(const GAS u32x4*)q_; p1_##s = *(const GAS u32x4*)(q_ + 16); p2_##s = *(const GAS u32x4*)(q_ + 32); \
    p3_##s = *(const GAS u32x4*)(q_ + 48); al_##s = *(const GAS float*)(q_ + 64); } while (0)
#define L_RESC(a) do { if (__any((a) < 1.f)) { if (hi == 0) al_l[r32] = (a); asm volatile("s_waitcnt lgkmcnt(0)" ::: "memory"); \
    _Pragma("unroll") for (int d_ = 0; d_ < 4; ++d_) _Pragma("unroll") for (int r = 0; r < 16; ++r) o[d_][r] *= al_l[crow(r, hi)]; } } while (0)
#define L_PA(s) __builtin_bit_cast(bf16x8, p0_##s), __builtin_bit_cast(bf16x8, p1_##s), __builtin_bit_cast(bf16x8, p2_##s), __builtin_bit_cast(bf16x8, p3_##s)
#define L_STEP(s, t, FIRST) do { asm volatile("s_waitcnt vmcnt(21)" ::: "memory"); \
    *(LAS bf16x8*)(V_lds + ((s) & 1) * SHM_V + vst0) = v0_##s; *(LAS bf16x8*)(V_lds + ((s) & 1) * SHM_V + vst1) = v1_##s; \
    __syncthreads(); \
    if (FIRST) { pv_one_z<0>(o[0], vb0, L_PA(s)); pv_one_z<1>(o[1], vb0, L_PA(s)); pv_one_z<2>(o[2], vb0, L_PA(s)); pv_one_z<3>(o[3], vb0, L_PA(s)); } \
    else { L_RESC(al_##s); pv_d0(o, vb0 + ((s) & 1) * SHM_V, L_PA(s)); } \
    asm volatile("" ::: "memory"); L_FILL(s, (t) + 4); } while (0)
    L_FILL(0, 0); L_FILL(1, 1); L_FILL(2, 2); L_FILL(3, 3);
    L_STEP(0, 0, true);
    if (1 < NT) L_STEP(1, 1, false);
    if (2 < NT) L_STEP(2, 2, false);
    if (3 < NT) L_STEP(3, 3, false);
    for (int j = 4; j < NT; j += 4) {
        L_STEP(0, j, false);
        if (j + 1 < NT) L_STEP(1, j + 1, false);
        if (j + 2 < NT) L_STEP(2, j + 2, false);
        if (j + 3 < NT) L_STEP(3, j + 3, false);
    }
    asm volatile("s_waitcnt vmcnt(0)" ::: "memory");
    __syncthreads();
#undef L_FILL
#undef L_RESC
#undef L_PA
#undef L_STEP
}
}

namespace sgu {
__device__ __forceinline__ void unit(const bf16_t* proj, const float* stats  , const float* lng, const float* lnb, const float* sw, const float* sb, bf16_t* Y2, int un, LAS unsigned char* lds) {
    int tid_l = threadIdx.x; asm volatile("" : "+v"(tid_l));
    const int tid = tid_l, wid = __builtin_amdgcn_readfirstlane(tid >> 6), lane = tid & 63, r32 = lane & 31, hi = lane >> 5;
    const int g = un & 7, R0 = (un >> 3) * 128;
    { const int sr = tid >> 4, sc = (tid & 15) * 8, ch = g * 128 + sc;
      const f32x4 g0 = *(const f32x4*)(lng + ch), g1 = *(const f32x4*)(lng + ch + 4), b0 = *(const f32x4*)(lnb + ch), b1 = *(const f32x4*)(lnb + ch + 4);
      float mus[4], rss[4];
      { float2 pp[4];
#pragma unroll
        for (int q = 0; q < 4; ++q) pp[q] = *(const float2*)(stats + ((size_t)(R0 + sr + 32 * q) * 16 + (tid & 15)) * 2);
        asm volatile("" ::: "memory");
#pragma unroll
        for (int q = 0; q < 4; ++q) { float s1 = pp[q].x, s2 = pp[q].y;
#pragma unroll
            for (int off = 1; off < 16; off <<= 1) { s1 += __shfl_xor(s1, off); s2 += __shfl_xor(s2, off); }
            mus[q] = s1 * (1.0f / 1024.0f); rss[q] = __builtin_amdgcn_rsqf(fmaxf(s2 * (1.0f / 1024.0f) - mus[q] * mus[q], 0.f) + LN_EPS); } }
#pragma unroll
      for (int q = 0; q < 4; ++q) { const int s = sr + 32 * q, row = R0 + s; const u32x4 vv = *(const u32x4*)(proj + (size_t)row * NC + C_VC + ch);
          const float mu = mus[q], rs = rss[q];
          u32x4 w; w.x = pg8::cvt_pk_bf16((bflo(vv.x) - mu) * rs * g0[0] + b0[0], (bfhi(vv.x) - mu) * rs * g0[1] + b0[1]); w.y = pg8::cvt_pk_bf16((bflo(vv.y) - mu) * rs * g0[2] + b0[2], (bfhi(vv.y) - mu) * rs * g0[3] + b0[3]);
          w.z = pg8::cvt_pk_bf16((bflo(vv.z) - mu) * rs * g1[0] + b1[0], (bfhi(vv.z) - mu) * rs * g1[1] + b1[1]); w.w = pg8::cvt_pk_bf16((bflo(vv.w) - mu) * rs * g1[2] + b1[2], (bfhi(vv.w) - mu) * rs * g1[3] + b1[3]);
          *(LAS u32x4*)(lds + (s >> 6) * att::SHM_V + att::v_st(s & 63, sc)) = w; } }
    __syncthreads();
    const int tb = wid & 3, eh = wid >> 2, t = tb * 32 + r32;
    att::f32x16 o0 = att::f32x16{}, o1 = att::f32x16{};
    LAS const unsigned char* vb = lds + att::v_rd_base(lane);
#pragma unroll
    for (int st = 0; st < 2; ++st) {
        if (st * 64 > tb * 32 + 31) continue;
        att::bf16x8 pa[4];
#pragma unroll
        for (int k = 0; k < 4; ++k) { const int s0 = st * 64 + 16 * k + hi * 8; const float* wp = sw + ((size_t)g * 128 + t) * 128 + s0; const f32x4 w0 = *(const f32x4*)wp, w1 = *(const f32x4*)(wp + 4);
            float x[8] = {w0[0], w0[1], w0[2], w0[3], w1[0], w1[1], w1[2], w1[3]};
#pragma unroll
            for (int j = 0; j < 8; ++j) x[j] = (s0 + j <= t) ? x[j] : 0.f;
            u32x4 p; p.x = pg8::cvt_pk_bf16(x[0], x[1]); p.y = pg8::cvt_pk_bf16(x[2], x[3]); p.z = pg8::cvt_pk_bf16(x[4], x[5]); p.w = pg8::cvt_pk_bf16(x[6], x[7]); pa[k] = __builtin_bit_cast(att::bf16x8, p); }
        if (eh == 0) { att::pv_one<0>(o0, vb + st * att::SHM_V, pa[0], pa[1], pa[2], pa[3]); att::pv_one<1>(o1, vb + st * att::SHM_V, pa[0], pa[1], pa[2], pa[3]); }
        else         { att::pv_one<2>(o0, vb + st * att::SHM_V, pa[0], pa[1], pa[2], pa[3]); att::pv_one<3>(o1, vb + st * att::SHM_V, pa[0], pa[1], pa[2], pa[3]); }
    }
    { unsigned uu[32], zq[32]; float bias[16];
#pragma unroll
      for (int r = 0; r < 16; ++r) { const int tr = tb * 32 + att::crow(r, hi), bt = R0 + tr; bias[r] = sb[g * 128 + tr];
#pragma unroll
          for (int d = 0; d < 2; ++d) { const int ch = g * 128 + (2 * eh + d) * 32 + (r32 & ~1); uu[r * 2 + d] = *(const unsigned*)(proj + (size_t)bt * NC + C_UC + ch); zq[r * 2 + d] = *(const unsigned*)(proj + (size_t)bt * NC + C_ZC + ch); } }
      asm volatile("" ::: "memory");
#pragma unroll
      for (int r = 0; r < 16; ++r) { const int bt = R0 + tb * 32 + att::crow(r, hi);
#pragma unroll
          for (int d = 0; d < 2; ++d) { const float val = (d == 0 ? o0[r] : o1[r]) + bias[r], vn = __shfl_xor(val, 1); const int ch = g * 128 + (2 * eh + d) * 32 + r32;
              if ((r32 & 1) == 0) *(unsigned*)(Y2 + (size_t)bt * YS + ch) = pk2(val * bflo(uu[r * 2 + d]) * bflo(zq[r * 2 + d]), vn * bfhi(uu[r * 2 + d]) * bfhi(zq[r * 2 + d])); } } }
    __syncthreads();
}
}

namespace memat {
__device__ __forceinline__ void task(const bf16_t* proj, const bf16_t* mk, const bf16_t* mvt, bf16_t* Y3, int tk, int lane) {
    const int rb = tk & 63, h = (tk >> 6) & 3, b = tk >> 8, r32 = lane & 31, hi = lane >> 5, bt0 = b * SEQ + rb * 32;
    att::bf16x8 qr[16];
    const bf16_t* qp = proj + (size_t)(bt0 + r32) * NC + C_QM + h * 256 + hi * 8;
#pragma unroll
    for (int d0 = 0; d0 < 16; ++d0) qr[d0] = *(const att::bf16x8*)(qp + d0 * 16);
    att::f32x16 s[8];
#pragma unroll
    for (int kb = 0; kb < 8; ++kb) { s[kb] = att::f32x16{}; const bf16_t* kp = mk + (size_t)(b * MEML + kb * 32 + r32) * 2048 + h * 256 + hi * 8;
#pragma unroll
        for (int q4 = 0; q4 < 4; ++q4) { att::bf16x8 kf[4];
#pragma unroll
            for (int i = 0; i < 4; ++i) kf[i] = *(const att::bf16x8*)(kp + (q4 * 4 + i) * 16);
            asm volatile("" ::: "memory");
#pragma unroll
            for (int i = 0; i < 4; ++i) s[kb] = __builtin_amdgcn_mfma_f32_32x32x16_bf16(kf[i], qr[q4 * 4 + i], s[kb], 0, 0, 0); } }
    constexpr float C = 0.0625f * att::LOG2E;
    float mx = -__builtin_inff();
#pragma unroll
    for (int kb = 0; kb < 8; ++kb)
#pragma unroll
        for (int r = 0; r < 16; ++r) mx = fmaxf(mx, s[kb][r]);
    { auto rr = __builtin_amdgcn_permlane32_swap(__float_as_uint(mx), __float_as_uint(mx), false, false); mx = fmaxf(__uint_as_float(rr[0]), __uint_as_float(rr[1])); }
    float l = 0.f; const float mc = mx * C;
#pragma unroll
    for (int kb = 0; kb < 8; ++kb)
#pragma unroll
        for (int r = 0; r < 16; ++r) { s[kb][r] = __builtin_amdgcn_exp2f(fmaf(s[kb][r], C, -mc)); l += s[kb][r]; }
    { auto rr = __builtin_amdgcn_permlane32_swap(__float_as_uint(l), __float_as_uint(l), false, false); l = __uint_as_float(rr[0]) + __uint_as_float(rr[1]); }
    const float linv = 1.0f / l;
    att::bf16x8 pa[16];
#define MEM_PK4(P, BASE, OUT) do { const unsigned a0_ = att::cvtpk(P[BASE + 0], P[BASE + 1]), a1_ = att::cvtpk(P[BASE + 2], P[BASE + 3]);   \
    const unsigned b0_ = att::cvtpk(P[BASE + 4], P[BASE + 5]), b1_ = att::cvtpk(P[BASE + 6], P[BASE + 7]);                              \
    auto r0_ = __builtin_amdgcn_permlane32_swap(a0_, b0_, false, false); auto r1_ = __builtin_amdgcn_permlane32_swap(a1_, b1_, false, false); \
    u32x4 w_ = {r0_[0], r1_[0], r0_[1], r1_[1]}; OUT = __builtin_bit_cast(att::bf16x8, w_); } while (0)
#pragma unroll
    for (int kb = 0; kb < 8; ++kb) { MEM_PK4(s[kb], 0, pa[2 * kb]); MEM_PK4(s[kb], 8, pa[2 * kb + 1]); }
#undef MEM_PK4
    float rli[16];
#pragma unroll
    for (int r = 0; r < 16; ++r) rli[r] = __shfl(linv, att::crow(r, hi));
#pragma unroll
    for (int db = 0; db < 8; ++db) { att::f32x16 o = att::f32x16{}; const bf16_t* vp = mvt + ((size_t)((b * 4 + h) * 256 + db * 32 + r32)) * 256 + hi * 8;
        att::bf16x8 vf[16]; unsigned zz[16];
#pragma unroll
        for (int ks = 0; ks < 16; ++ks) vf[ks] = *(const att::bf16x8*)(vp + ks * 16);
#pragma unroll
        for (int r = 0; r < 16; ++r) zz[r] = *(const unsigned*)(proj + (size_t)(bt0 + att::crow(r, hi)) * NC + C_ZM + h * 256 + db * 32 + (r32 & ~1));
        asm volatile("" ::: "memory");
#pragma unroll
        for (int ks = 0; ks < 16; ++ks) o = __builtin_amdgcn_mfma_f32_32x32x16_bf16(pa[ks], vf[ks], o, 0, 0, 0);
#pragma unroll
        for (int r = 0; r < 16; ++r) { const int bt = bt0 + att::crow(r, hi), col = h * 256 + db * 32 + r32; const float val = o[r] * rli[r], vn = __shfl_xor(val, 1);
            if ((r32 & 1) == 0) *(unsigned*)(Y3 + (size_t)bt * YS + col) = pk2(val * bflo(zz[r]), vn * bfhi(zz[r])); } }
}
}
#define XB_TMO      128
#define XB_XCNT(j)  (256  + 64 * (j))
#define XB_XSUB(j)  (1280 + 64 * (j))
#define XB_XGEN(j)  (2304 + 64 * (j))
#define XB_TOP      3328
#define XB_TOPGEN   3392
#define XCD_BAR_WORDS 3456
#define XB_SPIN_CAP (1u << 18)

__device__ __forceinline__ unsigned xb_ld(unsigned* p)              { return __hip_atomic_load(p, __ATOMIC_RELAXED, __HIP_MEMORY_SCOPE_AGENT); }
__device__ __forceinline__ unsigned xb_add(unsigned* p, unsigned v) { return __hip_atomic_fetch_add(p, v, __ATOMIC_RELAXED, __HIP_MEMORY_SCOPE_AGENT); }
__device__ __forceinline__ unsigned xb_xcc_id() { return (unsigned)__builtin_amdgcn_s_getreg((3 << 11) | 20) & 0xFu; }
#define XB_SPIN(cond, bar) do { unsigned _sp = 0; while (cond) { __builtin_amdgcn_s_sleep(1); \
    if ((++_sp & 255u) == 0u) { if (xb_ld(&(bar)[XB_TMO])) break; if (_sp > XB_SPIN_CAP) { atomicAdd(&(bar)[XB_TMO], 1u); break; } } } } while (0)

struct XcdBarrier {
    unsigned* bar; unsigned x;
    volatile LAS unsigned* st;
};

__device__ __forceinline__ XcdBarrier xcd_barrier_post(unsigned* bar, volatile LAS unsigned* st) {
    XcdBarrier b; b.bar = bar; b.x = xb_xcc_id(); b.st = st;
    if (threadIdx.x == 0) (void)xb_add(&bar[XB_XCNT(b.x)], 1u);
    return b;
}
__device__ __forceinline__ void xcd_barrier_complete(unsigned* bar, unsigned x, unsigned& nloc, unsigned& nx) {
    const unsigned G = gridDim.x * gridDim.y * gridDim.z;
    unsigned sum, cnt, mine, sp = 0u;
    for (;;) {
        sum = 0u; cnt = 0u; mine = 0u;
#pragma unroll
        for (unsigned j = 0; j < 16; ++j) { const unsigned c = xb_ld(&bar[XB_XCNT(j)]); sum += c; cnt += (c > 0u) ? 1u : 0u; mine = (j == x) ? c : mine; }
        if (sum == G) break;
        __builtin_amdgcn_s_sleep(1);
        if ((++sp & 255u) == 0u) { if (xb_ld(&bar[XB_TMO])) break; if (sp > XB_SPIN_CAP) { atomicAdd(&bar[XB_TMO], 1u); break; } }
    }
    nloc = mine > 0u ? mine : 1u; nx = cnt > 0u ? cnt : 1u;
}

__device__ __forceinline__ void xcd_barrier(const XcdBarrier& b) {
    asm volatile("s_waitcnt vmcnt(0)" ::: "memory");
    __syncthreads();
    if (threadIdx.x == 0) {
        unsigned* bar = b.bar;
        __builtin_amdgcn_s_waitcnt(0);
        unsigned nloc = b.st[0], nx = b.st[1];
        if (nloc == 0u) { xcd_barrier_complete(bar, b.x, nloc, nx); b.st[0] = nloc; b.st[1] = nx; }
        const unsigned old = xb_add(&bar[XB_XSUB(b.x)], 1u);
        const unsigned gen = old / nloc;
        if (old + 1u == (gen + 1u) * nloc) {
            __builtin_amdgcn_fence(__ATOMIC_RELEASE, "agent");
            asm volatile("s_waitcnt vmcnt(0)" ::: "memory");
            const unsigned og = xb_add(&bar[XB_TOP], 1u);
            const unsigned tg = og / nx;
            if (og + 1u == (tg + 1u) * nx) xb_add(&bar[XB_TOPGEN], 1u);
            else XB_SPIN(xb_ld(&bar[XB_TOPGEN]) == tg, bar);
            __builtin_amdgcn_fence(__ATOMIC_ACQUIRE, "agent");
            xb_add(&bar[XB_XGEN(b.x)], 1u);
            asm volatile("s_waitcnt vmcnt(0)" ::: "memory");
        } else {
            XB_SPIN(xb_ld(&bar[XB_XGEN(b.x)]) == gen, bar);
            __builtin_amdgcn_fence(__ATOMIC_ACQUIRE, "agent");
            asm volatile("s_waitcnt vmcnt(0)" ::: "memory");
        }
    }
    __syncthreads();
}

__device__ __forceinline__ const float* launder_p(const float* p) { const GAS float* g = (const GAS float*)p; asm volatile("" : "+s"(g)); return (const float*)g; }
#ifndef MK_TWICE
#define MK_TWICE -1
#endif
#define REPS(k, l_) ((MK_TWICE == (k) && (l_) == 0) ? 2 : 1)
constexpr int CONV_I_IN = (DM / 64) * (NC / 64), CONV_I_MEM = (DM / 64) * (2048 / 64), CONV_I_BR = (4 * BW / 64) * (DM / 64), CONV_I_OUT = (DM / 64) * (DM / 64);
constexpr int CONV_PER_L = CONV_I_IN + CONV_I_MEM + CONV_I_BR + CONV_I_OUT;
#define CONV_DECODE(t_, l_, it_) do { int r_ = (it_); \
    if (r_ < CONV_I_IN) { t_.W = INP(3) + (size_t)(l_) * DM * NC; t_.g = INP(2) + (size_t)(l_) * DM; t_.WT = (bf16_t*)(ws + WS_WIN) + (size_t)(l_) * NC * DM; t_.K = DM; t_.N = NC; } \
    else if ((r_ -= CONV_I_IN) < CONV_I_MEM) { t_.W = INP(5) + (size_t)(l_) * DM * 2048; t_.g = INP(4) + (size_t)(l_) * DM; t_.WT = (bf16_t*)(ws + WS_WMEM) + (size_t)(l_) * 2048 * DM; t_.K = DM; t_.N = 2048; } \
    else if ((r_ -= CONV_I_MEM) < CONV_I_BR) { t_.W = INP(15) + (size_t)(l_) * 4 * BW * DM; t_.g = nullptr; t_.WT = (bf16_t*)(ws + WS_WBR) + (size_t)(l_) * DM * 4 * BW; t_.K = 4 * BW; t_.N = DM; } \
    else { r_ -= CONV_I_BR; t_.W = INP(16) + (size_t)(l_) * DM * DM; t_.g = nullptr; t_.WT = (bf16_t*)(ws + WS_WOUT) + (size_t)(l_) * DM * DM; t_.K = DM; t_.N = DM; } \
    t_.idx = r_; t_.nt = ((l_) > 0 || (it_) >= CONV_P0_ITEMS) ? 1 : 0; } while (0)
#define CONV_RUN(l_, first_, stride_, end_, lane_) do { TPItem ta_, tb_; f32x4 va_[16], vb_[16]; float2 ga_[8], gb_[8]; int it_ = (first_); bool ha_ = it_ < (end_); \
    if (ha_) { CONV_DECODE(ta_, l_, it_); tp_load(ta_, va_, ga_, lane_); } \
    while (ha_) { const int itb_ = it_ + (stride_); const bool hb_ = itb_ < (end_); if (hb_) { CONV_DECODE(tb_, l_, itb_); tp_load(tb_, vb_, gb_, lane_); } \
        tp_store(ta_, va_, ga_, (LAS unsigned char*)wl, lane_); if (!hb_) break; \
        it_ = itb_ + (stride_); ha_ = it_ < (end_); if (ha_) { CONV_DECODE(ta_, l_, it_); tp_load(ta_, va_, ga_, lane_); } \
        tp_store(tb_, vb_, gb_, (LAS unsigned char*)wl, lane_); } } while (0)
static_assert(CONV_PER_L % 32 == 0, "conversion chunks of 32 items");
constexpr int CONV_P0_ITEMS = CONV_I_IN + CONV_I_MEM, CONV_D0 = (CONV_PER_L - CONV_P0_ITEMS) / 32, CONV_NCH = CONV_D0 + CONV_P0_ITEMS / 32;
static_assert(CONV_P0_ITEMS % 32 == 0 && (CONV_PER_L - CONV_P0_ITEMS) % 32 == 0, "chunk alignment");
#define CONV_CHUNK(ch_, lane_) do { if ((ch_) < CONV_D0) CONV_RUN4(0, CONV_P0_ITEMS + (ch_) * 32 + wave * 4, lane_); else CONV_RUN4(DEPTH - 1, ((ch_) - CONV_D0) * 32 + wave * 4, lane_); } while (0)
#define CONV_RUN4(l_, i0_, lane_) do { TPItem t0_, t1_, t2_, t3_; f32x4 va_[16], vb_[16]; float2 ga_[8], gb_[8]; \
    CONV_DECODE(t0_, l_, (i0_)); CONV_DECODE(t1_, l_, (i0_) + 1); tp_load(t0_, va_, ga_, lane_); tp_load(t1_, vb_, gb_, lane_); \
    tp_store(t0_, va_, ga_, (LAS unsigned char*)wl, lane_); CONV_DECODE(t2_, l_, (i0_) + 2); tp_load(t2_, va_, ga_, lane_); \
    tp_store(t1_, vb_, gb_, (LAS unsigned char*)wl, lane_); CONV_DECODE(t3_, l_, (i0_) + 3); tp_load(t3_, vb_, gb_, lane_); \
    tp_store(t2_, va_, ga_, (LAS unsigned char*)wl, lane_); tp_store(t3_, vb_, gb_, (LAS unsigned char*)wl, lane_); } while (0)
struct Args { const float* in[18]; float* out; unsigned char* ws; int ph_lo, ph_hi, li, pad; };
__global__ void __launch_bounds__(NWAVES * 64, 2) mega_fwd(Args args) {
    extern __shared__ __attribute__((aligned(16))) unsigned char lds_raw[];
    LAS unsigned char* lds = (LAS unsigned char*)lds_raw;
    volatile LAS unsigned* MISC = (volatile LAS unsigned*)(lds + MISC_OFF);
    const int G = (int)gridDim.x, NGW = G * NWAVES;
    for (int u = threadIdx.x; u < (LDS_BYTES - LDSCTL_OFF) / 4; u += NWAVES * 64) ((LAS unsigned*)(lds + LDSCTL_OFF))[u] = 0u;
    __syncthreads();
    XcdBarrier bar = xcd_barrier_post((unsigned*)((gu32*)(args.ws + WS_CTL) + CW_BAR) + args.li * XCD_BAR_WORDS, MISC + 8);
    const int lo = args.ph_lo, hi = args.ph_hi;
#define IN(k) (lo <= (k) && (k) < hi)
#define SEAM(k) do { if (IN(k) && IN((k) + 1)) { GRID_BAR(); } } while (0)
#define GRID_BAR() do { XcdBarrier bb_ = bar; GAS unsigned* gb_ = (GAS unsigned*)bar.bar; asm volatile("" : "+s"(gb_), "+s"(bb_.x)); bb_.bar = (unsigned*)gb_; xcd_barrier(bb_); } while (0)
#define PHASE_CTX() int tid_ = threadIdx.x; asm volatile("" : "+v"(tid_)); GAS unsigned char* wsg_ = (GAS unsigned char*)args.ws; asm volatile("" : "+s"(wsg_)); unsigned char* ws = (unsigned char*)wsg_; \
    const int tid = tid_, lane = tid & 63, wave = __builtin_amdgcn_readfirstlane(tid >> 6), gw = (int)blockIdx.x * NWAVES + wave; \
    LAS float* wl = (LAS float*)(lds + wave * 16384); (void)lane; (void)gw; (void)ws; (void)wl; (void)tid
#define INP(k) launder_p(args.in[k])

    if (IN(0)) for (int rep = 0; rep < REPS(0, 0); ++rep) {
        if (rep) GRID_BAR();
        PHASE_CTX();
        const float* x = INP(0); const float* mem = INP(1);
        CONV_RUN(0, gw, NGW, CONV_P0_ITEMS, lane);
        for (int r = gw; r < MT; r += NGW) row_item(x, (bf16_t*)(ws + WS_XB), (float*)(ws + WS_SS0), r, lane);
        for (int r = gw; r < MEMR; r += NGW) row_item(mem, (bf16_t*)(ws + WS_MEMB), (float*)(ws + WS_MEMSS), r, lane);
    }
    SEAM(0);

    for (int l = 0; l < DEPTH; ++l) {
        const int pb = 1 + 5 * l;
        if (IN(pb)) for (int rep = 0; rep < REPS(1, l); ++rep) {
            if (rep) GRID_BAR();
            { PHASE_CTX();
            { pg8::Gemm g{(const bf16_t*)(ws + WS_MEMB), (const bf16_t*)(ws + WS_WMEM) + (size_t)l * 2048 * DM, MEMR, 2048, DM}; pg8::StaticOrder S; S.init(MEMR, 2048, G, (int)((blockIdx.x + G / 2) % G));
              pg8::EpiMem E{(bf16_t*)(ws + WS_MKV) + (size_t)l * MEMR * 2048, (const float*)(ws + WS_MEMSS), (bf16_t*)(ws + WS_MVT) + (size_t)l * MEMR * 1024}; pg8::gemm_phase<pg8::EpiMem, pg8::StaticOrder, true, true>(lds, g, S, E); }
            { pg8::Gemm g{(const bf16_t*)(ws + WS_XB), (const bf16_t*)(ws + WS_WIN) + (size_t)l * NC * DM, MT, NC, DM}; pg8::StaticOrder S; S.init(MT, NC, G, (int)blockIdx.x);
              pg8::EpiProj E{(bf16_t*)(ws + WS_PROJ), (const float*)(ws + (l == 0 ? WS_SS0 : WS_CTL + CTL_SS1)), ws + WS_G8, (float*)(ws + WS_KMEAN), (float*)(ws + WS_KN), (float*)(ws + WS_STATS)}; pg8::gemm_phase<pg8::EpiProj, pg8::StaticOrder, true, true>(lds, g, S, E); }
            }
            if (l + 1 < DEPTH) {
                if ((int)blockIdx.x >= G / 2 + MEMR / 256 * 8 && 3712 % G != 0) {
                    PHASE_CTX();
                    gu32* chead = (gu32*)(ws + WS_CTL) + CW_CONV;
                    for (int k = 0; k < 7; ++k) {
                        if (tid == 0) MISC[17] = __hip_atomic_fetch_add(chead, 1u, RLX_AGENT);
                        __syncthreads(); const int cu = (int)MISC[17]; __syncthreads();
                        if (cu >= CONV_NCH) break;
                        CONV_CHUNK(cu, lane);
                    }
                }
            } else {
                PHASE_CTX();
                gu32* chead = (gu32*)(ws + WS_CTL) + CW_CONV + 64;
                for (;;) {
                    if (tid == 0) MISC[17] = __hip_atomic_fetch_add(chead, 1u, RLX_AGENT);
                    __syncthreads(); const int cu = (int)MISC[17]; __syncthreads();
                    if (cu >= CONV_D0) break;
                    CONV_RUN4(DEPTH - 1, CONV_P0_ITEMS + cu * 32 + wave * 4, lane);
                }
            }
        }
        SEAM(pb);
        if (IN(pb + 2)) for (int rep = 0; rep < REPS(3, l); ++rep) {
            if (rep) GRID_BAR();
            { PHASE_CTX();
            const bf16_t* PROJ = (const bf16_t*)(ws + WS_PROJ); bf16_t* Y = (bf16_t*)(ws + WS_Y);
            const bf16_t* mkv = (const bf16_t*)(ws + WS_MKV) + (size_t)l * MEMR * 2048;
            gu32* qhead = (gu32*)(ws + WS_CTL) + CW_Q + 64 * (l + 2 * rep);
            const float lam_init = l == 0 ? 0.2f : 0.35550907f;
            for (;;) {
                if (tid == 0) MISC[16] = __hip_atomic_fetch_add(qhead, 1u, RLX_AGENT);
                __syncthreads(); const int uq = (int)MISC[16]; __syncthreads();
                int lane_u = lane; asm volatile("" : "+v"(lane_u));
                constexpr int NCONV = CONV_NCH;
                int u = uq;
                if (l + 1 < DEPTH) {
                    if (uq >= 1024 + NCONV) break;
                    int cu = -1;
                    if (uq < 2048) { if (uq & 1) cu = uq >> 1; else u = uq >> 1; } else cu = uq - 1024;
                    if (cu >= 0) {
                        if (tid == 0) MISC[17] = __hip_atomic_fetch_add((gu32*)(ws + WS_CTL) + CW_CONV, 1u, RLX_AGENT);
                        __syncthreads(); const int ch = (int)MISC[17]; __syncthreads();
                        if (ch < NCONV) CONV_CHUNK(ch, lane_u);
                        continue; }
                } else {
#ifndef MQ_PROBE
#define MQ_PROBE 0
#endif
                    constexpr int MQX = MQ_PROBE == 1 ? 256 : MQ_PROBE == 2 ? 128 : MQ_PROBE == 3 ? 128 : MQ_PROBE == 4 ? 512 : 0;
                    if (uq >= 1024 + MQX) break;
                    if (uq < MQX) { if (MQ_PROBE == 1) u = (uq / 32) * 48 + 16 + uq % 32; else if (MQ_PROBE == 2) u = (uq / 16) * 48 + uq % 16; else if (MQ_PROBE == 3) u = 384 + uq; else u = 512 + uq; }
                    else u = uq - MQX;
                }
                if (u >= 512) {
                    sgu::unit(PROJ, (const float*)(ws + WS_STATS), INP(11) + l * BW, INP(12) + l * BW, INP(13) + (size_t)l * 8 * 128 * 128, INP(14) + l * 8 * 128, Y + 2 * BW, u - 512, lds);
                    continue; }
                if (u >= 384) {
                    memat::task(PROJ, mkv, (const bf16_t*)(ws + WS_MVT) + (size_t)l * MEMR * 1024, Y + 3 * BW, (u - 384) * 8 + wave, lane_u);
                    continue; }
                const int L = 7 - u / 48, v = u % 48;
                att::f32x16 o[4]; float rli[16];
                if (v < 16) {
                    const int b = v >> 2, h = v & 3;
                    float* S1 = (float*)(ws + WS_BSCR) + (size_t)blockIdx.x * 65536; float* S2 = S1 + 32768;
#pragma nounroll
                    for (int ps = 0; ps < 4; ++ps) { const int mp = ps & 1, vh = ps >> 1;
                        att::UnitDesc U; U.Q = PROJ + (size_t)(b * SEQ + L * 256) * NC + C_QB + h * 256 + mp * 128; U.K = PROJ + (size_t)(b * SEQ) * NC + C_KB + h * 256 + mp * 128;
                        U.V = PROJ + (size_t)(b * SEQ) * NC + C_VB + h * 256 + vh * 128; U.q0 = L * 256; U.nt = 4 * (L + 1); U.slopeL = exp2f(-8.0f * (float)(h + 1) / 12.0f) * att::LOG2E; U.moba_j = -1; U.kmean = nullptr;
                        U.knorm = (const float*)(ws + WS_KN) + ((b * 4 + h) * 2 + mp) * 128;
                        unsigned char* psv = ws + WS_PSAVE + (size_t)blockIdx.x * PSAVE_WG + (size_t)mp * PSAVE_MAP; U.psave = psv; U.kt0_out = (LAS unsigned*)(MISC + 20 + mp);
                        if (vh == 0) att::run_unit<false, true>(U, lds, o, rli);
                        else { const int kt0v = (int)MISC[20 + mp]; att::run_light(U.V, kt0v, U.nt - kt0v, psv, lds, o);
#pragma unroll
                            for (int r = 0; r < 16; ++r) rli[r] = 0.f; }
                        int lane_p = threadIdx.x & 63; asm volatile("" : "+v"(lane_p)); const int r32 = lane_p & 31, hi = lane_p >> 5;
                        float* sp = S1 + (size_t)(wave * 64 + lane_p) * 64;
                        { float* rl = (float*)(ws + WS_PSAVE + (size_t)blockIdx.x * PSAVE_WG + (size_t)mp * PSAVE_MAP + (size_t)32 * att::PS_TILE) + (size_t)(wave * 64 + lane_p) * 16;
                          if (vh == 0) {
#pragma unroll
                              for (int r = 0; r < 16; r += 4) *(f32x4*)(rl + r) = (f32x4){rli[r], rli[r + 1], rli[r + 2], rli[r + 3]};
                          } else {
#pragma unroll
                              for (int r = 0; r < 16; r += 4) { const f32x4 t4 = *(const f32x4*)(rl + r); rli[r] = t4[0]; rli[r + 1] = t4[1]; rli[r + 2] = t4[2]; rli[r + 3] = t4[3]; } } }
                        if (mp == 0) {
#pragma unroll
                            for (int r = 0; r < 16; ++r) *(f32x4*)(sp + r * 4) = (f32x4){o[0][r], o[1][r], o[2][r], o[3][r]} * rli[r];
                        } else {
                            const float* q1 = INP(6) + l * 128; const float* k1 = INP(7) + l * 128; const float* q2 = INP(8) + l * 128; const float* k2 = INP(9) + l * 128;
                            const float s1 = wave_sum(q1[lane_p] * k1[lane_p] + q1[lane_p + 64] * k1[lane_p + 64]), s2 = wave_sum(q2[lane_p] * k2[lane_p] + q2[lane_p + 64] * k2[lane_p + 64]);
                            const float lam = expf(s1) - expf(s2) + lam_init;
                            asm volatile("s_waitcnt vmcnt(0)" ::: "memory");
                            { f32x4 t[16];
#pragma unroll
                              for (int r = 0; r < 16; ++r) t[r] = *(const f32x4*)(sp + r * 4);
                              asm volatile("" ::: "memory");
#pragma unroll
                              for (int r = 0; r < 16; ++r) { const float a_ = lam * rli[r];
#pragma unroll
                                  for (int d0 = 0; d0 < 4; ++d0) o[d0][r] = t[r][d0] - a_ * o[d0][r]; } }
                            float* sq = S2 + (size_t)(wave * 64 + lane_p) * 64;
                            if (vh == 0) {
#pragma unroll
                                for (int r = 0; r < 16; ++r) *(f32x4*)(sq + r * 4) = (f32x4){o[0][r], o[1][r], o[2][r], o[3][r]};
                            } else { const float* subg = INP(10) + l * 256;
                                asm volatile("s_waitcnt vmcnt(0)" ::: "memory");
                                float sg[8];
#pragma unroll
                                for (int i = 0; i < 8; ++i) sg[i] = subg[(i >> 2) * 128 + (i & 3) * 32 + r32];
                                { f32x4 t[16];
#pragma unroll
                                  for (int r = 0; r < 16; ++r) t[r] = *(const f32x4*)(sq + r * 4);
                                  asm volatile("" ::: "memory");
#pragma unroll
                                  for (int r = 0; r < 16; ++r) { float ssq = 0.f;
#pragma unroll
                                      for (int d0 = 0; d0 < 4; ++d0) ssq += t[r][d0] * t[r][d0] + o[d0][r] * o[d0][r];
#pragma unroll
                                      for (int off = 1; off < 32; off <<= 1) ssq += __shfl_xor(ssq, off);
                                      rli[r] = __builtin_amdgcn_rsqf(ssq * (1.0f / 256.0f) + RMS_EPS) * (1.0f - lam_init); } }
#pragma unroll
                                for (int hv = 0; hv < 2; ++hv)
#pragma unroll
                                  for (int rq = 0; rq < 4; ++rq) { unsigned zz[16]; f32x4 t[4];
                                    int wv_ = wave; asm volatile("" : "+s"(wv_));
#pragma unroll
                                    for (int rr = 0; rr < 4; ++rr) { const int r = rq * 4 + rr; const bf16_t* zp = PROJ + (size_t)(b * SEQ + L * 256 + wv_ * 32 + att::crow(r, hi)) * NC + C_ZB + h * 256 + hv * 128 + (r32 & ~1);
#pragma unroll
                                        for (int d0 = 0; d0 < 4; ++d0) zz[rr * 4 + d0] = *(const unsigned*)(zp + d0 * 32);
                                        if (hv == 0) t[rr] = *(const f32x4*)(sq + r * 4); else t[rr] = (f32x4){o[0][r], o[1][r], o[2][r], o[3][r]}; }
                                    asm volatile("" ::: "memory");
#pragma unroll
                                    for (int rr = 0; rr < 4; ++rr) { const int r = rq * 4 + rr; bf16_t* yp = Y + (size_t)(b * SEQ + L * 256 + wv_ * 32 + att::crow(r, hi)) * YS + BW + h * 256 + hv * 128 + r32;
#pragma unroll
                                        for (int d0 = 0; d0 < 4; ++d0) { const float val = t[rr][d0] * rli[r] * sg[hv * 4 + d0], vn = __shfl_xor(val, 1);
                                            if ((r32 & 1) == 0) *(unsigned*)(yp + d0 * 32) = pk2(val * bflo(zz[rr * 4 + d0]), vn * bfhi(zz[rr * 4 + d0])); } } }
                            }
                        }
                    }
                } else {
                    const int bh = v - 16, b = bh >> 3, h = bh & 7;
                    att::UnitDesc U; U.Q = PROJ + (size_t)(b * SEQ + L * 256) * NC + C_QA + h * 128; U.K = PROJ + (size_t)(b * SEQ) * NC + C_KA + h * 128;
                    U.V = PROJ + (size_t)(b * SEQ) * NC + C_VA + h * 128; U.q0 = L * 256; U.nt = 4 * (L + 1); U.slopeL = exp2f(-8.0f * (float)(h + 5) / 12.0f) * att::LOG2E; U.moba_j = L;
                    U.kmean = (const float*)(ws + WS_KMEAN) + (size_t)(b * 8 + h) * 8 * 256; U.knorm = nullptr; U.psave = nullptr; U.kt0_out = nullptr;
                    att::run_unit<true>(U, lds, o, rli);
                    int lane_p = threadIdx.x & 63; asm volatile("" : "+v"(lane_p)); const int r32 = lane_p & 31, hi = lane_p >> 5;
                    { unsigned zz[64];
#pragma unroll
                      for (int r = 0; r < 16; ++r) { const int bt = b * SEQ + L * 256 + wave * 32 + att::crow(r, hi);
#pragma unroll
                          for (int d0 = 0; d0 < 4; ++d0) zz[r * 4 + d0] = *(const unsigned*)(PROJ + (size_t)bt * NC + C_ZA + h * 128 + d0 * 32 + (r32 & ~1)); }
                      asm volatile("" ::: "memory");
#pragma unroll
                      for (int r = 0; r < 16; ++r) { const int bt = b * SEQ + L * 256 + wave * 32 + att::crow(r, hi);
#pragma unroll
                          for (int d0 = 0; d0 < 4; ++d0) { const float val = o[d0][r] * rli[r], vn = __shfl_xor(val, 1); const int col = h * 128 + d0 * 32 + r32;
                              if ((r32 & 1) == 0) *(unsigned*)(Y + (size_t)bt * YS + col) = pk2(val * bflo(zz[r * 4 + d0]), vn * bfhi(zz[r * 4 + d0])); } } }
                }
            }
            }
        }
        SEAM(pb + 2);
        if (IN(pb + 3)) for (int rep = 0; rep < REPS(4, l); ++rep) {
            if (rep) GRID_BAR();
            PHASE_CTX();
            pg8::Gemm g{(const bf16_t*)(ws + WS_Y), (const bf16_t*)(ws + WS_WBR) + (size_t)l * DM * 4 * BW, MT, DM, 4 * BW}; pg8::StaticOrder S; S.init(MT, DM, G, (int)blockIdx.x);
            pg8::EpiGate2 E{ws + WS_G8, (bf16_t*)(ws + WS_MERGED)}; pg8::gemm_phase<pg8::EpiGate2, pg8::StaticOrder, true, true>(lds, g, S, E);
        }
        SEAM(pb + 3);
        if (IN(pb + 4)) for (int rep = 0; rep < REPS(5, l); ++rep) {
            if (rep) GRID_BAR();
            PHASE_CTX();
            pg8::Gemm g{(const bf16_t*)(ws + WS_MERGED), (const bf16_t*)(ws + WS_WOUT) + (size_t)l * DM * DM, MT, DM, DM}; pg8::StaticOrder S; S.init(MT, DM, G, (int)blockIdx.x);
            { typedef pg8::EpiResid<true, false, true> ER; ER E{nullptr, (const bf16_t*)(ws + WS_XB), nullptr, (bf16_t*)(ws + WS_XB), (float*)(ws + WS_CTL + (l == 0 ? CTL_SS1 : CTL_SS2)), (LAS float*)(lds + MISC_OFF + 1024)}; pg8::gemm_phase<ER, pg8::StaticOrder, true, true>(lds, g, S, E); }
        }
        SEAM(pb + 4);
    }
    if (IN(11)) { PHASE_CTX(); const float* fg = INP(17); float* outp = args.out; final_rows((const bf16_t*)(ws + WS_XB), (const float*)(ws + WS_CTL + CTL_SS2), fg, outp, gw, NGW, lane); }
#undef IN
#undef SEAM
}

extern "C" void kernel_launch(void* const* d_in, const int* in_sizes, int n_in, void* d_out, int out_size, void* d_ws, size_t ws_size, hipStream_t stream) {
    static int grid = 0;
    if (grid == 0) {
        if (n_in != 18 || in_sizes[0] != MT * DM || out_size != MT * DM || ws_size < WS_END) { fprintf(stderr, "kernel_launch: unexpected shapes (n_in %d in0 %d out %d ws %zu need %zu)\n", n_in, n_in > 0 ? in_sizes[0] : -1, out_size, ws_size, (size_t)WS_END); grid = -1; return; }
        int dev = 0, cus = 0, per_cu = 0;
        if (hipGetDevice(&dev) != hipSuccess || hipDeviceGetAttribute(&cus, hipDeviceAttributeMultiprocessorCount, dev) != hipSuccess) { fprintf(stderr, "kernel_launch: device query failed\n"); grid = -1; return; }
        if (hipFuncSetAttribute((const void*)mega_fwd, hipFuncAttributeMaxDynamicSharedMemorySize, LDS_BYTES) != hipSuccess) { fprintf(stderr, "kernel_launch: hipFuncSetAttribute failed\n"); grid = -1; return; }
        if (hipOccupancyMaxActiveBlocksPerMultiprocessor(&per_cu, (const void*)mega_fwd, NWAVES * 64, LDS_BYTES) != hipSuccess || per_cu < 1) fprintf(stderr, "kernel_launch: occupancy query reports %d workgroups per CU\n", per_cu);
        (void)hipGetLastError();
        grid = cus;
        if (grid != 256) fprintf(stderr, "kernel_launch: %d CUs (built and tuned for 256)\n", grid);
    }
    if (grid < 0) return;
    if (hipMemsetAsync((char*)d_ws + WS_CTL, 0, CTL_ZERO_BYTES, stream) != hipSuccess) { fprintf(stderr, "kernel_launch: memset failed\n"); return; }
    Args a{};
    for (int i = 0; i < 18; ++i) a.in[i] = (const float*)d_in[i];
    a.out = (float*)d_out; a.ws = (unsigned char*)d_ws;
#ifndef MK_SPLIT
    a.ph_lo = 0; a.ph_hi = 12; a.li = 0;
    hipLaunchKernelGGL(mega_fwd, dim3(grid), dim3(NWAVES * 64), LDS_BYTES, stream, a);
#else
    for (int p = 0; p < 12; ++p) { a.ph_lo = p; a.ph_hi = p + 1; a.li = p; hipLaunchKernelGGL(mega_fwd, dim3(grid), dim3(NWAVES * 64), LDS_BYTES, stream, a); }
#endif
    const hipError_t le = hipPeekAtLastError();
    if (le != hipSuccess) fprintf(stderr, "kernel_launch: launch failed: %s\n", hipGetErrorName(le));
}
```

```cpp
#include <hip/hip_runtime.h>
#include <cstdio>
#include <cstdint>

namespace cfg {
constexpr int DM = 4096, NBATCH = 4, SEQ = 2048, MT = NBATCH * SEQ, DEPTH = 2, MEML = 256, MEMR = NBATCH * MEML, BW = 1024;
constexpr int NC = 13 * BW + 4 * DM;
constexpr int C_QA = 0, C_KA = 1024, C_VA = 2048, C_ZA = 3072, C_QB = 4096, C_KB = 5120, C_VB = 6144, C_ZB = 7168, C_UC = 8192, C_VC = 9216, C_ZC = 10240, C_QM = 11264, C_ZM = 12288, C_G = 13312;
constexpr float RMS_EPS = 1e-6f, LN_EPS = 1e-5f;
}
namespace pg8 {
#define PG8_LAS __attribute__((address_space(3)))
typedef unsigned short bf16_t;
typedef short bf16x8 __attribute__((ext_vector_type(8)));
typedef float f32x4 __attribute__((ext_vector_type(4)));
typedef unsigned u32x4 __attribute__((ext_vector_type(4)));
constexpr int BM = 256, BK = 64, HALF = 128, HTB = HALF * BK * 2  , STAGE_BYTES = 8 * HTB, NXCD = 8, WGM = 4;

__host__ __device__ __forceinline__ int lds_byte(int r, int c) { const int st = (r >> 4) * 2 + (c >> 5), rr = r & 15, cc = c & 31, ob = rr * 64 + cc * 2; return st * 1024 + (ob ^ (((ob >> 9) & 1) << 5)); }
__host__ __device__ __forceinline__ void stage_rc(int b, int& R, int& C) { const int st = b / 1024, sb = b % 1024, swz = sb ^ (((sb >> 9) & 1) << 5); R = (st >> 1) * 16 + swz / 64; C = (st & 1) * 32 + (swz % 64) / 2; }
__host__ __device__ __forceinline__ int perm32(int rho) { const int n = rho >> 4, i = rho & 15; return 8 * (i >> 2) + 4 * n + (i & 3); }

struct Unit { int pm, pn; };
struct Gemm { const bf16_t* A; const bf16_t* Bt; int M, N, K; };

struct StaticOrder {
    int nM, nN, nwg, G, c;
    __host__ __device__ void init(int M, int N, int G_, int c_) { nM = M / BM; nN = N / BM; nwg = nM * nN; G = G_; c = c_; }
    __host__ __device__ bool next(int i, Unit& u) const {
        const long L = (long)i * G + c; if (L >= nwg) return false;
        int wgid = (int)L; { const int q = nwg / NXCD, r = nwg % NXCD, xcd = wgid % NXCD, off = wgid / NXCD; wgid = (xcd < r ? xcd * (q + 1) : r * (q + 1) + (xcd - r) * q) + off; }
        const int nig = WGM * nN, gid = wgid / nig, fm = gid * WGM, gsz = (nM - fm) < WGM ? (nM - fm) : WGM;
        u.pm = fm + ((wgid % nig) % gsz); u.pn = (wgid % nig) / gsz; return true;
    }
    __device__ __forceinline__ void a_ready(const Unit&) const {}
    __device__ __forceinline__ void done(const Unit&) const {}
};

typedef float f32x2_t __attribute__((ext_vector_type(2))); typedef __bf16 bf16x2_t __attribute__((ext_vector_type(2)));
__device__ __forceinline__ unsigned cvt_pk_bf16(float lo, float hi) { f32x2_t v = {lo, hi}; bf16x2_t b = __builtin_convertvector(v, bf16x2_t); return __builtin_bit_cast(unsigned, b); }
typedef float f32x2 __attribute__((ext_vector_type(2)));
typedef unsigned u32x2 __attribute__((ext_vector_type(2)));
__device__ __forceinline__ float bf_lo(unsigned w) { return __uint_as_float(w << 16); }
__device__ __forceinline__ float bf_hi(unsigned w) { return __uint_as_float(w & 0xffff0000u); }
__device__ __forceinline__ float sigmoid_f(float x) { return __builtin_amdgcn_rcpf(1.0f + __builtin_amdgcn_exp2f(-1.4426950408889634f * x)); }
template <int ACT> __device__ __forceinline__ float act_f(float v) {
    if (ACT == 1) return v * sigmoid_f(v);
    if (ACT == 2) { const float u2 = 1.5957691216057308f * (v + 0.044715f * v * v * v); return v * sigmoid_f(u2); }
    if (ACT == 3) return sigmoid_f(v);
    return v;
}
struct EpiProj {
    static constexpr bool PERM = true, AFTER_DRAIN = false, HAS_MID = false;
    bf16_t* O; const float* ss;
    unsigned char* g8;
    float* kms; float* kn2; float* st2;
    template <int ACT, int AUX> __device__ __forceinline__ void run(const f32x4 (&acc)[2][2][4][2], const Unit& u, int wr, int wc, int fr, int fq) const {
        const int row0 = u.pm * BM + wr * 64 + fr, col0 = u.pn * BM + wc * 32 + 8 * fq;
        float rsv[8];
#pragma unroll
        for (int i = 0; i < 8; ++i) rsv[i] = ss[row0 + (i >> 2) * HALF + (i & 3) * 16];
        asm volatile("" ::: "memory");
#pragma unroll
        for (int i = 0; i < 8; ++i) rsv[i] = __builtin_amdgcn_rsqf(rsv[i] * (1.0f / cfg::DM) + cfg::RMS_EPS);
        float cs[2][8]; float mx[2][2];
        if (AUX == 1) {
#pragma unroll
            for (int i = 0; i < 16; ++i) cs[i >> 3][i & 7] = 0.f; }
        if (AUX == 2) { mx[0][0] = mx[0][1] = mx[1][0] = mx[1][1] = 0.f; }
#pragma unroll
        for (int ai = 0; ai < 2; ++ai)
#pragma unroll
            for (int m = 0; m < 4; ++m) { const int r = row0 + ai * HALF + m * 16; const float rs = rsv[ai * 4 + m];
                bf16_t* rowp = O + (size_t)r * cfg::NC + col0; float s1 = 0.f, s2 = 0.f;
#pragma unroll
                for (int bj = 0; bj < 2; ++bj) { f32x4 v0 = acc[ai][bj][m][0] * rs, v1 = acc[ai][bj][m][1] * rs;
#pragma unroll
                    for (int j = 0; j < 4; ++j) { v0[j] = act_f<ACT>(v0[j]); v1[j] = act_f<ACT>(v1[j]); }
                    if (AUX == 4) {
                        unsigned q[8];
#pragma unroll
                        for (int j = 0; j < 4; ++j) { q[j] = (unsigned)fminf(fmaxf(fmaf(v0[j], 255.0f, 0.5f), 1.0f), 255.0f); q[4 + j] = (unsigned)fminf(fmaxf(fmaf(v1[j], 255.0f, 0.5f), 1.0f), 255.0f); }
                        u32x2 w8; w8.x = q[0] | (q[1] << 8) | (q[2] << 16) | (q[3] << 24); w8.y = q[4] | (q[5] << 8) | (q[6] << 16) | (q[7] << 24);
                        __builtin_nontemporal_store(w8, (u32x2*)(g8 + ((size_t)((u.pn - 52) >> 4) * cfg::MT + r) * cfg::DM + ((u.pn - 52) & 15) * BM + wc * 32 + 8 * fq + bj * HALF));
                    } else {
                    u32x4 w; w.x = cvt_pk_bf16(v0[0], v0[1]); w.y = cvt_pk_bf16(v0[2], v0[3]); w.z = cvt_pk_bf16(v1[0], v1[1]); w.w = cvt_pk_bf16(v1[2], v1[3]);
                    __builtin_nontemporal_store(w, (u32x4*)(rowp + bj * HALF)); }
                    if (AUX == 1) {
#pragma unroll
                        for (int j = 0; j < 4; ++j) { cs[bj][j] += v0[j]; cs[bj][4 + j] += v1[j]; } }
                    if (AUX == 2) { float p = (v0[0] * v0[0] + v0[1] * v0[1]) + (v0[2] * v0[2] + v0[3] * v0[3]) + (v1[0] * v1[0] + v1[1] * v1[1]) + (v1[2] * v1[2] + v1[3] * v1[3]);
                        p += __shfl_xor(p, 16); p += __shfl_xor(p, 32); mx[ai][bj] = fmaxf(mx[ai][bj], p); }
                    if (AUX == 3) { s1 += (v0[0] + v0[1]) + (v0[2] + v0[3]) + (v1[0] + v1[1]) + (v1[2] + v1[3]);
                        s2 += (v0[0] * v0[0] + v0[1] * v0[1]) + (v0[2] * v0[2] + v0[3] * v0[3]) + (v1[0] * v1[0] + v1[1] * v1[1]) + (v1[2] * v1[2] + v1[3] * v1[3]); } }
                if (AUX == 3) { s1 += __shfl_xor(s1, 16); s1 += __shfl_xor(s1, 32); s2 += __shfl_xor(s2, 16); s2 += __shfl_xor(s2, 32);
                    if (fq == 0) *(float2*)(st2 + ((size_t)r * 16 + (u.pn - 36) * 4 + wc) * 2) = make_float2(s1, s2); } }
        if (AUX == 1) {
#pragma unroll
            for (int i = 0; i < 16; ++i) { float x = cs[i >> 3][i & 7]; x += __shfl_xor(x, 1); x += __shfl_xor(x, 2); x += __shfl_xor(x, 4); x += __shfl_xor(x, 8); cs[i >> 3][i & 7] = x; }
            if (fr == 0) {
#pragma unroll
                for (int bj = 0; bj < 2; ++bj) { float* o = kms + ((size_t)(((u.pm >> 3) * 8 + (u.pn - 4) * 2 + bj) * 8 + (u.pm & 7)) * 2 + wr) * 128 + wc * 32 + 8 * fq;
                    *(f32x4*)o = (f32x4){cs[bj][0], cs[bj][1], cs[bj][2], cs[bj][3]}; *(f32x4*)(o + 4) = (f32x4){cs[bj][4], cs[bj][5], cs[bj][6], cs[bj][7]}; } }
        }
        if (AUX == 2) {
#pragma unroll
            for (int i = 0; i < 4; ++i) { float x = mx[i >> 1][i & 1]; x = fmaxf(x, __shfl_xor(x, 1)); x = fmaxf(x, __shfl_xor(x, 2)); x = fmaxf(x, __shfl_xor(x, 4)); x = fmaxf(x, __shfl_xor(x, 8));
                if (fr == 0 && fq == 0) kn2[((size_t)((((u.pm >> 3) * 4 + (u.pn - 20)) * 2 + (i & 1)) * 32 + (u.pm & 7) * 4 + (i >> 1) * 2 + wr)) * 4 + wc] = x; }
        }
    }
    __device__ __forceinline__ void operator()(const f32x4 (&acc)[2][2][4][2], const Unit& u, int wr, int wc, int fr, int fq) const {
        const int seg = u.pn >> 2;
        if (seg >= 13) run<3, 4>(acc, u, wr, wc, fr, fq);
        else if (seg == 3 || seg == 7 || seg == 10 || seg == 12) run<1, 0>(acc, u, wr, wc, fr, fq);
        else if (seg == 8) run<2, 0>(acc, u, wr, wc, fr, fq);
        else if (seg == 9) run<2, 3>(acc, u, wr, wc, fr, fq);
        else if (seg == 1) run<0, 1>(acc, u, wr, wc, fr, fq);
        else if (seg == 5) run<0, 2>(acc, u, wr, wc, fr, fq);
        else run<0, 0>(acc, u, wr, wc, fr, fq);
    }
};
struct EpiMem {
    static constexpr bool PERM = true, AFTER_DRAIN = false, HAS_MID = false;
    bf16_t* O; const float* ss; bf16_t* VT;
    __device__ __forceinline__ void operator()(const f32x4 (&acc)[2][2][4][2], const Unit& u, int wr, int wc, int fr, int fq) const {
        const int row0 = u.pm * BM + wr * 64 + fr, col0 = u.pn * BM + wc * 32 + 8 * fq;
        float rsv[8];
#pragma unroll
        for (int i = 0; i < 8; ++i) rsv[i] = ss[row0 + (i >> 2) * HALF + (i & 3) * 16];
        asm volatile("" ::: "memory");
#pragma unroll
        for (int i = 0; i < 8; ++i) rsv[i] = __builtin_amdgcn_rsqf(rsv[i] * (1.0f / cfg::DM) + cfg::RMS_EPS);
        if (u.pn < 4) {
#pragma unroll
            for (int ai = 0; ai < 2; ++ai)
#pragma unroll
                for (int m = 0; m < 4; ++m) { const int r = row0 + ai * HALF + m * 16; const float rs = rsv[ai * 4 + m];
                    bf16_t* rowp = O + (size_t)r * 2048 + col0;
#pragma unroll
                    for (int bj = 0; bj < 2; ++bj) { const f32x4 v0 = acc[ai][bj][m][0] * rs, v1 = acc[ai][bj][m][1] * rs;
                        u32x4 w; w.x = cvt_pk_bf16(v0[0], v0[1]); w.y = cvt_pk_bf16(v0[2], v0[3]); w.z = cvt_pk_bf16(v1[0], v1[1]); w.w = cvt_pk_bf16(v1[2], v1[3]);
                        *(u32x4*)(rowp + bj * HALF) = w; } }
        } else {
            bf16_t* vt = VT + (size_t)((u.pm * 4 + (u.pn - 4)) * 256) * 256;
#pragma unroll
            for (int ai = 0; ai < 2; ++ai)
#pragma unroll
                for (int m = 0; m < 4; ++m) { const int key = wr * 64 + fr + ai * HALF + m * 16; const float rs = rsv[ai * 4 + m];
#pragma unroll
                    for (int bj = 0; bj < 2; ++bj) { const f32x4 v0 = acc[ai][bj][m][0] * rs, v1 = acc[ai][bj][m][1] * rs; const int dv = bj * HALF + wc * 32 + 8 * fq;
                        const unsigned w0 = cvt_pk_bf16(v0[0], v0[1]), w1 = cvt_pk_bf16(v0[2], v0[3]), w2 = cvt_pk_bf16(v1[0], v1[1]), w3 = cvt_pk_bf16(v1[2], v1[3]);
                        bf16_t* p = vt + (size_t)dv * 256 + key;
                        p[0 * 256] = (bf16_t)(w0 & 0xffffu); p[1 * 256] = (bf16_t)(w0 >> 16); p[2 * 256] = (bf16_t)(w1 & 0xffffu); p[3 * 256] = (bf16_t)(w1 >> 16);
                        p[4 * 256] = (bf16_t)(w2 & 0xffffu); p[5 * 256] = (bf16_t)(w2 >> 16); p[6 * 256] = (bf16_t)(w3 & 0xffffu); p[7 * 256] = (bf16_t)(w3 >> 16); } }
        }
    }
};
struct EpiGate2 {
    static constexpr bool PERM = true, AFTER_DRAIN = false, HAS_MID = true; static constexpr int MID_EVERY = 16;
    const unsigned char* g8; bf16_t* merged;
    static __device__ __forceinline__ float ub(unsigned w, int k) { return (float)((w >> (8 * k)) & 0xffu); }
    __device__ __forceinline__ void mid(f32x4 (&acc)[2][2][4][2], const Unit& u, int b, int wr, int wc, int fr, int fq) const {
        const unsigned char* pa = g8 + ((size_t)(b - 1) * cfg::MT + u.pm * BM + wr * 64 + fr) * cfg::DM + u.pn * BM + wc * 32 + 8 * fq; const unsigned char* pb = pa + (size_t)cfg::MT * cfg::DM;
        u32x2 ga[16], gb[16];
#pragma unroll
        for (int i = 0; i < 16; ++i) { const size_t o = (size_t)(((i >> 3) & 1) * HALF + ((i >> 1) & 3) * 16) * cfg::DM + (i & 1) * HALF;
            ga[i] = *(const u32x2*)(pa + o); gb[i] = *(const u32x2*)(pb + o); }
        asm volatile("" ::: "memory");
#pragma unroll
        for (int i = 0; i < 16; ++i) { const int ai = (i >> 3) & 1, m = (i >> 1) & 3, bj = i & 1;
            f32x4 r0, r1;
#pragma unroll
            for (int j = 0; j < 4; ++j) { r0[j] = ub(ga[i].x, j) * __builtin_amdgcn_rcpf(ub(gb[i].x, j)); r1[j] = ub(ga[i].y, j) * __builtin_amdgcn_rcpf(ub(gb[i].y, j)); }
            acc[ai][bj][m][0] *= r0; acc[ai][bj][m][1] *= r1; }
    }
    __device__ __forceinline__ void operator()(const f32x4 (&acc)[2][2][4][2], const Unit& u, int wr, int wc, int fr, int fq) const {
        const int row0 = u.pm * BM + wr * 64 + fr, col0 = u.pn * BM + wc * 32 + 8 * fq;
        const unsigned char* pa = g8 + ((size_t)3 * cfg::MT + row0) * cfg::DM + col0;
        u32x2 ga[16];
#pragma unroll
        for (int i = 0; i < 16; ++i) ga[i] = *(const u32x2*)(pa + (size_t)(((i >> 3) & 1) * HALF + ((i >> 1) & 3) * 16) * cfg::DM + (i & 1) * HALF);
        asm volatile("" ::: "memory");
#pragma unroll
        for (int i = 0; i < 16; ++i) { const int ai = (i >> 3) & 1, m = (i >> 1) & 3, bj = i & 1; const int r = row0 + ai * HALF + m * 16, c = col0 + bj * HALF;
            f32x4 s0, s1;
#pragma unroll
            for (int j = 0; j < 4; ++j) { s0[j] = ub(ga[i].x, j) * (1.0f / 255.0f); s1[j] = ub(ga[i].y, j) * (1.0f / 255.0f); }
            const f32x4 v0 = acc[ai][bj][m][0] * s0, v1 = acc[ai][bj][m][1] * s1;
            u32x4 w; w.x = cvt_pk_bf16(v0[0], v0[1]); w.y = cvt_pk_bf16(v0[2], v0[3]); w.z = cvt_pk_bf16(v1[0], v1[1]); w.w = cvt_pk_bf16(v1[2], v1[3]);
            *(u32x4*)(merged + (size_t)r * cfg::DM + c) = w; }
    }
};
template <bool OLD_BF16, bool W_F32, bool W_BF16> struct EpiResid {
    static constexpr bool PERM = false, AFTER_DRAIN = false, HAS_MID = false;
    const float* xold; const bf16_t* xoldb; float* xnew; bf16_t* xb; float* ssn; PG8_LAS float* red;
    __device__ __forceinline__ void operator()(const f32x4 (&acc)[2][2][4][2], const Unit& u, int wr, int wc, int fr, int fq) const {
        typedef unsigned u32x2 __attribute__((ext_vector_type(2)));
        const int row0 = u.pm * BM + wr * 64 + fr, col0 = u.pn * BM + wc * 32 + 4 * fq;
#pragma unroll
        for (int ai = 0; ai < 2; ++ai) {
            f32x4 xo[16];
#pragma unroll
            for (int i = 0; i < 16; ++i) { const int m = i >> 2, bj = (i >> 1) & 1, n = i & 1; const size_t o = (size_t)(row0 + ai * HALF + m * 16) * cfg::DM + col0 + bj * HALF + n * 16;
                if (OLD_BF16) { const u32x2 ww = *(const u32x2*)(xoldb + o); xo[i] = (f32x4){bf_lo(ww.x), bf_hi(ww.x), bf_lo(ww.y), bf_hi(ww.y)}; } else xo[i] = *(const f32x4*)(xold + o); }
            asm volatile("" ::: "memory");
#pragma unroll
            for (int m = 0; m < 4; ++m) { const int r = row0 + ai * HALF + m * 16; float s = 0.f;
#pragma unroll
                for (int bj = 0; bj < 2; ++bj)
#pragma unroll
                    for (int n = 0; n < 2; ++n) { const size_t o = (size_t)r * cfg::DM + col0 + bj * HALF + n * 16; const f32x4 xn = xo[m * 4 + bj * 2 + n] + acc[ai][bj][m][n];
                        if (W_F32) *(f32x4*)(xnew + o) = xn;
                        if (W_BF16) { u32x2 w; w.x = cvt_pk_bf16(xn[0], xn[1]); w.y = cvt_pk_bf16(xn[2], xn[3]); *(u32x2*)(xb + o) = w; }
                        s += (xn[0] * xn[0] + xn[1] * xn[1]) + (xn[2] * xn[2] + xn[3] * xn[3]); }
                s += __shfl_xor(s, 16); s += __shfl_xor(s, 32);
                if (fq == 0) red[wc * 256 + (r - u.pm * BM)] = s; }
        }
        asm volatile("s_waitcnt lgkmcnt(0)" ::: "memory"); __builtin_amdgcn_s_barrier();
        if (wr == 0) { const int t = (wc * 4 + fq) * 16 + fr; unsafeAtomicAdd(ssn + u.pm * BM + t, (red[t] + red[256 + t]) + (red[512 + t] + red[768 + t])); }
    }
};
template <class Epi, class Sched, bool ALIGN_EPI = false, bool SP2 = false>
__device__ __forceinline__ void gemm_phase(PG8_LAS unsigned char* lds, const Gemm g, const Sched& S, const Epi& E) {
    int tid_l = threadIdx.x; asm volatile("" : "+v"(tid_l));
    const int tid = tid_l, wid = __builtin_amdgcn_readfirstlane(tid >> 6), lane = tid & 63, wr = wid >> 2, wc = wid & 3, fr = lane & 15, fq = lane >> 4;
    const int K = g.K, nt = K / BK;
    unsigned voffA[2], voffB[2];
#pragma unroll
    for (int i = 0; i < 2; ++i) { int R, C; stage_rc(tid * 16 + i * 8192, R, C); const int Rb = Epi::PERM ? ((R & ~31) + perm32(R & 31)) : R;
        voffA[i] = (unsigned)(R * K + C) * 2u; voffB[i] = (unsigned)(Rb * K + C) * 2u; }
    const size_t kstep = (size_t)(BK * 2);
    const size_t hstep = (size_t)HALF * K * 2;
    const size_t tstep = 2 * hstep;
    const unsigned ldsw = (unsigned)wid * 1024u;
    const int aoff = lds_byte(wr * 64 + fr, fq * 8), boff = lds_byte(wc * 32 + fr, fq * 8);
#define PG8_SA(b, h) (((b) * 2 + (h)) * HTB)
#define PG8_SB(b, h) ((4 + (b) * 2 + (h)) * HTB)
#define PG8_STAGE(bufoff, gbase, voff) do { _Pragma("unroll") for (int _i = 0; _i < 2; ++_i) \
        __builtin_amdgcn_global_load_lds((const unsigned*)((const char*)(gbase) + (voff)[_i]), (PG8_LAS unsigned*)(lds + (bufoff) + ldsw + _i * 8192), 16, 0, 0); } while (0)
#define PG8_LDA(dst, b, h) do { _Pragma("unroll") for (int m = 0; m < 4; ++m) _Pragma("unroll") for (int k = 0; k < 2; ++k) dst[m][k] = *(const PG8_LAS bf16x8*)(lds + PG8_SA(b, h) + aoff + m * 2048 + k * 1024); } while (0)
#define PG8_LDB(dst, b, h) do { _Pragma("unroll") for (int n = 0; n < 2; ++n) _Pragma("unroll") for (int k = 0; k < 2; ++k) dst[n][k] = *(const PG8_LAS bf16x8*)(lds + PG8_SB(b, h) + boff + n * 2048 + k * 1024); } while (0)
#define PG8_MMA(ai, bj, At, Bt) do { __builtin_amdgcn_s_setprio(1); _Pragma("unroll") for (int m = 0; m < 4; ++m) _Pragma("unroll") for (int n = 0; n < 2; ++n) _Pragma("unroll") for (int k = 0; k < 2; ++k) \
        acc[ai][bj][m][n] = __builtin_amdgcn_mfma_f32_16x16x32_bf16(Bt[n][k], At[m][k], acc[ai][bj][m][n], 0, 0, 0); __builtin_amdgcn_s_setprio(0); } while (0)
#define PG8_WAIT_V(n) asm volatile("s_waitcnt vmcnt(" #n ")" ::: "memory")
#define PG8_WAIT_L(n) asm volatile("s_waitcnt lgkmcnt(" #n ")" ::: "memory")
#define PG8_BAR __builtin_amdgcn_s_barrier()
#define PG8_SCHED __builtin_amdgcn_sched_barrier(0)
    Unit cur, nxt; int ui = 0;
    if (!S.next(0, cur)) return;
    f32x4 acc[2][2][4][2];
#pragma unroll
    for (int a = 0; a < 2; ++a)
#pragma unroll
        for (int b = 0; b < 2; ++b)
#pragma unroll
            for (int m = 0; m < 4; ++m)
#pragma unroll
                for (int n = 0; n < 2; ++n) acc[a][b][m][n] = (f32x4){0.f, 0.f, 0.f, 0.f};
    bf16x8 At[4][2], B0[2][2], B1[2][2];
    const char* cA = (const char*)g.A + (size_t)cur.pm * tstep; const char* cB = (const char*)g.Bt + (size_t)cur.pn * tstep;
    S.a_ready(cur);
    if constexpr (SP2) {
        PG8_STAGE(PG8_SB(0, 0), cB, voffB); PG8_STAGE(PG8_SB(0, 1), cB + hstep, voffB); PG8_STAGE(PG8_SA(0, 0), cA, voffA); PG8_STAGE(PG8_SA(0, 1), cA + hstep, voffA);
        if (wr == 1) PG8_BAR;
        PG8_WAIT_V(2); PG8_BAR;
        PG8_STAGE(PG8_SB(1, 0), cB + kstep, voffB); PG8_STAGE(PG8_SA(1, 0), cA + kstep, voffA); PG8_STAGE(PG8_SB(1, 1), cB + hstep + kstep, voffB);
        PG8_WAIT_V(6); PG8_BAR;
    } else {
        PG8_STAGE(PG8_SB(0, 0), cB, voffB); PG8_STAGE(PG8_SA(0, 0), cA, voffA); PG8_STAGE(PG8_SB(0, 1), cB + hstep, voffB); PG8_STAGE(PG8_SA(0, 1), cA + hstep, voffA);
        if (wr == 1) PG8_BAR;
        PG8_WAIT_V(4); PG8_BAR;
        PG8_STAGE(PG8_SB(1, 0), cB + kstep, voffB); PG8_STAGE(PG8_SA(1, 0), cA + kstep, voffA); PG8_STAGE(PG8_SB(1, 1), cB + hstep + kstep, voffB);
        PG8_WAIT_V(6); PG8_BAR;
    }
    for (;;) {
        const bool has_next = S.next(ui + 1, nxt);
        const char* nA = has_next ? (const char*)g.A + (size_t)nxt.pm * tstep : cA; const char* nB = has_next ? (const char*)g.Bt + (size_t)nxt.pn * tstep : cB;
        for (int t = 0; t < nt; t += 2) {
            const bool last = (t == nt - 2);
            const char* a1 = cA + (size_t)(t + 1) * kstep;
            const char* a2 = last ? nA : cA + (size_t)(t + 2) * kstep; const char* b2 = last ? nB : cB + (size_t)(t + 2) * kstep;
            const char* a3 = a2 + kstep; const char* b3 = b2 + kstep;
            if (last && has_next) S.a_ready(nxt);
            if constexpr (Epi::HAS_MID) { if (t != 0 && (t & (Epi::MID_EVERY - 1)) == 0) E.mid(acc, cur, t / Epi::MID_EVERY, wr, wc, fr, fq); }
            if constexpr (SP2) {
            PG8_LDB(B0, 0, 0); PG8_LDB(B1, 0, 1); PG8_SCHED; PG8_LDA(At, 0, 0); PG8_STAGE(PG8_SA(1, 1), a1 + hstep, voffA);
            PG8_WAIT_V(8); PG8_WAIT_L(0); PG8_BAR; PG8_MMA(0, 0, At, B0); PG8_MMA(0, 1, At, B1); PG8_BAR; PG8_SCHED;
            PG8_LDA(At, 0, 1); PG8_STAGE(PG8_SB(0, 0), b2, voffB); PG8_STAGE(PG8_SB(0, 1), b2 + hstep, voffB); PG8_STAGE(PG8_SA(0, 0), a2, voffA);
            PG8_WAIT_V(8); PG8_WAIT_L(0); PG8_BAR; PG8_MMA(1, 0, At, B0); PG8_MMA(1, 1, At, B1); PG8_BAR; PG8_SCHED;
            PG8_LDB(B0, 1, 0); PG8_LDB(B1, 1, 1); PG8_SCHED; PG8_LDA(At, 1, 0); PG8_STAGE(PG8_SA(0, 1), a2 + hstep, voffA);
            PG8_WAIT_V(8); PG8_WAIT_L(0); PG8_BAR; PG8_MMA(0, 0, At, B0); PG8_MMA(0, 1, At, B1); PG8_BAR; PG8_SCHED;
            PG8_LDA(At, 1, 1); PG8_STAGE(PG8_SB(1, 0), b3, voffB); PG8_STAGE(PG8_SB(1, 1), b3 + hstep, voffB); PG8_STAGE(PG8_SA(1, 0), a3, voffA);
            PG8_WAIT_V(8); PG8_WAIT_L(0); PG8_BAR; PG8_MMA(1, 0, At, B0); PG8_MMA(1, 1, At, B1); PG8_BAR; PG8_SCHED;
            } else {
            PG8_LDB(B0, 0, 0); PG8_SCHED; PG8_LDA(At, 0, 0); PG8_STAGE(PG8_SA(1, 1), a1 + hstep, voffA);
            PG8_WAIT_L(8); PG8_BAR; PG8_WAIT_L(0); PG8_MMA(0, 0, At, B0); PG8_BAR; PG8_SCHED;
            PG8_LDB(B1, 0, 1); PG8_STAGE(PG8_SB(0, 0), b2, voffB);
            PG8_BAR; PG8_WAIT_L(0); PG8_MMA(0, 1, At, B1); PG8_BAR;
            PG8_LDA(At, 0, 1); PG8_STAGE(PG8_SA(0, 0), a2, voffA);
            PG8_BAR; PG8_WAIT_L(0); PG8_MMA(1, 0, At, B0); PG8_BAR; PG8_SCHED;
            PG8_STAGE(PG8_SB(0, 1), b2 + hstep, voffB);
            PG8_WAIT_V(6); PG8_BAR; PG8_MMA(1, 1, At, B1); PG8_BAR;
            PG8_LDB(B0, 1, 0); PG8_SCHED; PG8_LDA(At, 1, 0); PG8_STAGE(PG8_SA(0, 1), a2 + hstep, voffA);
            PG8_WAIT_L(8); PG8_BAR; PG8_WAIT_L(0); PG8_MMA(0, 0, At, B0); PG8_BAR; PG8_SCHED;
            PG8_LDB(B1, 1, 1); PG8_STAGE(PG8_SB(1, 0), b3, voffB);
            PG8_BAR; PG8_WAIT_L(0); PG8_MMA(0, 1, At, B1); PG8_BAR;
            PG8_LDA(At, 1, 1); PG8_STAGE(PG8_SA(1, 0), a3, voffA);
            PG8_BAR; PG8_WAIT_L(0); PG8_MMA(1, 0, At, B0); PG8_BAR; PG8_SCHED;
            PG8_STAGE(PG8_SB(1, 1), b3 + hstep, voffB);
            PG8_WAIT_V(6); PG8_BAR; PG8_MMA(1, 1, At, B1); PG8_BAR;
            }
        }
        if constexpr (ALIGN_EPI) { if (wr == 0) PG8_BAR; }
        if constexpr (!Epi::AFTER_DRAIN) { E(acc, cur, wr, wc, fr, fq); S.done(cur); }
        if (!has_next) break;
#pragma unroll
        for (int a = 0; a < 2; ++a)
#pragma unroll
            for (int b = 0; b < 2; ++b)
#pragma unroll
                for (int m = 0; m < 4; ++m)
#pragma unroll
                    for (int n = 0; n < 2; ++n) acc[a][b][m][n] = (f32x4){0.f, 0.f, 0.f, 0.f};
        cur = nxt; cA = nA; cB = nB; ++ui;
        if constexpr (ALIGN_EPI) { if (wr == 1) PG8_BAR; }
    }
    PG8_WAIT_V(0);
    if constexpr (!ALIGN_EPI) { if (wr == 0) PG8_BAR; }
    PG8_BAR;
    if constexpr (Epi::AFTER_DRAIN) { E.fused(acc, cur, wr, wc, fr, fq, lds, wid, lane); S.done(cur); }
#undef PG8_SA
#undef PG8_SB
#undef PG8_STAGE
#undef PG8_LDA
#undef PG8_LDB
#undef PG8_MMA
#undef PG8_WAIT_V
#undef PG8_WAIT_L
#undef PG8_BAR
#undef PG8_SCHED
}
}

typedef unsigned short bf16_t;
typedef unsigned u32x4 __attribute__((ext_vector_type(4)));
typedef unsigned u32x2 __attribute__((ext_vector_type(2)));
typedef float f32x4 __attribute__((ext_vector_type(4)));
#define LAS __attribute__((address_space(3)))
#define GAS __attribute__((address_space(1)))
typedef GAS unsigned gu32;
#define RLX_AGENT __ATOMIC_RELAXED, __HIP_MEMORY_SCOPE_AGENT
#define WFENCE() asm volatile("s_waitcnt lgkmcnt(0)" ::: "memory")
using namespace cfg;

__device__ __forceinline__ float bf2f(unsigned short b) { return __uint_as_float(((unsigned)b) << 16); }
__device__ __forceinline__ float bflo(unsigned w) { return __uint_as_float(w << 16); }
__device__ __forceinline__ float bfhi(unsigned w) { return __uint_as_float(w & 0xffff0000u); }
__device__ __forceinline__ unsigned f2bf(float f) { unsigned u = __float_as_uint(f); return (u + 0x7fffu + ((u >> 16) & 1u)) >> 16; }
__device__ __forceinline__ unsigned pk2(float lo, float hi) { return f2bf(lo) | (f2bf(hi) << 16); }
__device__ __forceinline__ float wave_sum(float v) {
#pragma unroll
    for (int o = 1; o < 64; o <<= 1) v += __shfl_xor(v, o);
    return v;
}
__device__ __forceinline__ float wave_max(float v) {
#pragma unroll
    for (int o = 1; o < 64; o <<= 1) v = fmaxf(v, __shfl_xor(v, o));
    return v;
}

constexpr size_t MiB = 1u << 20;
constexpr size_t WS_CTL = 0, CTL_ZERO_BYTES = 1 * MiB;
constexpr int CW_BAR = 4096, CW_Q = 2048, CW_CONV = 3072;
constexpr size_t CTL_SS1 = 512 * 1024, CTL_SS2 = 512 * 1024 + 65536;
constexpr size_t SZ_WIN = (size_t)NC * DM * 2, SZ_WMEM = (size_t)2048 * DM * 2, SZ_WBR = (size_t)4 * DM * BW * 2, SZ_WOUT = (size_t)DM * DM * 2;
constexpr size_t WS_WIN = 1 * MiB, WS_WMEM = WS_WIN + 2 * SZ_WIN, WS_WBR = WS_WMEM + 2 * SZ_WMEM, WS_WOUT = WS_WBR + 2 * SZ_WBR;
constexpr size_t WS_XB = WS_WOUT + 2 * SZ_WOUT, WS_X1 = WS_XB + (size_t)MT * DM * 2, WS_X2 = WS_X1 + (size_t)MT * DM * 4, WS_SS0 = WS_X2 + (size_t)MT * DM * 4;
constexpr size_t WS_MEMB = WS_SS0 + 65536, WS_MEMSS = WS_MEMB + (size_t)MEMR * DM * 2, WS_MKV = WS_MEMSS + 65536, WS_PROJ = WS_MKV + 2 * (size_t)MEMR * 2048 * 2;
constexpr size_t WS_KMEAN = WS_PROJ + (size_t)MT * NC * 2, WS_Y = WS_KMEAN + 2 * 256 * 128 * 4, WS_BSCR = WS_Y + (size_t)4 * MT * BW * 2, WS_VN = WS_BSCR + (size_t)MT * 2048 * 4;
constexpr size_t WS_T = WS_VN + (size_t)MT * BW * 4, WS_G8 = WS_T  , WS_MERGED = WS_T + (size_t)MT * DM * 4, WS_MVT = WS_MERGED + (size_t)MT * DM * 2, WS_STATS = WS_MVT + 2 * (size_t)MEMR * 1024 * 2, WS_KN = WS_STATS + (size_t)MT * 16 * 8, WS_END = WS_KN + 4 * 1024 * 4;

constexpr int NWAVES = 8;
constexpr int YS = 4 * BW;
constexpr int RING_BYTES = 131072;
constexpr int LDSCTL_OFF = RING_BYTES, MISC_OFF = LDSCTL_OFF + 320;
constexpr int LDS_BYTES = 147456;
static_assert(MISC_OFF + 128 <= LDS_BYTES, "LDS map");

struct TPItem { const float* W; const float* g; bf16_t* WT; int K, N, idx, nt; };
__device__ __forceinline__ void tp_load(const TPItem& t, f32x4 (&v)[16], float2 (&gv)[8], int lane) {
    const int nblk = t.N / 64, kb = t.idx / nblk, nb = t.idx - kb * nblk, kq = lane >> 4, p = lane & 15;
    const GAS float* src = (const GAS float*)(t.W + (size_t)(64 * kb + 2 * kq) * t.N + 64 * nb + 4 * p); const size_t s1 = (size_t)t.N, s7 = (size_t)7 * t.N;
#pragma unroll
    for (int i = 0; i < 16; ++i) { v[i] = __builtin_nontemporal_load((const GAS f32x4*)src); src += (i & 1) ? s7 : s1; asm volatile("" : "+v"(src)); }
    if (t.g) {
#pragma unroll
        for (int ii = 0; ii < 8; ++ii) gv[ii] = *(const float2*)(t.g + 64 * kb + 2 * kq + 8 * ii);
    } else {
#pragma unroll
        for (int ii = 0; ii < 8; ++ii) gv[ii] = make_float2(1.0f, 1.0f);
    }
    asm volatile("" ::: "memory");
}
__device__ __forceinline__ void tp_store(const TPItem& t, const f32x4 (&v)[16], const float2 (&gv)[8], LAS unsigned char* scr, int lane) {
    const int nblk = t.N / 64, kb = t.idx / nblk, nb = t.idx - kb * nblk, k0 = 64 * kb, n0 = 64 * nb, kq = lane >> 4, p = lane & 15;
#pragma unroll
    for (int ii = 0; ii < 8; ++ii) { const float sa = gv[ii].x, sb = gv[ii].y;
#pragma unroll
        for (int j = 0; j < 4; ++j) { const int n = 4 * p + j;
            *(LAS unsigned*)(scr + n * 128 + (((ii ^ (p & 7)) << 4) | (kq << 2))) = pg8::cvt_pk_bf16(v[2 * ii][j] * sa, v[2 * ii + 1][j] * sb); } }
    WFENCE();
    const int c = lane & 7;
    GAS bf16_t* dst = (GAS bf16_t*)(t.WT + (size_t)(n0 + (lane >> 3)) * t.K + k0 + 8 * c); const size_t dstep = (size_t)8 * t.K;
#pragma unroll
    for (int j = 0; j < 8; ++j) { const int n = (lane >> 3) + 8 * j; const u32x4 o = *(LAS const u32x4*)(scr + n * 128 + ((c ^ ((n >> 2) & 7)) << 4));
        if (t.nt) __builtin_nontemporal_store(o, (GAS u32x4*)dst); else *(GAS u32x4*)dst = o;
        dst += dstep; asm volatile("" : "+v"(dst)); }
    WFENCE();
}
__device__ __forceinline__ void row_item(const float* x, bf16_t* xb, float* ss, int r, int lane) {
    const f32x4* xr = (const f32x4*)(x + (size_t)r * DM) + lane; u32x2* o = (u32x2*)(xb + (size_t)r * DM) + lane; float s = 0.f;
    f32x4 v[16];
#pragma unroll
    for (int j = 0; j < 16; ++j) v[j] = xr[64 * j];
    asm volatile("" ::: "memory");
#pragma unroll
    for (int j = 0; j < 16; ++j) { s += (v[j][0] * v[j][0] + v[j][1] * v[j][1]) + (v[j][2] * v[j][2] + v[j][3] * v[j][3]); u32x2 w; w.x = pk2(v[j][0], v[j][1]); w.y = pk2(v[j][2], v[j][3]); o[64 * j] = w; }
    s = wave_sum(s); if (lane == 0) ss[r] = s;
}

__device__ __forceinline__ float dot8(const u32x4 kk, const LAS float* q) {
    return bflo(kk.x) * q[0] + bfhi(kk.x) * q[1] + bflo(kk.y) * q[2] + bfhi(kk.y) * q[3] + bflo(kk.z) * q[4] + bfhi(kk.z) * q[5] + bflo(kk.w) * q[6] + bfhi(kk.w) * q[7];
}
__device__ __forceinline__ void kmean_task(const bf16_t* proj, float* kmean, int id, int lane) {
    const int n = id & 7, h = (id >> 3) & 7, b = id >> 6, rg = lane >> 4, c8 = lane & 15;
    const bf16_t* p = proj + (size_t)(b * SEQ + n * 256 + rg) * NC + C_KA + h * 128 + c8 * 8; float s[8] = {0.f, 0.f, 0.f, 0.f, 0.f, 0.f, 0.f, 0.f};
#pragma unroll
    for (int q = 0; q < 4; ++q) { u32x4 w[16];
#pragma unroll
        for (int i = 0; i < 16; ++i) w[i] = *(const u32x4*)(p + (size_t)(4 * (q * 16 + i)) * NC);
        asm volatile("" ::: "memory");
#pragma unroll
        for (int i = 0; i < 16; ++i) { s[0] += bflo(w[i].x); s[1] += bfhi(w[i].x); s[2] += bflo(w[i].y); s[3] += bfhi(w[i].y); s[4] += bflo(w[i].z); s[5] += bfhi(w[i].z); s[6] += bflo(w[i].w); s[7] += bfhi(w[i].w); } }
#pragma unroll
    for (int j = 0; j < 8; ++j) { s[j] += __shfl_xor(s[j], 16); s[j] += __shfl_xor(s[j], 32); }
    if (lane < 16) { float* o = kmean + (size_t)id * 128 + c8 * 8; *(f32x4*)o = (f32x4){s[0], s[1], s[2], s[3]} * (1.0f / 256.0f); *(f32x4*)(o + 4) = (f32x4){s[4], s[5], s[6], s[7]} * (1.0f / 256.0f); }
}
__device__ __forceinline__ void knorm_task(const bf16_t* proj, float* kn, int id, int lane) {
    const int tile = id & 31, mp = (id >> 5) & 1, h = (id >> 6) & 3, b = id >> 8;
    const bf16_t* p = proj + (size_t)(b * SEQ + tile * 64 + lane) * NC + C_KB + h * 256 + mp * 128; float s = 0.f;
    { u32x4 w[16];
#pragma unroll
      for (int i = 0; i < 16; ++i) w[i] = *(const u32x4*)(p + 8 * i);
      asm volatile("" ::: "memory");
#pragma unroll
      for (int i = 0; i < 16; ++i) s += (bflo(w[i].x) * bflo(w[i].x) + bfhi(w[i].x) * bfhi(w[i].x)) + (bflo(w[i].y) * bflo(w[i].y) + bfhi(w[i].y) * bfhi(w[i].y)) + (bflo(w[i].z) * bflo(w[i].z) + bfhi(w[i].z) * bfhi(w[i].z)) + (bflo(w[i].w) * bflo(w[i].w) + bfhi(w[i].w) * bfhi(w[i].w)); }
    s = wave_max(s);
    if (lane == 0) kn[id] = sqrtf(s) * 1.0001f;
}
__device__ __forceinline__ void sgu_stats_task(const bf16_t* proj, float* stats, int bt, int lane) {
    const u32x4 a = *(const u32x4*)(proj + (size_t)bt * NC + C_VC + lane * 8), b = *(const u32x4*)(proj + (size_t)bt * NC + C_VC + 512 + lane * 8);
    float v[16] = {bflo(a.x), bfhi(a.x), bflo(a.y), bfhi(a.y), bflo(a.z), bfhi(a.z), bflo(a.w), bfhi(a.w), bflo(b.x), bfhi(b.x), bflo(b.y), bfhi(b.y), bflo(b.z), bfhi(b.z), bflo(b.w), bfhi(b.w)};
    float s = 0.f;
#pragma unroll
    for (int i = 0; i < 16; ++i) s += v[i];
    const float mu = wave_sum(s) * (1.0f / 1024.0f); float q = 0.f;
#pragma unroll
    for (int i = 0; i < 16; ++i) { const float d = v[i] - mu; q += d * d; }
    const float rstd = 1.0f / sqrtf(wave_sum(q) * (1.0f / 1024.0f) + LN_EPS);
    if (lane == 0) { stats[2 * bt] = mu; stats[2 * bt + 1] = rstd; }
}
__device__ __forceinline__ void moba_task(const bf16_t* proj, const float* kmean, bf16_t* Y0, int id, int lane, LAS float* wl) {
    LAS float* qs = wl; LAS float* sc = wl + 128;
    const int h = id & 7, bt = id >> 3, b = bt >> 11, t = bt & 2047, j = t >> 8;
    const unsigned qq = *(const unsigned*)(proj + (size_t)bt * NC + C_QA + h * 128 + 2 * lane);
    const float q0 = bflo(qq), q1 = bfhi(qq);
    qs[2 * lane] = q0; qs[2 * lane + 1] = q1;
    float g[8];
#pragma unroll
    for (int n = 0; n < 8; ++n) { const float* km = kmean + (size_t)((b * 8 + h) * 8 + n) * 128; g[n] = wave_sum(q0 * km[2 * lane] + q1 * km[2 * lane + 1]); }
    unsigned sel = 0;
#pragma unroll
    for (int n = 0; n < 8; ++n) { int rank = 0;
#pragma unroll
        for (int m = 0; m < 8; ++m) if (m != n) rank += (m < j && (g[m] > g[n] || (g[m] == g[n] && m < n))) ? 1 : 0;
        if (n < j && rank < 3) sel |= 1u << n; }
    sel |= 1u << j;
    WFENCE();
    const float scale = 0.08838834764831845f, slope = exp2f(-8.0f * (float)(h + 5) / 12.0f);
    float mx = -INFINITY; int nslots = 0;
    for (int n = 0; n <= j; ++n) { if (!((sel >> n) & 1u)) continue;
        for (int c = 0; c < 4; ++c) { const int key = n * 256 + c * 64 + lane; float s = -INFINITY;
            if (key <= t) { const bf16_t* kr = proj + (size_t)(b * SEQ + key) * NC + C_KA + h * 128; float d = 0.f;
#pragma unroll 4
                for (int i = 0; i < 16; ++i) d += dot8(*(const u32x4*)(kr + 8 * i), qs + 8 * i);
                s = d * scale - slope * (float)(t - key); }
            sc[nslots * 256 + c * 64 + lane] = s; mx = fmaxf(mx, s); }
        ++nslots; }
    mx = wave_max(mx);
    WFENCE();
    float l = 0.f;
    for (int i = lane; i < nslots * 256; i += 64) { const float p = __expf(sc[i] - mx); sc[i] = p; l += p; }
    l = wave_sum(l);
    WFENCE();
    float o0 = 0.f, o1 = 0.f; int slot = 0;
    for (int n = 0; n <= j; ++n) { if (!((sel >> n) & 1u)) continue;
        const int kend = (n == j) ? (t - n * 256) : 255;
        const bf16_t* vr = proj + (size_t)(b * SEQ + n * 256) * NC + C_VA + h * 128 + 2 * lane;
        for (int k = 0; k <= kend; ++k) { const float p = sc[slot * 256 + k]; const unsigned vv = *(const unsigned*)(vr + (size_t)k * NC); o0 += p * bflo(vv); o1 += p * bfhi(vv); }
        ++slot; }
    const float inv = 1.0f / l;
    const unsigned zz = *(const unsigned*)(proj + (size_t)bt * NC + C_ZA + h * 128 + 2 * lane);
    *(unsigned*)(Y0 + (size_t)bt * BW + h * 128 + 2 * lane) = pk2(o0 * inv * bflo(zz), o1 * inv * bfhi(zz));
    WFENCE();
}
__device__ __forceinline__ f32x4 diff_task(const bf16_t* proj, int id, int lane, LAS float* wl) {
    LAS float* qs = wl; LAS float* sc = wl + 128;
    const int mp = id & 1, h = (id >> 1) & 3, bt = id >> 3, b = bt >> 11, t = bt & 2047;
    const unsigned qq = *(const unsigned*)(proj + (size_t)bt * NC + C_QB + h * 256 + mp * 128 + 2 * lane);
    qs[2 * lane] = bflo(qq); qs[2 * lane + 1] = bfhi(qq);
    WFENCE();
    const float scale = 0.08838834764831845f, slope = exp2f(-8.0f * (float)(h + 1) / 12.0f);
    float mx = -INFINITY; const int nch = t / 64 + 1;
    for (int c = 0; c < nch; ++c) { const int key = c * 64 + lane; float s = -INFINITY;
        if (key <= t) { const bf16_t* kr = proj + (size_t)(b * SEQ + key) * NC + C_KB + h * 256 + mp * 128; float d = 0.f;
#pragma unroll 4
            for (int i = 0; i < 16; ++i) d += dot8(*(const u32x4*)(kr + 8 * i), qs + 8 * i);
            s = d * scale - slope * (float)(t - key); }
        sc[key] = s; mx = fmaxf(mx, s); }
    mx = wave_max(mx);
    WFENCE();
    float l = 0.f;
    for (int i = lane; i < nch * 64; i += 64) { const float p = __expf(sc[i] - mx); sc[i] = p; l += p; }
    l = wave_sum(l);
    WFENCE();
    float o0 = 0.f, o1 = 0.f, o2 = 0.f, o3 = 0.f;
    const bf16_t* vr = proj + (size_t)(b * SEQ) * NC + C_VB + h * 256 + 4 * lane;
    for (int k = 0; k <= t; ++k) { const float p = sc[k]; const u32x2 vv = *(const u32x2*)(vr + (size_t)k * NC);
        o0 += p * bflo(vv.x); o1 += p * bfhi(vv.x); o2 += p * bflo(vv.y); o3 += p * bfhi(vv.y); }
    const float inv = 1.0f / l;
    WFENCE();
    return (f32x4){o0 * inv, o1 * inv, o2 * inv, o3 * inv};
}
__device__ __forceinline__ void diff_combine_task(const float* scr, const bf16_t* proj, float lam, float lam_init, const float* subg, bf16_t* Y1, int id, int lane) {
    const int h = id & 3, bt = id >> 2;
    const f32x4 a = *(const f32x4*)(scr + ((size_t)(bt * 4 + h) * 2 + 0) * 256 + 4 * lane), c = *(const f32x4*)(scr + ((size_t)(bt * 4 + h) * 2 + 1) * 256 + 4 * lane);
    const f32x4 o = a - c * lam;
    const float ms = wave_sum((o[0] * o[0] + o[1] * o[1]) + (o[2] * o[2] + o[3] * o[3])) * (1.0f / 256.0f);
    const float rs = (1.0f / sqrtf(ms + RMS_EPS)) * (1.0f - lam_init);
    const f32x4 gg = *(const f32x4*)(subg + 4 * lane);
    const u32x2 zz = *(const u32x2*)(proj + (size_t)bt * NC + C_ZB + h * 256 + 4 * lane);
    u32x2 w; w.x = pk2(o[0] * rs * gg[0] * bflo(zz.x), o[1] * rs * gg[1] * bfhi(zz.x)); w.y = pk2(o[2] * rs * gg[2] * bflo(zz.y), o[3] * rs * gg[3] * bfhi(zz.y));
    *(u32x2*)(Y1 + (size_t)bt * YS + h * 256 + 4 * lane) = w;
}
__device__ __forceinline__ void sgu_ln_task(const bf16_t* proj, const float* lng, const float* lnb, float* VN, int bt, int lane) {
    float v[16]; float s = 0.f;
#pragma unroll
    for (int i = 0; i < 16; ++i) { v[i] = bf2f(proj[(size_t)bt * NC + C_VC + lane + 64 * i]); s += v[i]; }
    const float mu = wave_sum(s) * (1.0f / 1024.0f); float q = 0.f;
#pragma unroll
    for (int i = 0; i < 16; ++i) { v[i] -= mu; q += v[i] * v[i]; }
    const float rstd = 1.0f / sqrtf(wave_sum(q) * (1.0f / 1024.0f) + LN_EPS);
#pragma unroll
    for (int i = 0; i < 16; ++i) { const int c = lane + 64 * i; VN[(size_t)bt * BW + c] = v[i] * rstd * lng[c] + lnb[c]; }
}
__device__ __forceinline__ void sgu_mix_elem(const bf16_t* proj, const float* VN, const float* sw, const float* sb, bf16_t* Y2, int idx) {
    const int c = idx & 1023, bt = idx >> 10, g = c >> 7, t = bt & 2047, tl = t & 127, r0 = bt - tl;
    const float* wrow = sw + ((size_t)g * 128 + tl) * 128; float acc = 0.f;
    for (int s = 0; s <= tl; ++s) acc += wrow[s] * VN[(size_t)(r0 + s) * BW + c];
    acc += sb[g * 128 + tl];
    const float u = bf2f(proj[(size_t)bt * NC + C_UC + c]), z = bf2f(proj[(size_t)bt * NC + C_ZC + c]);
    Y2[(size_t)bt * BW + c] = (bf16_t)f2bf(u * acc * z);
}
__device__ __forceinline__ void memattn_task(const bf16_t* proj, const bf16_t* mkv, bf16_t* Y3, int id, int lane, LAS float* wl) {
    LAS float* qs = wl; LAS float* sc = wl + 256;
    const int h = id & 3, bt = id >> 2, b = bt >> 11;
    const u32x2 qq = *(const u32x2*)(proj + (size_t)bt * NC + C_QM + h * 256 + 4 * lane);
    qs[4 * lane] = bflo(qq.x); qs[4 * lane + 1] = bfhi(qq.x); qs[4 * lane + 2] = bflo(qq.y); qs[4 * lane + 3] = bfhi(qq.y);
    WFENCE();
    float mx = -INFINITY;
    for (int c = 0; c < 4; ++c) { const int key = c * 64 + lane; const bf16_t* kr = mkv + (size_t)(b * MEML + key) * 2048 + h * 256; float d = 0.f;
#pragma unroll 4
        for (int i = 0; i < 32; ++i) d += dot8(*(const u32x4*)(kr + 8 * i), qs + 8 * i);
        const float s = d * 0.0625f; sc[key] = s; mx = fmaxf(mx, s); }
    mx = wave_max(mx);
    WFENCE();
    float l = 0.f;
    for (int i = lane; i < 256; i += 64) { const float p = __expf(sc[i] - mx); sc[i] = p; l += p; }
    l = wave_sum(l);
    WFENCE();
    float o0 = 0.f, o1 = 0.f, o2 = 0.f, o3 = 0.f;
    const bf16_t* vr = mkv + (size_t)(b * MEML) * 2048 + 1024 + h * 256 + 4 * lane;
    for (int k = 0; k < 256; ++k) { const float p = sc[k]; const u32x2 vv = *(const u32x2*)(vr + (size_t)k * 2048);
        o0 += p * bflo(vv.x); o1 += p * bfhi(vv.x); o2 += p * bflo(vv.y); o3 += p * bfhi(vv.y); }
    const float inv = 1.0f / l;
    const u32x2 zz = *(const u32x2*)(proj + (size_t)bt * NC + C_ZM + h * 256 + 4 * lane);
    u32x2 w; w.x = pk2(o0 * inv * bflo(zz.x), o1 * inv * bfhi(zz.x)); w.y = pk2(o2 * inv * bflo(zz.y), o3 * inv * bfhi(zz.y));
    *(u32x2*)(Y3 + (size_t)bt * BW + h * 256 + 4 * lane) = w;
    WFENCE();
}
__device__ __forceinline__ void final_rows(const bf16_t* x, const float* ss, const float* g, float* out, int r0, int step, int lane) {
    f32x4 gv[16]; u32x4 va[8], vb[8];
#pragma unroll
    for (int j = 0; j < 8; ++j) { gv[2 * j] = ((const f32x4*)g)[2 * (64 * j + lane)]; gv[2 * j + 1] = ((const f32x4*)g)[2 * (64 * j + lane) + 1]; }
    float sa = 0.f, sb = 0.f;
    if (r0 < MT) { sa = ss[r0];
#pragma unroll
        for (int j = 0; j < 8; ++j) va[j] = ((const u32x4*)(x + (size_t)r0 * DM))[64 * j + lane]; }
    asm volatile("" ::: "memory");
#define FIN_STORE(V, S, R) do { const float rs = __builtin_amdgcn_rsqf((S) * (1.0f / DM) + RMS_EPS); f32x4* o = (f32x4*)(out + (size_t)(R) * DM); \
        _Pragma("unroll") for (int j = 0; j < 8; ++j) { \
            o[2 * (64 * j + lane)]     = (f32x4){bflo(V[j].x), bfhi(V[j].x), bflo(V[j].y), bfhi(V[j].y)} * rs * gv[2 * j]; \
            o[2 * (64 * j + lane) + 1] = (f32x4){bflo(V[j].z), bfhi(V[j].z), bflo(V[j].w), bfhi(V[j].w)} * rs * gv[2 * j + 1]; } } while (0)
    for (int r = r0; r < MT; r += 2 * step) {
        const int r1 = r + step, r2 = r + 2 * step;
        if (r1 < MT) { sb = ss[r1];
#pragma unroll
            for (int j = 0; j < 8; ++j) vb[j] = ((const u32x4*)(x + (size_t)r1 * DM))[64 * j + lane]; }
        asm volatile("" ::: "memory");
        FIN_STORE(va, sa, r);
        if (r1 >= MT) break;
        if (r2 < MT) { sa = ss[r2];
#pragma unroll
            for (int j = 0; j < 8; ++j) va[j] = ((const u32x4*)(x + (size_t)r2 * DM))[64 * j + lane]; }
        asm volatile("" ::: "memory");
        FIN_STORE(vb, sb, r1);
    }
#undef FIN_STORE
}

namespace att {
typedef short bf16x8 __attribute__((ext_vector_type(8)));
typedef short s16x4 __attribute__((ext_vector_type(4)));
typedef float f32x16 __attribute__((ext_vector_type(16)));
typedef short v4i16_t __attribute__((ext_vector_type(4)));
constexpr int KVBLK = 64, QBLK = 32, SHM_V = KVBLK * 128 * 2, SHM_K = KVBLK * 128 * 2;
constexpr int OFF_K = 2 * SHM_V, OFF_WS = 2 * SHM_V + 2 * SHM_K, OFF_KM = OFF_WS + 8 * 64 * 4, LDS_NEED = OFF_KM + 8 * 128 * 4;
constexpr float LOG2E = 1.4426950408889634f, SCALE = 0.08838834764831845f, CS = SCALE * LOG2E, THRL = 8.0f * LOG2E;
#define ATT_KSWZ(row, colB) ((row) * 256 + ((colB) ^ (((row) & 7) << 4)))
#define ATT_SBAR() __builtin_amdgcn_sched_barrier(0)
__device__ __forceinline__ int crow(int r, int hi) { return (r & 3) + 8 * (r >> 2) + 4 * hi; }
__device__ __forceinline__ unsigned cvtpk(float lo, float hi) { return pg8::cvt_pk_bf16(lo, hi); }
__device__ __forceinline__ int v_st(int k, int c) { const int kk = (k & ~0xC) | ((k & 4) << 1) | ((k & 8) >> 1); return ((kk >> 3) * 4 + (c >> 5)) * 512 + ((kk & 7) * 32 + (c & 31)) * 2; }
__device__ __forceinline__ int v_rd_base(int lane) { return ((lane & 3) << 3) | (((lane >> 2) & 3) << 6) | (((lane >> 4) & 1) << 5) | (((lane >> 5) & 1) << 8); }
constexpr int v_rd_off(int d0, int ks, int half) { return d0 * 512 + ks * 4096 + half * 2048; }
__device__ __forceinline__ s16x4 tr_read(LAS const unsigned char* p) { return __builtin_bit_cast(s16x4, __builtin_amdgcn_ds_read_tr16_b64_v4i16((LAS v4i16_t*)p)); }

__device__ __forceinline__ void qkt(f32x16& p0, f32x16& p1, LAS const unsigned char* Ks, const bf16x8* qr, int r32, int hi) {
    p0 = f32x16{}; p1 = f32x16{};
#pragma unroll
    for (int d0 = 0; d0 < 8; ++d0) { const int cb = (d0 * 16 + hi * 8) * 2;
        const bf16x8 b0 = *(LAS const bf16x8*)(Ks + ATT_KSWZ(r32, cb));
        const bf16x8 b1 = *(LAS const bf16x8*)(Ks + ATT_KSWZ(32 + r32, cb));
        p0 = __builtin_amdgcn_mfma_f32_32x32x16_bf16(b0, qr[d0], p0, 0, 0, 0);
        p1 = __builtin_amdgcn_mfma_f32_32x32x16_bf16(b1, qr[d0], p1, 0, 0, 0); }
}
__device__ __forceinline__ void partialSM(f32x16& p0, f32x16& p1, float& m_reg, float& mn, float& alpha, int dq, float slopeL, bool diag, bool rowmasked) {
    const float NEG = -__builtin_inff(); const float a0 = -slopeL * (float)dq;
#pragma unroll
    for (int r = 0; r < 16; ++r) { const int c = (r & 3) + 8 * (r >> 2);
        p0[r] = fmaf(p0[r], CS, fmaf(slopeL, (float)c, a0)); p1[r] = fmaf(p1[r], CS, fmaf(slopeL, (float)(c + 32), a0)); }
    if (diag) { asm volatile("" ::: "memory");
#pragma unroll
        for (int r = 0; r < 16; ++r) { const int c = (r & 3) + 8 * (r >> 2); if (c > dq) p0[r] = NEG; if (c + 32 > dq) p1[r] = NEG; } }
    if (rowmasked) {
#pragma unroll
        for (int r = 0; r < 16; ++r) { p0[r] = NEG; p1[r] = NEG; } }
    float pmax = p0[0];
#pragma unroll
    for (int r = 1; r < 16; ++r) pmax = fmaxf(pmax, p0[r]);
#pragma unroll
    for (int r = 0; r < 16; ++r) pmax = fmaxf(pmax, p1[r]);
    { auto rr = __builtin_amdgcn_permlane32_swap(__float_as_uint(pmax), __float_as_uint(pmax), false, false);
      pmax = fmaxf(__uint_as_float(rr[0]), __uint_as_float(rr[1])); }
    if (__builtin_expect(__all(pmax - m_reg <= THRL), 1)) { mn = m_reg; alpha = 1.f; }
    else { mn = fmaxf(m_reg, pmax); alpha = __builtin_amdgcn_exp2f(m_reg - mn); m_reg = mn; }
#pragma unroll
    for (int r = 0; r < 16; ++r) { p0[r] = p0[r] - mn; p1[r] = p1[r] - mn; }
#pragma unroll
    for (int r = 0; r < 16; ++r) p0[r] = __builtin_amdgcn_exp2f(p0[r]);
}
__device__ __forceinline__ void finishSM(f32x16& p0, f32x16& p1, float alpha, float& l_reg, bf16x8& pa0, bf16x8& pa1, bf16x8& pa2, bf16x8& pa3) {
#pragma unroll
    for (int r = 0; r < 16; ++r) p1[r] = __builtin_amdgcn_exp2f(p1[r]);
    float ps = 0;
#pragma unroll
    for (int r = 0; r < 16; ++r) ps += p0[r];
#pragma unroll
    for (int r = 0; r < 16; ++r) ps += p1[r];
    { auto rr = __builtin_amdgcn_permlane32_swap(__float_as_uint(ps), __float_as_uint(ps), false, false);
      ps = __uint_as_float(rr[0]) + __uint_as_float(rr[1]); }
    l_reg = l_reg * alpha + ps;
#define ATT_PK4(P, BASE, OUT) do { const unsigned a0_ = cvtpk(P[BASE + 0], P[BASE + 1]), a1_ = cvtpk(P[BASE + 2], P[BASE + 3]);   \
    const unsigned b0_ = cvtpk(P[BASE + 4], P[BASE + 5]), b1_ = cvtpk(P[BASE + 6], P[BASE + 7]);                              \
    auto r0_ = __builtin_amdgcn_permlane32_swap(a0_, b0_, false, false); auto r1_ = __builtin_amdgcn_permlane32_swap(a1_, b1_, false, false); \
    u32x4 w_ = {r0_[0], r1_[0], r0_[1], r1_[1]}; OUT = __builtin_bit_cast(bf16x8, w_); } while (0)
    ATT_PK4(p0, 0, pa0); ATT_PK4(p0, 8, pa1); ATT_PK4(p1, 0, pa2); ATT_PK4(p1, 8, pa3);
#undef ATT_PK4
}
template <int D0> __device__ __forceinline__ void pv_one(f32x16& od, LAS const unsigned char* vb, bf16x8 pa0, bf16x8 pa1, bf16x8 pa2, bf16x8 pa3) {
    const s16x4 l0 = tr_read(vb + v_rd_off(D0, 0, 0)), h0 = tr_read(vb + v_rd_off(D0, 0, 1)), l1 = tr_read(vb + v_rd_off(D0, 1, 0)), h1 = tr_read(vb + v_rd_off(D0, 1, 1));
    const s16x4 l2 = tr_read(vb + v_rd_off(D0, 2, 0)), h2 = tr_read(vb + v_rd_off(D0, 2, 1)), l3 = tr_read(vb + v_rd_off(D0, 3, 0)), h3 = tr_read(vb + v_rd_off(D0, 3, 1));
#define ATT_PK(L, H) (bf16x8){L[0], L[1], L[2], L[3], H[0], H[1], H[2], H[3]}
    od = __builtin_amdgcn_mfma_f32_32x32x16_bf16(pa0, ATT_PK(l0, h0), od, 0, 0, 0);
    od = __builtin_amdgcn_mfma_f32_32x32x16_bf16(pa1, ATT_PK(l1, h1), od, 0, 0, 0);
    od = __builtin_amdgcn_mfma_f32_32x32x16_bf16(pa2, ATT_PK(l2, h2), od, 0, 0, 0);
    od = __builtin_amdgcn_mfma_f32_32x32x16_bf16(pa3, ATT_PK(l3, h3), od, 0, 0, 0);
#undef ATT_PK
}
__device__ __forceinline__ void pv_d0(f32x16* o, LAS const unsigned char* vb, bf16x8 pa0, bf16x8 pa1, bf16x8 pa2, bf16x8 pa3) {
    pv_one<0>(o[0], vb, pa0, pa1, pa2, pa3); pv_one<1>(o[1], vb, pa0, pa1, pa2, pa3); pv_one<2>(o[2], vb, pa0, pa1, pa2, pa3); pv_one<3>(o[3], vb, pa0, pa1, pa2, pa3);
}

__device__ __forceinline__ float knt(const float* kn2, int t) { const f32x4 p = *(const f32x4*)(kn2 + 4 * t); return sqrtf((p[0] + p[1]) + (p[2] + p[3])) * 1.005f; }
struct UnitDesc {
    const bf16_t* Q;
    const bf16_t* K;
    const bf16_t* V;
    int q0;
    int nt;
    float slopeL;
    int moba_j;
    const float* kmean;
    int kt0_in; LAS unsigned* kt0_out;
    const float* knorm;
};
template <bool MOBA>
__device__ __forceinline__ void run_unit(const UnitDesc& U, LAS unsigned char* lds, f32x16 (&o)[4], float (&rli)[16]) {
    int tid_l = threadIdx.x; asm volatile("" : "+v"(tid_l));
    const int tid = tid_l, wid = __builtin_amdgcn_readfirstlane(tid >> 6), lane = tid & 63, r32 = lane & 31, hi = lane >> 5;
    LAS unsigned char* V_lds = lds; LAS unsigned char* K_lds = lds + OFF_K;
    LAS float* wsf = (LAS float*)(lds + OFF_WS) + wid * 64; LAS float* li_l = wsf; LAS float* al_l = wsf + 32;
    float m_reg = -1e30f, l_reg = 0.f; bf16x8 qr[8];
#pragma unroll
    for (int d = 0; d < 4; ++d) o[d] = f32x16{};
    const bf16_t* Qw = U.Q + (size_t)(wid * QBLK + r32) * NC + hi * 8;
#pragma unroll
    for (int d0 = 0; d0 < 8; ++d0) qr[d0] = *(const bf16x8*)(Qw + d0 * 16);
    int qpos = U.q0 + wid * QBLK + r32, qlo = U.q0 + wid * QBLK;
    unsigned sel = 0xffffffffu;
    if (MOBA && U.moba_j > 3) {
        const int j = U.moba_j; LAS float* km = (LAS float*)(lds + OFF_KM);
        for (int i = tid; i < j * 128; i += 512) { const float* kp = U.kmean + (i >> 7) * 256 + (i & 127); km[i] = kp[0] + kp[128]; }
        __syncthreads();
        float g[8];
#pragma unroll
        for (int n = 0; n < 8; ++n) { g[n] = 0.f;
            if (n < j) { float s = 0.f;
#pragma unroll
                for (int d0 = 0; d0 < 8; ++d0) { const LAS float* kp = km + n * 128 + d0 * 16 + hi * 8; const f32x4 k0 = *(LAS const f32x4*)kp, k1 = *(LAS const f32x4*)(kp + 4);
                    const u32x4 qq = __builtin_bit_cast(u32x4, qr[d0]);
                    s += bflo(qq.x) * k0[0] + bfhi(qq.x) * k0[1] + bflo(qq.y) * k0[2] + bfhi(qq.y) * k0[3] + bflo(qq.z) * k1[0] + bfhi(qq.z) * k1[1] + bflo(qq.w) * k1[2] + bfhi(qq.w) * k1[3]; }
                auto rr = __builtin_amdgcn_permlane32_swap(__float_as_uint(s), __float_as_uint(s), false, false);
                g[n] = __uint_as_float(rr[0]) + __uint_as_float(rr[1]); } }
        sel = 0u;
#pragma unroll
        for (int n = 0; n < 8; ++n) { int rank = 0;
#pragma unroll
            for (int m = 0; m < 8; ++m) if (m != n) rank += (m < j && (g[m] > g[n] || (g[m] == g[n] && m < n))) ? 1 : 0;
            if (n < j && rank < 3) sel |= 1u << n; }
        sel |= 1u << j;
        __syncthreads();
    }
    int kt0 = 0;
    if (!MOBA && U.knorm != nullptr && U.kt0_in >= 0) kt0 = U.kt0_in;
    else if (!MOBA && U.knorm != nullptr) {
        LAS float* wm = (LAS float*)(lds + OFF_KM); LAS int* tmin = (LAS int*)(lds + OFF_KM + 64);
        float q2 = 0.f;
#pragma unroll
        for (int d0 = 0; d0 < 8; ++d0) { const u32x4 qq = __builtin_bit_cast(u32x4, qr[d0]);
            q2 += (bflo(qq.x) * bflo(qq.x) + bfhi(qq.x) * bfhi(qq.x)) + (bflo(qq.y) * bflo(qq.y) + bfhi(qq.y) * bfhi(qq.y)) + (bflo(qq.z) * bflo(qq.z) + bfhi(qq.z) * bfhi(qq.z)) + (bflo(qq.w) * bflo(qq.w) + bfhi(qq.w) * bfhi(qq.w)); }
        q2 += __shfl_xor(q2, 32);
#pragma unroll
        for (int off = 1; off < 32; off <<= 1) q2 = fmaxf(q2, __shfl_xor(q2, off));
        if (lane == 0) wm[wid] = q2;
        __syncthreads();
        if (wid == 0) {
            float qm = wm[0];
#pragma unroll
            for (int w = 1; w < 8; ++w) qm = fmaxf(qm, wm[w]);
            const float qc = sqrtf(qm) * (CS * 1.0005f); const int NTd = U.nt - 4;
            const float kown = fmaxf(fmaxf(knt(U.knorm, NTd), knt(U.knorm, NTd + 1)), fmaxf(knt(U.knorm, NTd + 2), knt(U.knorm, NTd + 3)));
            bool ns = false;
            if (lane < NTd) ns = !(U.slopeL * (float)(U.q0 - KVBLK * lane - (KVBLK - 1)) > fmaf(qc, knt(U.knorm, lane) + kown, 35.0f));
            const unsigned long long mk = __ballot(ns);
            if (lane == 0) *tmin = (mk ? (int)__builtin_ctzll(mk) : NTd) & ~1;
        }
        __syncthreads();
        kt0 = *tmin;
        __syncthreads();
        if (tid == 0) *U.kt0_out = (unsigned)kt0;
    }
    const int sr = tid >> 4, sc = (tid & 15) * 8, vst0 = v_st(sr, sc), vst1 = v_st(32 + sr, sc), kst0 = ATT_KSWZ(sr, sc * 2), kst1 = ATT_KSWZ(32 + sr, sc * 2);
    LAS const unsigned char* vb0 = V_lds + v_rd_base(lane);
    const bf16_t* Kh = U.K + (size_t)(sr + kt0 * KVBLK) * NC + sc; const bf16_t* Vh = U.V + (size_t)(sr + kt0 * KVBLK) * NC + sc;
    qpos -= kt0 * KVBLK; qlo -= kt0 * KVBLK;
    bf16x8 sA_v0, sA_v1, sA_k0, sA_k1, sB_v0, sB_v1, sB_k0, sB_k1;
#define ATT_SLOAD(S, k0) do { S##_v0 = *(const bf16x8*)(Vh + (size_t)(k0) * NC); S##_v1 = *(const bf16x8*)(Vh + (size_t)((k0) + 32) * NC); \
    S##_k0 = *(const bf16x8*)(Kh + (size_t)(k0) * NC); S##_k1 = *(const bf16x8*)(Kh + (size_t)((k0) + 32) * NC); } while (0)
#define ATT_SWRITE(b, S) do { *(LAS bf16x8*)(V_lds + (b) * SHM_V + vst0) = S##_v0; *(LAS bf16x8*)(V_lds + (b) * SHM_V + vst1) = S##_v1; \
    *(LAS bf16x8*)(K_lds + (b) * SHM_K + kst0) = S##_k0; *(LAS bf16x8*)(K_lds + (b) * SHM_K + kst1) = S##_k1; } while (0)
#define ATT_SWAIT() asm volatile("s_waitcnt vmcnt(4)" ::: "memory")
#define ATT_RESC(a) do { if (__any((a) < 1.f)) { if (hi == 0) al_l[r32] = (a); asm volatile("s_waitcnt lgkmcnt(0)" ::: "memory"); \
    _Pragma("unroll") for (int d_ = 0; d_ < 4; ++d_) _Pragma("unroll") for (int r = 0; r < 16; ++r) o[d_][r] *= al_l[crow(r, hi)]; } } while (0)
#define ATT_PSM(P0, P1, MN, AL, t) partialSM(P0, P1, m_reg, MN, AL, qpos - (t) * KVBLK - 4 * hi, U.slopeL, (t) * KVBLK + KVBLK - 1 > qlo, MOBA && ((t) >> 2) < U.moba_j && !((sel >> ((t) >> 2)) & 1u))
    f32x16 pA0, pA1, pB0, pB1; float mnA, mnB, alA, alB; bf16x8 pa0, pa1, pa2, pa3; const int NT = U.nt - kt0;
    ATT_SLOAD(sA, 0); ATT_SLOAD(sB, KVBLK); ATT_SWAIT(); ATT_SWRITE(0, sA); __syncthreads();
    qkt(pA0, pA1, K_lds, qr, r32, hi); ATT_PSM(pA0, pA1, mnA, alA, 0);
    ATT_SLOAD(sA, 2 * KVBLK);
    ATT_SWAIT(); ATT_SWRITE(1, sB); __syncthreads();
    for (int j = 1; j + 1 < NT; j += 2) {
        ATT_SBAR(); qkt(pB0, pB1, K_lds + SHM_K, qr, r32, hi);
        finishSM(pA0, pA1, alA, l_reg, pa0, pa1, pa2, pa3); ATT_SBAR();
        ATT_SLOAD(sB, (j + 2) * KVBLK); ATT_SBAR();
        pv_d0(o, vb0, pa0, pa1, pa2, pa3); ATT_PSM(pB0, pB1, mnB, alB, j);
        __syncthreads(); ATT_SWAIT(); ATT_SWRITE(0, sA);
        ATT_RESC(alB); __syncthreads();
        ATT_SBAR(); qkt(pA0, pA1, K_lds, qr, r32, hi);
        finishSM(pB0, pB1, alB, l_reg, pa0, pa1, pa2, pa3); ATT_SBAR();
        if (j + 3 < NT) ATT_SLOAD(sA, (j + 3) * KVBLK);
        ATT_SBAR();
        pv_d0(o, vb0 + SHM_V, pa0, pa1, pa2, pa3); ATT_PSM(pA0, pA1, mnA, alA, j + 1);
        __syncthreads(); ATT_SWAIT(); ATT_SWRITE(1, sB);
        ATT_RESC(alA); __syncthreads();
    }
    ATT_SBAR(); qkt(pB0, pB1, K_lds + SHM_K, qr, r32, hi);
    finishSM(pA0, pA1, alA, l_reg, pa0, pa1, pa2, pa3); ATT_SBAR();
    pv_d0(o, vb0, pa0, pa1, pa2, pa3); ATT_PSM(pB0, pB1, mnB, alB, NT - 1);
    __syncthreads(); ATT_RESC(alB);
    finishSM(pB0, pB1, alB, l_reg, pa0, pa1, pa2, pa3); ATT_SBAR();
    pv_d0(o, vb0 + SHM_V, pa0, pa1, pa2, pa3);
    if (hi == 0) li_l[r32] = l_reg;
    asm volatile("s_waitcnt lgkmcnt(0)" ::: "memory");
#pragma unroll
    for (int r = 0; r < 16; ++r) rli[r] = 1.0f / li_l[crow(r, hi)];
    __syncthreads();
#undef ATT_SLOAD
#undef ATT_SWRITE
#undef ATT_SWAIT
#undef ATT_RESC
#undef ATT_PSM
}
}

namespace sgu {
__device__ __forceinline__ void unit(const bf16_t* proj, const float* stats  , const float* lng, const float* lnb, const float* sw, const float* sb, bf16_t* Y2, int un, LAS unsigned char* lds) {
    int tid_l = threadIdx.x; asm volatile("" : "+v"(tid_l));
    const int tid = tid_l, wid = __builtin_amdgcn_readfirstlane(tid >> 6), lane = tid & 63, r32 = lane & 31, hi = lane >> 5;
    const int g = un & 7, R0 = (un >> 3) * 128;
    const int tb = wid & 3, eh = wid >> 2, t = tb * 32 + r32;
    f32x4 wv[16]; unsigned uu[32], zq[32]; float bias[16];
#pragma unroll
    for (int i = 0; i < 8; ++i) { const int s0 = (i >> 2) * 64 + 16 * (i & 3) + hi * 8; const float* wp = sw + ((size_t)g * 128 + t) * 128 + s0; wv[2 * i] = *(const f32x4*)wp; wv[2 * i + 1] = *(const f32x4*)(wp + 4); }
#pragma unroll
    for (int r = 0; r < 16; ++r) { const int tr = tb * 32 + att::crow(r, hi), bt = R0 + tr; bias[r] = sb[g * 128 + tr];
#pragma unroll
        for (int d = 0; d < 2; ++d) { const int ch = g * 128 + (2 * eh + d) * 32 + (r32 & ~1); uu[r * 2 + d] = *(const unsigned*)(proj + (size_t)bt * NC + C_UC + ch); zq[r * 2 + d] = *(const unsigned*)(proj + (size_t)bt * NC + C_ZC + ch); } }
    { const int sr = tid >> 4, sc = (tid & 15) * 8, ch = g * 128 + sc;
      const f32x4 g0 = *(const f32x4*)(lng + ch), g1 = *(const f32x4*)(lng + ch + 4), b0 = *(const f32x4*)(lnb + ch), b1 = *(const f32x4*)(lnb + ch + 4);
      float mus[4], rss[4];
      { float2 pp[4];
#pragma unroll
        for (int q = 0; q < 4; ++q) pp[q] = *(const float2*)(stats + ((size_t)(R0 + sr + 32 * q) * 16 + (tid & 15)) * 2);
        asm volatile("" ::: "memory");
#pragma unroll
        for (int q = 0; q < 4; ++q) { float s1 = pp[q].x, s2 = pp[q].y;
#pragma unroll
            for (int off = 1; off < 16; off <<= 1) { s1 += __shfl_xor(s1, off); s2 += __shfl_xor(s2, off); }
            mus[q] = s1 * (1.0f / 1024.0f); rss[q] = __builtin_amdgcn_rsqf(fmaxf(s2 * (1.0f / 1024.0f) - mus[q] * mus[q], 0.f) + LN_EPS); } }
#pragma unroll
      for (int q = 0; q < 4; ++q) { const int s = sr + 32 * q, row = R0 + s; const u32x4 vv = *(const u32x4*)(proj + (size_t)row * NC + C_VC + ch);
          const float mu = mus[q], rs = rss[q];
          u32x4 w; w.x = pg8::cvt_pk_bf16((bflo(vv.x) - mu) * rs * g0[0] + b0[0], (bfhi(vv.x) - mu) * rs * g0[1] + b0[1]); w.y = pg8::cvt_pk_bf16((bflo(vv.y) - mu) * rs * g0[2] + b0[2], (bfhi(vv.y) - mu) * rs * g0[3] + b0[3]);
          w.z = pg8::cvt_pk_bf16((bflo(vv.z) - mu) * rs * g1[0] + b1[0], (bfhi(vv.z) - mu) * rs * g1[1] + b1[1]); w.w = pg8::cvt_pk_bf16((bflo(vv.w) - mu) * rs * g1[2] + b1[2], (bfhi(vv.w) - mu) * rs * g1[3] + b1[3]);
          *(LAS u32x4*)(lds + (s >> 6) * att::SHM_V + att::v_st(s & 63, sc)) = w; } }
    __syncthreads();
    att::f32x16 o0 = att::f32x16{}, o1 = att::f32x16{};
    LAS const unsigned char* vb = lds + att::v_rd_base(lane);
#pragma unroll
    for (int st = 0; st < 2; ++st) {
        if (st * 64 > tb * 32 + 31) continue;
        att::bf16x8 pa[4];
#pragma unroll
        for (int k = 0; k < 4; ++k) { const int s0 = st * 64 + 16 * k + hi * 8; const f32x4 w0 = wv[2 * (st * 4 + k)], w1 = wv[2 * (st * 4 + k) + 1];
            float x[8] = {w0[0], w0[1], w0[2], w0[3], w1[0], w1[1], w1[2], w1[3]};
#pragma unroll
            for (int j = 0; j < 8; ++j) x[j] = (s0 + j <= t) ? x[j] : 0.f;
            u32x4 p; p.x = pg8::cvt_pk_bf16(x[0], x[1]); p.y = pg8::cvt_pk_bf16(x[2], x[3]); p.z = pg8::cvt_pk_bf16(x[4], x[5]); p.w = pg8::cvt_pk_bf16(x[6], x[7]); pa[k] = __builtin_bit_cast(att::bf16x8, p); }
        if (eh == 0) { att::pv_one<0>(o0, vb + st * att::SHM_V, pa[0], pa[1], pa[2], pa[3]); att::pv_one<1>(o1, vb + st * att::SHM_V, pa[0], pa[1], pa[2], pa[3]); }
        else         { att::pv_one<2>(o0, vb + st * att::SHM_V, pa[0], pa[1], pa[2], pa[3]); att::pv_one<3>(o1, vb + st * att::SHM_V, pa[0], pa[1], pa[2], pa[3]); }
    }
    {
      asm volatile("" ::: "memory");
#pragma unroll
      for (int r = 0; r < 16; ++r) { const int bt = R0 + tb * 32 + att::crow(r, hi);
#pragma unroll
          for (int d = 0; d < 2; ++d) { const float val = (d == 0 ? o0[r] : o1[r]) + bias[r], vn = __shfl_xor(val, 1); const int ch = g * 128 + (2 * eh + d) * 32 + r32;
              if ((r32 & 1) == 0) *(unsigned*)(Y2 + (size_t)bt * YS + ch) = pk2(val * bflo(uu[r * 2 + d]) * bflo(zq[r * 2 + d]), vn * bfhi(uu[r * 2 + d]) * bfhi(zq[r * 2 + d])); } } }
    __syncthreads();
}
}

namespace memat {
__device__ __forceinline__ void task(const bf16_t* proj, const bf16_t* mk, const bf16_t* mvt, bf16_t* Y3, int tk, int lane) {
    const int rb = tk & 63, h = (tk >> 6) & 3, b = tk >> 8, r32 = lane & 31, hi = lane >> 5, bt0 = b * SEQ + rb * 32;
    att::bf16x8 qr[16];
    const bf16_t* qp = proj + (size_t)(bt0 + r32) * NC + C_QM + h * 256 + hi * 8;
#pragma unroll
    for (int d0 = 0; d0 < 16; ++d0) qr[d0] = *(const att::bf16x8*)(qp + d0 * 16);
    att::f32x16 s[8];
#pragma unroll
    for (int kb = 0; kb < 8; ++kb) { s[kb] = att::f32x16{}; const bf16_t* kp = mk + (size_t)(b * MEML + kb * 32 + r32) * 2048 + h * 256 + hi * 8;
#pragma unroll
        for (int q4 = 0; q4 < 4; ++q4) { att::bf16x8 kf[4];
#pragma unroll
            for (int i = 0; i < 4; ++i) kf[i] = *(const att::bf16x8*)(kp + (q4 * 4 + i) * 16);
            asm volatile("" ::: "memory");
#pragma unroll
            for (int i = 0; i < 4; ++i) s[kb] = __builtin_amdgcn_mfma_f32_32x32x16_bf16(kf[i], qr[q4 * 4 + i], s[kb], 0, 0, 0); } }
    constexpr float C = 0.0625f * att::LOG2E;
    float mx = -__builtin_inff();
#pragma unroll
    for (int kb = 0; kb < 8; ++kb)
#pragma unroll
        for (int r = 0; r < 16; ++r) mx = fmaxf(mx, s[kb][r]);
    { auto rr = __builtin_amdgcn_permlane32_swap(__float_as_uint(mx), __float_as_uint(mx), false, false); mx = fmaxf(__uint_as_float(rr[0]), __uint_as_float(rr[1])); }
    float l = 0.f; const float mc = mx * C;
#pragma unroll
    for (int kb = 0; kb < 8; ++kb)
#pragma unroll
        for (int r = 0; r < 16; ++r) { s[kb][r] = __builtin_amdgcn_exp2f(fmaf(s[kb][r], C, -mc)); l += s[kb][r]; }
    { auto rr = __builtin_amdgcn_permlane32_swap(__float_as_uint(l), __float_as_uint(l), false, false); l = __uint_as_float(rr[0]) + __uint_as_float(rr[1]); }
    const float linv = 1.0f / l;
    att::bf16x8 pa[16];
#define MEM_PK4(P, BASE, OUT) do { const unsigned a0_ = att::cvtpk(P[BASE + 0], P[BASE + 1]), a1_ = att::cvtpk(P[BASE + 2], P[BASE + 3]);   \
    const unsigned b0_ = att::cvtpk(P[BASE + 4], P[BASE + 5]), b1_ = att::cvtpk(P[BASE + 6], P[BASE + 7]);                              \
    auto r0_ = __builtin_amdgcn_permlane32_swap(a0_, b0_, false, false); auto r1_ = __builtin_amdgcn_permlane32_swap(a1_, b1_, false, false); \
    u32x4 w_ = {r0_[0], r1_[0], r0_[1], r1_[1]}; OUT = __builtin_bit_cast(att::bf16x8, w_); } while (0)
#pragma unroll
    for (int kb = 0; kb < 8; ++kb) { MEM_PK4(s[kb], 0, pa[2 * kb]); MEM_PK4(s[kb], 8, pa[2 * kb + 1]); }
#undef MEM_PK4
    float rli[16];
#pragma unroll
    for (int r = 0; r < 16; ++r) rli[r] = __shfl(linv, att::crow(r, hi));
#pragma unroll
    for (int db = 0; db < 8; ++db) { att::f32x16 o = att::f32x16{}; const bf16_t* vp = mvt + ((size_t)((b * 4 + h) * 256 + db * 32 + r32)) * 256 + hi * 8;
        att::bf16x8 vf[16]; unsigned zz[16];
#pragma unroll
        for (int ks = 0; ks < 16; ++ks) vf[ks] = *(const att::bf16x8*)(vp + ks * 16);
#pragma unroll
        for (int r = 0; r < 16; ++r) zz[r] = *(const unsigned*)(proj + (size_t)(bt0 + att::crow(r, hi)) * NC + C_ZM + h * 256 + db * 32 + (r32 & ~1));
        asm volatile("" ::: "memory");
#pragma unroll
        for (int ks = 0; ks < 16; ++ks) o = __builtin_amdgcn_mfma_f32_32x32x16_bf16(pa[ks], vf[ks], o, 0, 0, 0);
#pragma unroll
        for (int r = 0; r < 16; ++r) { const int bt = bt0 + att::crow(r, hi), col = h * 256 + db * 32 + r32; const float val = o[r] * rli[r], vn = __shfl_xor(val, 1);
            if ((r32 & 1) == 0) *(unsigned*)(Y3 + (size_t)bt * YS + col) = pk2(val * bflo(zz[r]), vn * bfhi(zz[r])); } }
}

__device__ __forceinline__ void stage_load(u32x4 (&v)[16], const bf16_t* src, int row_stride, int wave, int lane) {
    const bf16_t* p = src + (size_t)(wave * 2 + (lane >> 5)) * row_stride + (lane & 31) * 8;
#pragma unroll
    for (int i = 0; i < 16; ++i) v[i] = *(const u32x4*)(p + (size_t)(16 * i) * row_stride);
}
__device__ __forceinline__ void stage_store(const u32x4 (&v)[16], LAS unsigned char* lds, int wave, int lane) {
    const int c = lane & 31, r0 = wave * 2 + (lane >> 5);
#pragma unroll
    for (int i = 0; i < 16; ++i) { const int r = r0 + 16 * i; *(LAS u32x4*)(lds + r * 512 + ((c ^ (r & 31)) << 4)) = v[i]; }
}
__device__ __forceinline__ att::bf16x8 frag(LAS const unsigned char* lds, int row, int chunk) { return *(LAS const att::bf16x8*)(lds + row * 512 + ((chunk ^ (row & 31)) << 4)); }
__device__ __forceinline__ void unit(const bf16_t* proj, const bf16_t* mk, const bf16_t* mvt, bf16_t* Y3, int un, LAS unsigned char* lds) {
    int tid_l = threadIdx.x; asm volatile("" : "+v"(tid_l));
    const int tid = tid_l, wave = __builtin_amdgcn_readfirstlane(tid >> 6), lane = tid & 63, r32 = lane & 31, hi = lane >> 5;
    const int tk = un * 8 + wave, rb = tk & 63, h = (tk >> 6) & 3, b = tk >> 8, bt0 = b * SEQ + rb * 32;
    u32x4 st[16]; att::bf16x8 qr[16];
    stage_load(st, mk + (size_t)(b * MEML) * 2048 + h * 256, 2048, wave, lane);
    const bf16_t* qp = proj + (size_t)(bt0 + r32) * NC + C_QM + h * 256 + hi * 8;
#pragma unroll
    for (int d0 = 0; d0 < 16; ++d0) qr[d0] = *(const att::bf16x8*)(qp + d0 * 16);
    asm volatile("" ::: "memory");
    stage_store(st, lds, wave, lane);
    __syncthreads();
    att::f32x16 s[8];
#pragma unroll
    for (int kb = 0; kb < 8; ++kb) { s[kb] = att::f32x16{};
#pragma unroll
        for (int q2 = 0; q2 < 8; ++q2) { att::bf16x8 kf[2]; int rv = r32; asm volatile("" : "+v"(rv));
#pragma unroll
            for (int i = 0; i < 2; ++i) kf[i] = frag(lds, kb * 32 + rv, 2 * (q2 * 2 + i) + hi);
            asm volatile("" ::: "memory");
#pragma unroll
            for (int i = 0; i < 2; ++i) s[kb] = __builtin_amdgcn_mfma_f32_32x32x16_bf16(kf[i], qr[q2 * 2 + i], s[kb], 0, 0, 0); } }
    constexpr float C = 0.0625f * att::LOG2E;
    float mx = -__builtin_inff();
#pragma unroll
    for (int kb = 0; kb < 8; ++kb)
#pragma unroll
        for (int r = 0; r < 16; ++r) mx = fmaxf(mx, s[kb][r]);
    { auto rr = __builtin_amdgcn_permlane32_swap(__float_as_uint(mx), __float_as_uint(mx), false, false); mx = fmaxf(__uint_as_float(rr[0]), __uint_as_float(rr[1])); }
    float l = 0.f; const float mc = mx * C;
#pragma unroll
    for (int kb = 0; kb < 8; ++kb)
#pragma unroll
        for (int r = 0; r < 16; ++r) { s[kb][r] = __builtin_amdgcn_exp2f(fmaf(s[kb][r], C, -mc)); l += s[kb][r]; }
    { auto rr = __builtin_amdgcn_permlane32_swap(__float_as_uint(l), __float_as_uint(l), false, false); l = __uint_as_float(rr[0]) + __uint_as_float(rr[1]); }
    const float linv = 1.0f / l;
    att::bf16x8 pa[16];
#define MEM_PK4(P, BASE, OUT) do { const unsigned a0_ = att::cvtpk(P[BASE + 0], P[BASE + 1]), a1_ = att::cvtpk(P[BASE + 2], P[BASE + 3]);   \
    const unsigned b0_ = att::cvtpk(P[BASE + 4], P[BASE + 5]), b1_ = att::cvtpk(P[BASE + 6], P[BASE + 7]);                              \
    auto r0_ = __builtin_amdgcn_permlane32_swap(a0_, b0_, false, false); auto r1_ = __builtin_amdgcn_permlane32_swap(a1_, b1_, false, false); \
    u32x4 w_ = {r0_[0], r1_[0], r0_[1], r1_[1]}; OUT = __builtin_bit_cast(att::bf16x8, w_); } while (0)
#pragma unroll
    for (int kb = 0; kb < 8; ++kb) { MEM_PK4(s[kb], 0, pa[2 * kb]); MEM_PK4(s[kb], 8, pa[2 * kb + 1]); }
#undef MEM_PK4
#pragma unroll
    for (int i = 0; i < 16; ++i) { u32x4 w_ = __builtin_bit_cast(u32x4, pa[i]); asm volatile("" : "+v"(w_)); pa[i] = __builtin_bit_cast(att::bf16x8, w_); }
    float rli[16];
#pragma unroll
    for (int r = 0; r < 16; ++r) rli[r] = __shfl(linv, att::crow(r, hi));
    stage_load(st, mvt + (size_t)((b * 4 + h) * 256) * 256, 256, wave, lane);
    asm volatile("" ::: "memory");
    __syncthreads();
    stage_store(st, lds, wave, lane);
    __syncthreads();
#pragma unroll
    for (int hf = 0; hf < 4; ++hf) { unsigned zz[32];
#pragma unroll
        for (int dbi = 0; dbi < 2; ++dbi)
#pragma unroll
            for (int r = 0; r < 16; ++r) zz[dbi * 16 + r] = *(const unsigned*)(proj + (size_t)(bt0 + att::crow(r, hi)) * NC + C_ZM + h * 256 + (hf * 2 + dbi) * 32 + (r32 & ~1));
        asm volatile("" ::: "memory");
#pragma unroll
        for (int dbi = 0; dbi < 2; ++dbi) { const int db = hf * 2 + dbi; att::f32x16 o = att::f32x16{};
#pragma unroll
            for (int q4 = 0; q4 < 4; ++q4) { att::bf16x8 vf[4]; int rv = r32; asm volatile("" : "+v"(rv));
#pragma unroll
                for (int i = 0; i < 4; ++i) vf[i] = frag(lds, db * 32 + rv, 2 * (q4 * 4 + i) + hi);
                asm volatile("" ::: "memory");
#pragma unroll
                for (int i = 0; i < 4; ++i) o = __builtin_amdgcn_mfma_f32_32x32x16_bf16(pa[q4 * 4 + i], vf[i], o, 0, 0, 0); }
#pragma unroll
            for (int r = 0; r < 16; ++r) { const int bt = bt0 + att::crow(r, hi), col = h * 256 + db * 32 + r32; const float val = o[r] * rli[r], vn = __shfl_xor(val, 1);
                if ((r32 & 1) == 0) *(unsigned*)(Y3 + (size_t)bt * YS + col) = pk2(val * bflo(zz[dbi * 16 + r]), vn * bfhi(zz[dbi * 16 + r])); } } }
    __syncthreads();
}
}
#define XB_TMO      128
#define XB_XCNT(j)  (256  + 64 * (j))
#define XB_XSUB(j)  (1280 + 64 * (j))
#define XB_XGEN(j)  (2304 + 64 * (j))
#define XB_TOP      3328
#define XB_TOPGEN   3392
#define XCD_BAR_WORDS 3456
#define XB_SPIN_CAP (1u << 18)

__device__ __forceinline__ unsigned xb_ld(unsigned* p)              { return __hip_atomic_load(p, __ATOMIC_RELAXED, __HIP_MEMORY_SCOPE_AGENT); }
__device__ __forceinline__ unsigned xb_add(unsigned* p, unsigned v) { return __hip_atomic_fetch_add(p, v, __ATOMIC_RELAXED, __HIP_MEMORY_SCOPE_AGENT); }
__device__ __forceinline__ unsigned xb_xcc_id() { return (unsigned)__builtin_amdgcn_s_getreg((3 << 11) | 20) & 0xFu; }
#define XB_SPIN(cond, bar) do { unsigned _sp = 0; while (cond) { __builtin_amdgcn_s_sleep(1); \
    if ((++_sp & 255u) == 0u) { if (xb_ld(&(bar)[XB_TMO])) break; if (_sp > XB_SPIN_CAP) { atomicAdd(&(bar)[XB_TMO], 1u); break; } } } } while (0)

struct XcdBarrier {
    unsigned* bar; unsigned x;
    volatile LAS unsigned* st;
};

__device__ __forceinline__ XcdBarrier xcd_barrier_post(unsigned* bar, volatile LAS unsigned* st) {
    XcdBarrier b; b.bar = bar; b.x = xb_xcc_id(); b.st = st;
    if (threadIdx.x == 0) (void)xb_add(&bar[XB_XCNT(b.x)], 1u);
    return b;
}
__device__ __forceinline__ void xcd_barrier_complete(unsigned* bar, unsigned x, unsigned& nloc, unsigned& nx) {
    const unsigned G = gridDim.x * gridDim.y * gridDim.z;
    unsigned sum, cnt, mine, sp = 0u;
    for (;;) {
        sum = 0u; cnt = 0u; mine = 0u;
#pragma unroll
        for (unsigned j = 0; j < 16; ++j) { const unsigned c = xb_ld(&bar[XB_XCNT(j)]); sum += c; cnt += (c > 0u) ? 1u : 0u; mine = (j == x) ? c : mine; }
        if (sum == G) break;
        __builtin_amdgcn_s_sleep(1);
        if ((++sp & 255u) == 0u) { if (xb_ld(&bar[XB_TMO])) break; if (sp > XB_SPIN_CAP) { atomicAdd(&bar[XB_TMO], 1u); break; } }
    }
    nloc = mine > 0u ? mine : 1u; nx = cnt > 0u ? cnt : 1u;
}

__device__ __forceinline__ void xcd_barrier(const XcdBarrier& b) {
    asm volatile("s_waitcnt vmcnt(0)" ::: "memory");
    __syncthreads();
    if (threadIdx.x == 0) {
        unsigned* bar = b.bar;
        __builtin_amdgcn_s_waitcnt(0);
        unsigned nloc = b.st[0], nx = b.st[1];
        if (nloc == 0u) { xcd_barrier_complete(bar, b.x, nloc, nx); b.st[0] = nloc; b.st[1] = nx; }
        const unsigned old = xb_add(&bar[XB_XSUB(b.x)], 1u);
        const unsigned gen = old / nloc;
        if (old + 1u == (gen + 1u) * nloc) {
            __builtin_amdgcn_fence(__ATOMIC_RELEASE, "agent");
            asm volatile("s_waitcnt vmcnt(0)" ::: "memory");
            const unsigned og = xb_add(&bar[XB_TOP], 1u);
            const unsigned tg = og / nx;
            if (og + 1u == (tg + 1u) * nx) xb_add(&bar[XB_TOPGEN], 1u);
            else XB_SPIN(xb_ld(&bar[XB_TOPGEN]) == tg, bar);
            __builtin_amdgcn_fence(__ATOMIC_ACQUIRE, "agent");
            xb_add(&bar[XB_XGEN(b.x)], 1u);
            asm volatile("s_waitcnt vmcnt(0)" ::: "memory");
        } else {
            XB_SPIN(xb_ld(&bar[XB_XGEN(b.x)]) == gen, bar);
            __builtin_amdgcn_fence(__ATOMIC_ACQUIRE, "agent");
            asm volatile("s_waitcnt vmcnt(0)" ::: "memory");
        }
    }
    __syncthreads();
}

__device__ __forceinline__ const float* launder_p(const float* p) { const GAS float* g = (const GAS float*)p; asm volatile("" : "+s"(g)); return (const float*)g; }
#ifndef MK_TWICE
#define MK_TWICE -1
#endif
#define REPS(k, l_) ((MK_TWICE == (k) && (l_) == 0) ? 2 : 1)
#ifndef TP_MODE
#define TP_MODE 0
#endif
#ifndef TP_K
#define TP_K 8
#endif
#define TP_BEGIN(c) do { if (TP_MODE != 0 && (c) && threadIdx.x == 0) MISC[25] = (unsigned)__builtin_amdgcn_s_memrealtime(); } while (0)
#define TP_END(c)   do { if (TP_MODE != 0 && (c) && threadIdx.x == 0) MISC[24] = MISC[24] + ((unsigned)__builtin_amdgcn_s_memrealtime() - MISC[25]); } while (0)
constexpr int CONV_I_IN = (DM / 64) * (NC / 64), CONV_I_MEM = (DM / 64) * (2048 / 64), CONV_I_BR = (4 * BW / 64) * (DM / 64), CONV_I_OUT = (DM / 64) * (DM / 64);
constexpr int CONV_PER_L = CONV_I_IN + CONV_I_MEM + CONV_I_BR + CONV_I_OUT;
#define CONV_DECODE(t_, l_, it_) do { int r_ = (it_); \
    if (r_ < CONV_I_IN) { t_.W = INP(3) + (size_t)(l_) * DM * NC; t_.g = INP(2) + (size_t)(l_) * DM; t_.WT = (bf16_t*)(ws + WS_WIN) + (size_t)(l_) * NC * DM; t_.K = DM; t_.N = NC; } \
    else if ((r_ -= CONV_I_IN) < CONV_I_MEM) { t_.W = INP(5) + (size_t)(l_) * DM * 2048; t_.g = INP(4) + (size_t)(l_) * DM; t_.WT = (bf16_t*)(ws + WS_WMEM) + (size_t)(l_) * 2048 * DM; t_.K = DM; t_.N = 2048; } \
    else if ((r_ -= CONV_I_MEM) < CONV_I_BR) { t_.W = INP(15) + (size_t)(l_) * 4 * BW * DM; t_.g = nullptr; t_.WT = (bf16_t*)(ws + WS_WBR) + (size_t)(l_) * DM * 4 * BW; t_.K = 4 * BW; t_.N = DM; } \
    else { r_ -= CONV_I_BR; t_.W = INP(16) + (size_t)(l_) * DM * DM; t_.g = nullptr; t_.WT = (bf16_t*)(ws + WS_WOUT) + (size_t)(l_) * DM * DM; t_.K = DM; t_.N = DM; } \
    t_.idx = r_; t_.nt = ((l_) > 0 || (it_) >= CONV_P0_ITEMS) ? 1 : 0; } while (0)
#define CONV_RUN(l_, first_, stride_, end_, lane_) do { TPItem ta_, tb_; f32x4 va_[16], vb_[16]; float2 ga_[8], gb_[8]; int it_ = (first_); bool ha_ = it_ < (end_); \
    if (ha_) { CONV_DECODE(ta_, l_, it_); tp_load(ta_, va_, ga_, lane_); } \
    while (ha_) { const int itb_ = it_ + (stride_); const bool hb_ = itb_ < (end_); if (hb_) { CONV_DECODE(tb_, l_, itb_); tp_load(tb_, vb_, gb_, lane_); } \
        tp_store(ta_, va_, ga_, (LAS unsigned char*)wl, lane_); if (!hb_) break; \
        it_ = itb_ + (stride_); ha_ = it_ < (end_); if (ha_) { CONV_DECODE(ta_, l_, it_); tp_load(ta_, va_, ga_, lane_); } \
        tp_store(tb_, vb_, gb_, (LAS unsigned char*)wl, lane_); } } while (0)
static_assert(CONV_PER_L % 32 == 0, "conversion chunks of 32 items");
constexpr int CONV_P0_ITEMS = CONV_I_IN + CONV_I_MEM, CONV_D0 = (CONV_PER_L - CONV_P0_ITEMS) / 32, CONV_NCH = CONV_D0 + CONV_P0_ITEMS / 32;
static_assert(CONV_P0_ITEMS % 32 == 0 && (CONV_PER_L - CONV_P0_ITEMS) % 32 == 0, "chunk alignment");
#define CONV_CHUNK(ch_, lane_) do { if ((ch_) < CONV_D0) CONV_RUN4(0, CONV_P0_ITEMS + (ch_) * 32 + wave * 4, lane_); else CONV_RUN4(DEPTH - 1, ((ch_) - CONV_D0) * 32 + wave * 4, lane_); } while (0)
#define CONV_RUN4(l_, i0_, lane_) do { TPItem t0_, t1_, t2_, t3_; f32x4 va_[16], vb_[16]; float2 ga_[8], gb_[8]; \
    CONV_DECODE(t0_, l_, (i0_)); CONV_DECODE(t1_, l_, (i0_) + 1); tp_load(t0_, va_, ga_, lane_); tp_load(t1_, vb_, gb_, lane_); \
    tp_store(t0_, va_, ga_, (LAS unsigned char*)wl, lane_); CONV_DECODE(t2_, l_, (i0_) + 2); tp_load(t2_, va_, ga_, lane_); \
    tp_store(t1_, vb_, gb_, (LAS unsigned char*)wl, lane_); CONV_DECODE(t3_, l_, (i0_) + 3); tp_load(t3_, vb_, gb_, lane_); \
    tp_store(t2_, va_, ga_, (LAS unsigned char*)wl, lane_); tp_store(t3_, vb_, gb_, (LAS unsigned char*)wl, lane_); } while (0)
struct Args { const float* in[18]; float* out; unsigned char* ws; int ph_lo, ph_hi, li, pad; };
__global__ void __launch_bounds__(NWAVES * 64, 2) mega_fwd(Args args) {
    extern __shared__ __attribute__((aligned(16))) unsigned char lds_raw[];
    LAS unsigned char* lds = (LAS unsigned char*)lds_raw;
    volatile LAS unsigned* MISC = (volatile LAS unsigned*)(lds + MISC_OFF);
    const int G = (int)gridDim.x, NGW = G * NWAVES;
    for (int u = threadIdx.x; u < (LDS_BYTES - LDSCTL_OFF) / 4; u += NWAVES * 64) ((LAS unsigned*)(lds + LDSCTL_OFF))[u] = 0u;
    __syncthreads();
    XcdBarrier bar = xcd_barrier_post((unsigned*)((gu32*)(args.ws + WS_CTL) + CW_BAR) + args.li * XCD_BAR_WORDS, MISC + 8);
    const int lo = args.ph_lo, hi = args.ph_hi;
#define IN(k) (lo <= (k) && (k) < hi)
#define SEAM(k) do { if (IN(k) && IN((k) + 1)) { GRID_BAR(); } } while (0)
#define GRID_BAR() do { XcdBarrier bb_ = bar; GAS unsigned* gb_ = (GAS unsigned*)bar.bar; asm volatile("" : "+s"(gb_), "+s"(bb_.x)); bb_.bar = (unsigned*)gb_; xcd_barrier(bb_); } while (0)
#define PHASE_CTX() int tid_ = threadIdx.x; asm volatile("" : "+v"(tid_)); GAS unsigned char* wsg_ = (GAS unsigned char*)args.ws; asm volatile("" : "+s"(wsg_)); unsigned char* ws = (unsigned char*)wsg_; \
    const int tid = tid_, lane = tid & 63, wave = __builtin_amdgcn_readfirstlane(tid >> 6), gw = (int)blockIdx.x * NWAVES + wave; \
    LAS float* wl = (LAS float*)(lds + wave * 16384); (void)lane; (void)gw; (void)ws; (void)wl; (void)tid
#define INP(k) launder_p(args.in[k])

    if (IN(0)) for (int rep = 0; rep < REPS(0, 0); ++rep) {
        if (rep) GRID_BAR();
        PHASE_CTX();
        const float* x = INP(0); const float* mem = INP(1);
        CONV_RUN(0, gw, NGW, CONV_P0_ITEMS, lane);
        for (int r = gw; r < MT; r += NGW) row_item(x, (bf16_t*)(ws + WS_XB), (float*)(ws + WS_SS0), r, lane);
        for (int r = gw; r < MEMR; r += NGW) row_item(mem, (bf16_t*)(ws + WS_MEMB), (float*)(ws + WS_MEMSS), r, lane);
    }
    SEAM(0);

    for (int l = 0; l < DEPTH; ++l) {
        const int pb = 1 + 5 * l;
        if (IN(pb)) for (int rep = 0; rep < REPS(1, l); ++rep) {
            if (rep) GRID_BAR();
            { PHASE_CTX();
            { pg8::Gemm g{(const bf16_t*)(ws + WS_MEMB), (const bf16_t*)(ws + WS_WMEM) + (size_t)l * 2048 * DM, MEMR, 2048, DM}; pg8::StaticOrder S; S.init(MEMR, 2048, G, (int)((blockIdx.x + G / 2) % G));
              pg8::EpiMem E{(bf16_t*)(ws + WS_MKV) + (size_t)l * MEMR * 2048, (const float*)(ws + WS_MEMSS), (bf16_t*)(ws + WS_MVT) + (size_t)l * MEMR * 1024}; pg8::gemm_phase<pg8::EpiMem, pg8::StaticOrder, true, true>(lds, g, S, E); }
            { pg8::Gemm g{(const bf16_t*)(ws + WS_XB), (const bf16_t*)(ws + WS_WIN) + (size_t)l * NC * DM, MT, NC, DM}; pg8::StaticOrder S; S.init(MT, NC, G, (int)blockIdx.x);
              pg8::EpiProj E{(bf16_t*)(ws + WS_PROJ), (const float*)(ws + (l == 0 ? WS_SS0 : WS_CTL + CTL_SS1)), ws + WS_G8, (float*)(ws + WS_KMEAN), (float*)(ws + WS_KN), (float*)(ws + WS_STATS)}; pg8::gemm_phase<pg8::EpiProj, pg8::StaticOrder, true, true>(lds, g, S, E); }
            }
            if (l + 1 < DEPTH) {
                if ((int)blockIdx.x >= G / 2 + MEMR / 256 * 8 && 3712 % G != 0) {
                    PHASE_CTX();
                    gu32* chead = (gu32*)(ws + WS_CTL) + CW_CONV;
                    for (int k = 0; k < 7; ++k) {
                        if (tid == 0) MISC[17] = __hip_atomic_fetch_add(chead, 1u, RLX_AGENT);
                        __syncthreads(); const int cu = (int)MISC[17]; __syncthreads();
                        if (cu >= CONV_NCH) break;
                        CONV_CHUNK(cu, lane);
                    }
                }
            } else {
                PHASE_CTX();
                gu32* chead = (gu32*)(ws + WS_CTL) + CW_CONV + 64;
                for (;;) {
                    if (tid == 0) MISC[17] = __hip_atomic_fetch_add(chead, 1u, RLX_AGENT);
                    __syncthreads(); const int cu = (int)MISC[17]; __syncthreads();
                    if (cu >= CONV_D0) break;
                    CONV_RUN4(DEPTH - 1, CONV_P0_ITEMS + cu * 32 + wave * 4, lane);
                }
            }
        }
        SEAM(pb);
        TP_BEGIN((TP_MODE == 1 || TP_MODE == 6) && l == 1);
        if (IN(pb + 2)) for (int rep = 0; rep < REPS(3, l); ++rep) {
            if (rep) GRID_BAR();
            { PHASE_CTX();
            const bf16_t* PROJ = (const bf16_t*)(ws + WS_PROJ); bf16_t* Y = (bf16_t*)(ws + WS_Y);
            const bf16_t* mkv = (const bf16_t*)(ws + WS_MKV) + (size_t)l * MEMR * 2048;
            gu32* qhead = (gu32*)(ws + WS_CTL) + CW_Q + 64 * (l + 2 * rep);
            const float lam_init = l == 0 ? 0.2f : 0.35550907f;
            for (;;) {
                if (tid == 0) MISC[16] = __hip_atomic_fetch_add(qhead, 1u, RLX_AGENT);
                __syncthreads(); const int uq = (int)MISC[16]; __syncthreads();
                int lane_u = lane; asm volatile("" : "+v"(lane_u));
                constexpr int NCONV = CONV_NCH;
                int u = uq; bool xtra = false; (void)xtra;
                if (l + 1 < DEPTH) {
                    if (uq >= 1024 + NCONV) break;
                    int cu = -1;
                    if (uq < 2048) { if (uq & 1) cu = uq >> 1; else u = uq >> 1; } else cu = uq - 1024;
                    if (cu >= 0) {
                        if (tid == 0) MISC[17] = __hip_atomic_fetch_add((gu32*)(ws + WS_CTL) + CW_CONV, 1u, RLX_AGENT);
                        __syncthreads(); const int ch = (int)MISC[17]; __syncthreads();
                        if (ch < NCONV) CONV_CHUNK(ch, lane_u);
                        continue; }
                } else {
#ifndef MQ_PROBE
#define MQ_PROBE 0
#endif
                    constexpr int MQX = MQ_PROBE == 1 ? 256 : (MQ_PROBE == 2 || MQ_PROBE == 5) ? 128 : MQ_PROBE == 3 ? 128 : MQ_PROBE == 4 ? 512 : 0;
                    if (uq >= 1024 + MQX) break;
                    if (uq < MQX) { xtra = true; if (MQ_PROBE == 1) u = (uq / 32) * 48 + 16 + uq % 32; else if (MQ_PROBE == 2 || MQ_PROBE == 5) u = (uq / 16) * 48 + uq % 16; else if (MQ_PROBE == 3) u = 384 + uq; else u = 512 + uq; }
                    else u = uq - MQX;
                }
                if (u < 128) u = (u >> 4) * 48 + (u & 15);
                else if (u < 384) { const int e_ = u - 128; u = (e_ >> 5) * 48 + 16 + (e_ & 31); }
                if (u >= 512) {
                    TP_BEGIN(TP_MODE == 8 && l == 1 && u == 512);
                    sgu::unit(PROJ, (const float*)(ws + WS_STATS), INP(11) + l * BW, INP(12) + l * BW, INP(13) + (size_t)l * 8 * 128 * 128, INP(14) + l * 8 * 128, Y + 2 * BW, u - 512, lds);
                    TP_END(TP_MODE == 8 && l == 1 && u == 512);
                    continue; }
                if (u >= 384) {
                    TP_BEGIN(TP_MODE == 7 && l == 1 && u == 384);
                    memat::unit(PROJ, mkv, (const bf16_t*)(ws + WS_MVT) + (size_t)l * MEMR * 1024, Y + 3 * BW, u - 384, lds);
                    TP_END(TP_MODE == 7 && l == 1 && u == 384);
                    continue; }
                const int L = 7 - u / 48, v = u % 48;
                att::f32x16 o[4]; float rli[16];
                TP_BEGIN((TP_MODE == 2 && l == 1 && u == 3) || (TP_MODE == 4 && l == 1 && u == 16));
                if (v < 16) {
                    const int b = v >> 2, h = v & 3;
                    float* S1 = (float*)(ws + WS_BSCR) + (size_t)blockIdx.x * 65536; float* S2 = S1 + 32768;
#pragma nounroll
                    for (int ps = 0; ps < 4; ++ps) { const int mp = ps & 1, vh = ps >> 1;
                        att::UnitDesc U; U.Q = PROJ + (size_t)(b * SEQ + L * 256) * NC + C_QB + h * 256 + mp * 128; U.K = PROJ + (size_t)(b * SEQ) * NC + C_KB + h * 256 + mp * 128;
                        U.V = PROJ + (size_t)(b * SEQ) * NC + C_VB + h * 256 + vh * 128; U.q0 = L * 256; U.nt = 4 * (L + 1); U.slopeL = exp2f(-8.0f * (float)(h + 1) / 12.0f) * att::LOG2E; U.moba_j = -1; U.kmean = nullptr;
                        U.knorm = (const float*)(ws + WS_KN) + ((b * 4 + h) * 2 + mp) * 128;
                        U.kt0_out = (LAS unsigned*)(MISC + 20 + mp); U.kt0_in = vh == 0 ? -1 : (int)MISC[20 + mp];
                        TP_BEGIN(TP_MODE == 3 && l == 1 && u == 3 && ps == 0);
                        att::run_unit<false>(U, lds, o, rli);
                        TP_END(TP_MODE == 3 && l == 1 && u == 3 && ps == 0);
                        if (MQ_PROBE == 5 && xtra) { S1[(size_t)ps * 512 + threadIdx.x] = o[0][0] + o[1][1] + o[2][2] + o[3][3] + rli[0]; continue; }
                        int lane_p = threadIdx.x & 63; asm volatile("" : "+v"(lane_p)); const int r32 = lane_p & 31, hi = lane_p >> 5;
                        float* sp = S1 + (size_t)(wave * 64 + lane_p) * 64;
                        if (mp == 0) {
#pragma unroll
                            for (int r = 0; r < 16; ++r) *(f32x4*)(sp + r * 4) = (f32x4){o[0][r], o[1][r], o[2][r], o[3][r]} * rli[r];
                        } else {
                            const float* q1 = INP(6) + l * 128; const float* k1 = INP(7) + l * 128; const float* q2 = INP(8) + l * 128; const float* k2 = INP(9) + l * 128;
                            const float s1 = wave_sum(q1[lane_p] * k1[lane_p] + q1[lane_p + 64] * k1[lane_p + 64]), s2 = wave_sum(q2[lane_p] * k2[lane_p] + q2[lane_p + 64] * k2[lane_p + 64]);
                            const float lam = expf(s1) - expf(s2) + lam_init;
                            asm volatile("s_waitcnt vmcnt(0)" ::: "memory");
                            { f32x4 t[16];
#pragma unroll
                              for (int r = 0; r < 16; ++r) t[r] = *(const f32x4*)(sp + r * 4);
                              asm volatile("" ::: "memory");
#pragma unroll
                              for (int r = 0; r < 16; ++r) { const float a_ = lam * rli[r];
#pragma unroll
                                  for (int d0 = 0; d0 < 4; ++d0) o[d0][r] = t[r][d0] - a_ * o[d0][r]; } }
                            float* sq = S2 + (size_t)(wave * 64 + lane_p) * 64;
                            if (vh == 0) {
#pragma unroll
                                for (int r = 0; r < 16; ++r) *(f32x4*)(sq + r * 4) = (f32x4){o[0][r], o[1][r], o[2][r], o[3][r]};
                            } else { const float* subg = INP(10) + l * 256;
                                asm volatile("s_waitcnt vmcnt(0)" ::: "memory");
                                float sg[8];
#pragma unroll
                                for (int i = 0; i < 8; ++i) sg[i] = subg[(i >> 2) * 128 + (i & 3) * 32 + r32];
                                { f32x4 t[16];
#pragma unroll
                                  for (int r = 0; r < 16; ++r) t[r] = *(const f32x4*)(sq + r * 4);
                                  asm volatile("" ::: "memory");
#pragma unroll
                                  for (int r = 0; r < 16; ++r) { float ssq = 0.f;
#pragma unroll
                                      for (int d0 = 0; d0 < 4; ++d0) ssq += t[r][d0] * t[r][d0] + o[d0][r] * o[d0][r];
#pragma unroll
                                      for (int off = 1; off < 32; off <<= 1) ssq += __shfl_xor(ssq, off);
                                      rli[r] = __builtin_amdgcn_rsqf(ssq * (1.0f / 256.0f) + RMS_EPS) * (1.0f - lam_init); } }
#pragma unroll
                                for (int hv = 0; hv < 2; ++hv)
#pragma unroll
                                  for (int rq = 0; rq < 4; ++rq) { unsigned zz[16]; f32x4 t[4];
                                    int wv_ = wave; asm volatile("" : "+s"(wv_));
#pragma unroll
                                    for (int rr = 0; rr < 4; ++rr) { const int r = rq * 4 + rr; const bf16_t* zp = PROJ + (size_t)(b * SEQ + L * 256 + wv_ * 32 + att::crow(r, hi)) * NC + C_ZB + h * 256 + hv * 128 + (r32 & ~1);
#pragma unroll
                                        for (int d0 = 0; d0 < 4; ++d0) zz[rr * 4 + d0] = *(const unsigned*)(zp + d0 * 32);
                                        if (hv == 0) t[rr] = *(const f32x4*)(sq + r * 4); else t[rr] = (f32x4){o[0][r], o[1][r], o[2][r], o[3][r]}; }
                                    asm volatile("" ::: "memory");
#pragma unroll
                                    for (int rr = 0; rr < 4; ++rr) { const int r = rq * 4 + rr; bf16_t* yp = Y + (size_t)(b * SEQ + L * 256 + wv_ * 32 + att::crow(r, hi)) * YS + BW + h * 256 + hv * 128 + r32;
#pragma unroll
                                        for (int d0 = 0; d0 < 4; ++d0) { const float val = t[rr][d0] * rli[r] * sg[hv * 4 + d0], vn = __shfl_xor(val, 1);
                                            if ((r32 & 1) == 0) *(unsigned*)(yp + d0 * 32) = pk2(val * bflo(zz[rr * 4 + d0]), vn * bfhi(zz[rr * 4 + d0])); } } }
                            }
                        }
                    }
                    TP_END(TP_MODE == 2 && l == 1 && u == 3);
                } else {
                    const int bh = v - 16, b = bh >> 3, h = bh & 7;
                    att::UnitDesc U; U.Q = PROJ + (size_t)(b * SEQ + L * 256) * NC + C_QA + h * 128; U.K = PROJ + (size_t)(b * SEQ) * NC + C_KA + h * 128;
                    U.V = PROJ + (size_t)(b * SEQ) * NC + C_VA + h * 128; U.q0 = L * 256; U.nt = 4 * (L + 1); U.slopeL = exp2f(-8.0f * (float)(h + 5) / 12.0f) * att::LOG2E; U.moba_j = L;
                    U.kmean = (const float*)(ws + WS_KMEAN) + (size_t)(b * 8 + h) * 8 * 256; U.knorm = nullptr; U.kt0_out = nullptr; U.kt0_in = -1;
                    att::run_unit<true>(U, lds, o, rli);
                    int lane_p = threadIdx.x & 63; asm volatile("" : "+v"(lane_p)); const int r32 = lane_p & 31, hi = lane_p >> 5;
                    { unsigned zz[64];
#pragma unroll
                      for (int r = 0; r < 16; ++r) { const int bt = b * SEQ + L * 256 + wave * 32 + att::crow(r, hi);
#pragma unroll
                          for (int d0 = 0; d0 < 4; ++d0) zz[r * 4 + d0] = *(const unsigned*)(PROJ + (size_t)bt * NC + C_ZA + h * 128 + d0 * 32 + (r32 & ~1)); }
                      asm volatile("" ::: "memory");
#pragma unroll
                      for (int r = 0; r < 16; ++r) { const int bt = b * SEQ + L * 256 + wave * 32 + att::crow(r, hi);
#pragma unroll
                          for (int d0 = 0; d0 < 4; ++d0) { const float val = o[d0][r] * rli[r], vn = __shfl_xor(val, 1); const int col = h * 128 + d0 * 32 + r32;
                              if ((r32 & 1) == 0) *(unsigned*)(Y + (size_t)bt * YS + col) = pk2(val * bflo(zz[r * 4 + d0]), vn * bfhi(zz[r * 4 + d0])); } } }
                }
                TP_END(TP_MODE == 4 && l == 1 && u == 16);
            }
            }
        }
        TP_END(TP_MODE == 6 && l == 1);
        SEAM(pb + 2);
        TP_END(TP_MODE == 1 && l == 1);
        if (IN(pb + 3)) for (int rep = 0; rep < REPS(4, l); ++rep) {
            if (rep) GRID_BAR();
            PHASE_CTX();
            pg8::Gemm g{(const bf16_t*)(ws + WS_Y), (const bf16_t*)(ws + WS_WBR) + (size_t)l * DM * 4 * BW, MT, DM, 4 * BW}; pg8::StaticOrder S; S.init(MT, DM, G, (int)blockIdx.x);
            pg8::EpiGate2 E{ws + WS_G8, (bf16_t*)(ws + WS_MERGED)}; pg8::gemm_phase<pg8::EpiGate2, pg8::StaticOrder, true, true>(lds, g, S, E);
        }
        SEAM(pb + 3);
        if (IN(pb + 4)) for (int rep = 0; rep < REPS(5, l); ++rep) {
            if (rep) GRID_BAR();
            PHASE_CTX();
            pg8::Gemm g{(const bf16_t*)(ws + WS_MERGED), (const bf16_t*)(ws + WS_WOUT) + (size_t)l * DM * DM, MT, DM, DM}; pg8::StaticOrder S; S.init(MT, DM, G, (int)blockIdx.x);
            { typedef pg8::EpiResid<true, false, true> ER; ER E{nullptr, (const bf16_t*)(ws + WS_XB), nullptr, (bf16_t*)(ws + WS_XB), (float*)(ws + WS_CTL + (l == 0 ? CTL_SS1 : CTL_SS2)), (LAS float*)(lds + MISC_OFF + 1024)}; pg8::gemm_phase<ER, pg8::StaticOrder, true, true>(lds, g, S, E); }
        }
        SEAM(pb + 4);
    }
    if (IN(11)) { PHASE_CTX(); const float* fg = INP(17); float* outp = args.out; final_rows((const bf16_t*)(ws + WS_XB), (const float*)(ws + WS_CTL + CTL_SS2), fg, outp, gw, NGW, lane); }
    if (TP_MODE != 0) { __syncthreads(); if (threadIdx.x == 0) { const unsigned w_ = MISC[24] * (unsigned)TP_K; const unsigned t0_ = (unsigned)__builtin_amdgcn_s_memrealtime();
        while ((unsigned)__builtin_amdgcn_s_memrealtime() - t0_ < w_) __builtin_amdgcn_s_sleep(8); } __syncthreads(); }
#undef IN
#undef SEAM
}

extern "C" void kernel_launch(void* const* d_in, const int* in_sizes, int n_in, void* d_out, int out_size, void* d_ws, size_t ws_size, hipStream_t stream) {
    static int grid = 0;
    if (grid == 0) {
        if (n_in != 18 || in_sizes[0] != MT * DM || out_size != MT * DM || ws_size < WS_END) { fprintf(stderr, "kernel_launch: unexpected shapes (n_in %d in0 %d out %d ws %zu need %zu)\n", n_in, n_in > 0 ? in_sizes[0] : -1, out_size, ws_size, (size_t)WS_END); grid = -1; return; }
        int dev = 0, cus = 0, per_cu = 0;
        if (hipGetDevice(&dev) != hipSuccess || hipDeviceGetAttribute(&cus, hipDeviceAttributeMultiprocessorCount, dev) != hipSuccess) { fprintf(stderr, "kernel_launch: device query failed\n"); grid = -1; return; }
        if (hipFuncSetAttribute((const void*)mega_fwd, hipFuncAttributeMaxDynamicSharedMemorySize, LDS_BYTES) != hipSuccess) { fprintf(stderr, "kernel_launch: hipFuncSetAttribute failed\n"); grid = -1; return; }
        if (hipOccupancyMaxActiveBlocksPerMultiprocessor(&per_cu, (const void*)mega_fwd, NWAVES * 64, LDS_BYTES) != hipSuccess || per_cu < 1) fprintf(stderr, "kernel_launch: occupancy query reports %d workgroups per CU\n", per_cu);
        (void)hipGetLastError();
        grid = cus;
        if (grid != 256) fprintf(stderr, "kernel_launch: %d CUs (built and tuned for 256)\n", grid);
    }
    if (grid < 0) return;
    if (hipMemsetAsync((char*)d_ws + WS_CTL, 0, CTL_ZERO_BYTES, stream) != hipSuccess) { fprintf(stderr, "kernel_launch: memset failed\n"); return; }
    Args a{};
    for (int i = 0; i < 18; ++i) a.in[i] = (const float*)d_in[i];
    a.out = (float*)d_out; a.ws = (unsigned char*)d_ws;
#ifndef MK_SPLIT
    a.ph_lo = 0; a.ph_hi = 12; a.li = 0;
    hipLaunchKernelGGL(mega_fwd, dim3(grid), dim3(NWAVES * 64), LDS_BYTES, stream, a);
#else
    for (int p = 0; p < 12; ++p) { a.ph_lo = p; a.ph_hi = p + 1; a.li = p; hipLaunchKernelGGL(mega_fwd, dim3(grid), dim3(NWAVES * 64), LDS_BYTES, stream, a); }
#endif
    const hipError_t le = hipPeekAtLastError();
    if (le != hipSuccess) fprintf(stderr, "kernel_launch: launch failed: %s\n", hipGetErrorName(le));
}
```

```cpp
#include <hip/hip_runtime.h>
#include <cstdio>
#include <cstdint>

namespace cfg {
constexpr int DM = 4096, NBATCH = 4, SEQ = 2048, MT = NBATCH * SEQ, DEPTH = 2, MEML = 256, MEMR = NBATCH * MEML, BW = 1024;
constexpr int NC = 13 * BW + 4 * DM;
constexpr int C_QA = 0, C_KA = 1024, C_VA = 2048, C_ZA = 3072, C_QB = 4096, C_KB = 5120, C_VB = 6144, C_ZB = 7168, C_UC = 8192, C_VC = 9216, C_ZC = 10240, C_QM = 11264, C_ZM = 12288, C_G = 13312;
constexpr float RMS_EPS = 1e-6f, LN_EPS = 1e-5f;
}
namespace pg8 {
#define PG8_LAS __attribute__((address_space(3)))
typedef unsigned short bf16_t;
typedef short bf16x8 __attribute__((ext_vector_type(8)));
typedef float f32x4 __attribute__((ext_vector_type(4)));
typedef unsigned u32x4 __attribute__((ext_vector_type(4)));
constexpr int BM = 256, BK = 64, HALF = 128, HTB = HALF * BK * 2  , STAGE_BYTES = 8 * HTB, NXCD = 8, WGM = 4;

__host__ __device__ __forceinline__ int lds_byte(int r, int c) { const int st = (r >> 4) * 2 + (c >> 5), rr = r & 15, cc = c & 31, ob = rr * 64 + cc * 2; return st * 1024 + (ob ^ (((ob >> 9) & 1) << 5)); }
__host__ __device__ __forceinline__ void stage_rc(int b, int& R, int& C) { const int st = b / 1024, sb = b % 1024, swz = sb ^ (((sb >> 9) & 1) << 5); R = (st >> 1) * 16 + swz / 64; C = (st & 1) * 32 + (swz % 64) / 2; }
__host__ __device__ __forceinline__ int perm32(int rho) { const int n = rho >> 4, i = rho & 15; return 8 * (i >> 2) + 4 * n + (i & 3); }

struct Unit { int pm, pn; };
struct Gemm { const bf16_t* A; const bf16_t* Bt; int M, N, K; };

struct StaticOrder {
    int nM, nN, nwg, G, c;
    __host__ __device__ void init(int M, int N, int G_, int c_) { nM = M / BM; nN = N / BM; nwg = nM * nN; G = G_; c = c_; }
    __host__ __device__ bool next(int i, Unit& u) const {
        const long L = (long)i * G + c; if (L >= nwg) return false;
        int wgid = (int)L; { const int q = nwg / NXCD, r = nwg % NXCD, xcd = wgid % NXCD, off = wgid / NXCD; wgid = (xcd < r ? xcd * (q + 1) : r * (q + 1) + (xcd - r) * q) + off; }
        const int nig = WGM * nN, gid = wgid / nig, fm = gid * WGM, gsz = (nM - fm) < WGM ? (nM - fm) : WGM;
        u.pm = fm + ((wgid % nig) % gsz); u.pn = (wgid % nig) / gsz; return true;
    }
    __device__ __forceinline__ void a_ready(const Unit&) const {}
    __device__ __forceinline__ void done(const Unit&) const {}
};

typedef float f32x2_t __attribute__((ext_vector_type(2))); typedef __bf16 bf16x2_t __attribute__((ext_vector_type(2)));
__device__ __forceinline__ unsigned cvt_pk_bf16(float lo, float hi) { f32x2_t v = {lo, hi}; bf16x2_t b = __builtin_convertvector(v, bf16x2_t); return __builtin_bit_cast(unsigned, b); }
typedef float f32x2 __attribute__((ext_vector_type(2)));
typedef unsigned u32x2 __attribute__((ext_vector_type(2)));
__device__ __forceinline__ float bf_lo(unsigned w) { return __uint_as_float(w << 16); }
__device__ __forceinline__ float bf_hi(unsigned w) { return __uint_as_float(w & 0xffff0000u); }
__device__ __forceinline__ float sigmoid_f(float x) { return __builtin_amdgcn_rcpf(1.0f + __builtin_amdgcn_exp2f(-1.4426950408889634f * x)); }
template <int ACT> __device__ __forceinline__ float act_f(float v) {
    if (ACT == 1) return v * sigmoid_f(v);
    if (ACT == 2) { const float u2 = 1.5957691216057308f * (v + 0.044715f * v * v * v); return v * sigmoid_f(u2); }
    if (ACT == 3) return sigmoid_f(v);
    return v;
}
struct EpiProj {
    static constexpr bool PERM = true, AFTER_DRAIN = false, HAS_MID = false;
    bf16_t* O; const float* ss;
    unsigned char* g8;
    float* kms; float* kn2; float* st2; int pn0;
    template <int ACT, int AUX> __device__ __forceinline__ void run(const f32x4 (&acc)[2][2][4][2], const Unit& uu, int wr, int wc, int fr, int fq) const {
        Unit u = uu; u.pn += pn0;
        const int row0 = u.pm * BM + wr * 64 + fr, col0 = u.pn * BM + wc * 32 + 8 * fq;
        float rsv[8];
#pragma unroll
        for (int i = 0; i < 8; ++i) rsv[i] = ss[row0 + (i >> 2) * HALF + (i & 3) * 16];
        asm volatile("" ::: "memory");
#pragma unroll
        for (int i = 0; i < 8; ++i) rsv[i] = __builtin_amdgcn_rsqf(rsv[i] * (1.0f / cfg::DM) + cfg::RMS_EPS);
        float cs[2][8]; float mx[2][2];
        if (AUX == 1) {
#pragma unroll
            for (int i = 0; i < 16; ++i) cs[i >> 3][i & 7] = 0.f; }
        if (AUX == 2) { mx[0][0] = mx[0][1] = mx[1][0] = mx[1][1] = 0.f; }
#pragma unroll
        for (int ai = 0; ai < 2; ++ai)
#pragma unroll
            for (int m = 0; m < 4; ++m) { const int r = row0 + ai * HALF + m * 16; const float rs = rsv[ai * 4 + m];
                bf16_t* rowp = O + (size_t)r * cfg::NC + col0; float s1 = 0.f, s2 = 0.f;
#pragma unroll
                for (int bj = 0; bj < 2; ++bj) { f32x4 v0 = acc[ai][bj][m][0] * rs, v1 = acc[ai][bj][m][1] * rs;
#pragma unroll
                    for (int j = 0; j < 4; ++j) { v0[j] = act_f<ACT>(v0[j]); v1[j] = act_f<ACT>(v1[j]); }
                    if (AUX == 4) {
                        unsigned q[8];
#pragma unroll
                        for (int j = 0; j < 4; ++j) { q[j] = (unsigned)fminf(fmaxf(fmaf(v0[j], 255.0f, 0.5f), 1.0f), 255.0f); q[4 + j] = (unsigned)fminf(fmaxf(fmaf(v1[j], 255.0f, 0.5f), 1.0f), 255.0f); }
                        u32x2 w8; w8.x = q[0] | (q[1] << 8) | (q[2] << 16) | (q[3] << 24); w8.y = q[4] | (q[5] << 8) | (q[6] << 16) | (q[7] << 24);
                        __builtin_nontemporal_store(w8, (u32x2*)(g8 + ((size_t)((u.pn - 52) >> 4) * cfg::MT + r) * cfg::DM + ((u.pn - 52) & 15) * BM + wc * 32 + 8 * fq + bj * HALF));
                    } else {
                    u32x4 w; w.x = cvt_pk_bf16(v0[0], v0[1]); w.y = cvt_pk_bf16(v0[2], v0[3]); w.z = cvt_pk_bf16(v1[0], v1[1]); w.w = cvt_pk_bf16(v1[2], v1[3]);
                    __builtin_nontemporal_store(w, (u32x4*)(rowp + bj * HALF)); }
                    if (AUX == 1) {
#pragma unroll
                        for (int j = 0; j < 4; ++j) { cs[bj][j] += v0[j]; cs[bj][4 + j] += v1[j]; } }
                    if (AUX == 2) { float p = (v0[0] * v0[0] + v0[1] * v0[1]) + (v0[2] * v0[2] + v0[3] * v0[3]) + (v1[0] * v1[0] + v1[1] * v1[1]) + (v1[2] * v1[2] + v1[3] * v1[3]);
                        p += __shfl_xor(p, 16); p += __shfl_xor(p, 32); mx[ai][bj] = fmaxf(mx[ai][bj], p); }
                    if (AUX == 3) { s1 += (v0[0] + v0[1]) + (v0[2] + v0[3]) + (v1[0] + v1[1]) + (v1[2] + v1[3]);
                        s2 += (v0[0] * v0[0] + v0[1] * v0[1]) + (v0[2] * v0[2] + v0[3] * v0[3]) + (v1[0] * v1[0] + v1[1] * v1[1]) + (v1[2] * v1[2] + v1[3] * v1[3]); } }
                if (AUX == 3) { s1 += __shfl_xor(s1, 16); s1 += __shfl_xor(s1, 32); s2 += __shfl_xor(s2, 16); s2 += __shfl_xor(s2, 32);
                    if (fq == 0) *(float2*)(st2 + ((size_t)r * 16 + (u.pn - 36) * 4 + wc) * 2) = make_float2(s1, s2); } }
        if (AUX == 1) {
#pragma unroll
            for (int i = 0; i < 16; ++i) { float x = cs[i >> 3][i & 7]; x += __shfl_xor(x, 1); x += __shfl_xor(x, 2); x += __shfl_xor(x, 4); x += __shfl_xor(x, 8); cs[i >> 3][i & 7] = x; }
            if (fr == 0) {
#pragma unroll
                for (int bj = 0; bj < 2; ++bj) { float* o = kms + ((size_t)(((u.pm >> 3) * 8 + (u.pn - 4) * 2 + bj) * 8 + (u.pm & 7)) * 2 + wr) * 128 + wc * 32 + 8 * fq;
                    *(f32x4*)o = (f32x4){cs[bj][0], cs[bj][1], cs[bj][2], cs[bj][3]}; *(f32x4*)(o + 4) = (f32x4){cs[bj][4], cs[bj][5], cs[bj][6], cs[bj][7]}; } }
        }
        if (AUX == 2) {
#pragma unroll
            for (int i = 0; i < 4; ++i) { float x = mx[i >> 1][i & 1]; x = fmaxf(x, __shfl_xor(x, 1)); x = fmaxf(x, __shfl_xor(x, 2)); x = fmaxf(x, __shfl_xor(x, 4)); x = fmaxf(x, __shfl_xor(x, 8));
                if (fr == 0 && fq == 0) kn2[((size_t)((((u.pm >> 3) * 4 + (u.pn - 20)) * 2 + (i & 1)) * 32 + (u.pm & 7) * 4 + (i >> 1) * 2 + wr)) * 4 + wc] = x; }
        }
    }
    __device__ __forceinline__ void operator()(const f32x4 (&acc)[2][2][4][2], const Unit& u, int wr, int wc, int fr, int fq) const {
        const int seg = (u.pn + pn0) >> 2;
        if (seg >= 13) run<3, 4>(acc, u, wr, wc, fr, fq);
        else if (seg == 3 || seg == 7 || seg == 10 || seg == 12) run<1, 0>(acc, u, wr, wc, fr, fq);
        else if (seg == 8) run<2, 0>(acc, u, wr, wc, fr, fq);
        else if (seg == 9) run<2, 3>(acc, u, wr, wc, fr, fq);
        else if (seg == 1) run<0, 1>(acc, u, wr, wc, fr, fq);
        else if (seg == 5) run<0, 2>(acc, u, wr, wc, fr, fq);
        else run<0, 0>(acc, u, wr, wc, fr, fq);
    }
};
struct EpiMem {
    static constexpr bool PERM = true, AFTER_DRAIN = false, HAS_MID = false;
    bf16_t* O; const float* ss; bf16_t* VT;
    __device__ __forceinline__ void operator()(const f32x4 (&acc)[2][2][4][2], const Unit& u, int wr, int wc, int fr, int fq) const {
        const int row0 = u.pm * BM + wr * 64 + fr, col0 = u.pn * BM + wc * 32 + 8 * fq;
        float rsv[8];
#pragma unroll
        for (int i = 0; i < 8; ++i) rsv[i] = ss[row0 + (i >> 2) * HALF + (i & 3) * 16];
        asm volatile("" ::: "memory");
#pragma unroll
        for (int i = 0; i < 8; ++i) rsv[i] = __builtin_amdgcn_rsqf(rsv[i] * (1.0f / cfg::DM) + cfg::RMS_EPS);
        if (u.pn < 4) {
#pragma unroll
            for (int ai = 0; ai < 2; ++ai)
#pragma unroll
                for (int m = 0; m < 4; ++m) { const int r = row0 + ai * HALF + m * 16; const float rs = rsv[ai * 4 + m];
                    bf16_t* rowp = O + (size_t)r * 2048 + col0;
#pragma unroll
                    for (int bj = 0; bj < 2; ++bj) { const f32x4 v0 = acc[ai][bj][m][0] * rs, v1 = acc[ai][bj][m][1] * rs;
                        u32x4 w; w.x = cvt_pk_bf16(v0[0], v0[1]); w.y = cvt_pk_bf16(v0[2], v0[3]); w.z = cvt_pk_bf16(v1[0], v1[1]); w.w = cvt_pk_bf16(v1[2], v1[3]);
                        *(u32x4*)(rowp + bj * HALF) = w; } }
        } else {
            bf16_t* vt = VT + (size_t)((u.pm * 4 + (u.pn - 4)) * 256) * 256;
#pragma unroll
            for (int ai = 0; ai < 2; ++ai)
#pragma unroll
                for (int m = 0; m < 4; ++m) { const int key = wr * 64 + fr + ai * HALF + m * 16; const float rs = rsv[ai * 4 + m];
#pragma unroll
                    for (int bj = 0; bj < 2; ++bj) { const f32x4 v0 = acc[ai][bj][m][0] * rs, v1 = acc[ai][bj][m][1] * rs; const int dv = bj * HALF + wc * 32 + 8 * fq;
                        const unsigned w0 = cvt_pk_bf16(v0[0], v0[1]), w1 = cvt_pk_bf16(v0[2], v0[3]), w2 = cvt_pk_bf16(v1[0], v1[1]), w3 = cvt_pk_bf16(v1[2], v1[3]);
                        bf16_t* p = vt + (size_t)dv * 256 + key;
                        p[0 * 256] = (bf16_t)(w0 & 0xffffu); p[1 * 256] = (bf16_t)(w0 >> 16); p[2 * 256] = (bf16_t)(w1 & 0xffffu); p[3 * 256] = (bf16_t)(w1 >> 16);
                        p[4 * 256] = (bf16_t)(w2 & 0xffffu); p[5 * 256] = (bf16_t)(w2 >> 16); p[6 * 256] = (bf16_t)(w3 & 0xffffu); p[7 * 256] = (bf16_t)(w3 >> 16); } }
        }
    }
};
struct EpiGate2 {
    static constexpr bool PERM = true, AFTER_DRAIN = false, HAS_MID = true; static constexpr int MID_EVERY = 16;
    const unsigned char* g8; bf16_t* merged;
    static __device__ __forceinline__ float ub(unsigned w, int k) { return (float)((w >> (8 * k)) & 0xffu); }
    __device__ __forceinline__ void mid(f32x4 (&acc)[2][2][4][2], const Unit& u, int b, int wr, int wc, int fr, int fq) const {
        const unsigned char* pa = g8 + ((size_t)(b - 1) * cfg::MT + u.pm * BM + wr * 64 + fr) * cfg::DM + u.pn * BM + wc * 32 + 8 * fq; const unsigned char* pb = pa + (size_t)cfg::MT * cfg::DM;
        u32x2 ga[16], gb[16];
#pragma unroll
        for (int i = 0; i < 16; ++i) { const size_t o = (size_t)(((i >> 3) & 1) * HALF + ((i >> 1) & 3) * 16) * cfg::DM + (i & 1) * HALF;
            ga[i] = *(const u32x2*)(pa + o); gb[i] = *(const u32x2*)(pb + o); }
        asm volatile("" ::: "memory");
#pragma unroll
        for (int i = 0; i < 16; ++i) { const int ai = (i >> 3) & 1, m = (i >> 1) & 3, bj = i & 1;
            f32x4 r0, r1;
#pragma unroll
            for (int j = 0; j < 4; ++j) { r0[j] = ub(ga[i].x, j) * __builtin_amdgcn_rcpf(ub(gb[i].x, j)); r1[j] = ub(ga[i].y, j) * __builtin_amdgcn_rcpf(ub(gb[i].y, j)); }
            acc[ai][bj][m][0] *= r0; acc[ai][bj][m][1] *= r1; }
    }
    __device__ __forceinline__ void operator()(const f32x4 (&acc)[2][2][4][2], const Unit& u, int wr, int wc, int fr, int fq) const {
        const int row0 = u.pm * BM + wr * 64 + fr, col0 = u.pn * BM + wc * 32 + 8 * fq;
        const unsigned char* pa = g8 + ((size_t)3 * cfg::MT + row0) * cfg::DM + col0;
        u32x2 ga[16];
#pragma unroll
        for (int i = 0; i < 16; ++i) ga[i] = *(const u32x2*)(pa + (size_t)(((i >> 3) & 1) * HALF + ((i >> 1) & 3) * 16) * cfg::DM + (i & 1) * HALF);
        asm volatile("" ::: "memory");
#pragma unroll
        for (int i = 0; i < 16; ++i) { const int ai = (i >> 3) & 1, m = (i >> 1) & 3, bj = i & 1; const int r = row0 + ai * HALF + m * 16, c = col0 + bj * HALF;
            f32x4 s0, s1;
#pragma unroll
            for (int j = 0; j < 4; ++j) { s0[j] = ub(ga[i].x, j) * (1.0f / 255.0f); s1[j] = ub(ga[i].y, j) * (1.0f / 255.0f); }
            const f32x4 v0 = acc[ai][bj][m][0] * s0, v1 = acc[ai][bj][m][1] * s1;
            u32x4 w; w.x = cvt_pk_bf16(v0[0], v0[1]); w.y = cvt_pk_bf16(v0[2], v0[3]); w.z = cvt_pk_bf16(v1[0], v1[1]); w.w = cvt_pk_bf16(v1[2], v1[3]);
            *(u32x4*)(merged + (size_t)r * cfg::DM + c) = w; }
    }
};
template <bool OLD_BF16, bool W_F32, bool W_BF16> struct EpiResid {
    static constexpr bool PERM = false, AFTER_DRAIN = false, HAS_MID = false;
    const float* xold; const bf16_t* xoldb; float* xnew; bf16_t* xb; float* ssn; PG8_LAS float* red;
    __device__ __forceinline__ void operator()(const f32x4 (&acc)[2][2][4][2], const Unit& u, int wr, int wc, int fr, int fq) const {
        typedef unsigned u32x2 __attribute__((ext_vector_type(2)));
        const int row0 = u.pm * BM + wr * 64 + fr, col0 = u.pn * BM + wc * 32 + 4 * fq;
#pragma unroll
        for (int ai = 0; ai < 2; ++ai) {
            f32x4 xo[16];
#pragma unroll
            for (int i = 0; i < 16; ++i) { const int m = i >> 2, bj = (i >> 1) & 1, n = i & 1; const size_t o = (size_t)(row0 + ai * HALF + m * 16) * cfg::DM + col0 + bj * HALF + n * 16;
                if (OLD_BF16) { const u32x2 ww = *(const u32x2*)(xoldb + o); xo[i] = (f32x4){bf_lo(ww.x), bf_hi(ww.x), bf_lo(ww.y), bf_hi(ww.y)}; } else xo[i] = *(const f32x4*)(xold + o); }
            asm volatile("" ::: "memory");
#pragma unroll
            for (int m = 0; m < 4; ++m) { const int r = row0 + ai * HALF + m * 16; float s = 0.f;
#pragma unroll
                for (int bj = 0; bj < 2; ++bj)
#pragma unroll
                    for (int n = 0; n < 2; ++n) { const size_t o = (size_t)r * cfg::DM + col0 + bj * HALF + n * 16; const f32x4 xn = xo[m * 4 + bj * 2 + n] + acc[ai][bj][m][n];
                        if (W_F32) *(f32x4*)(xnew + o) = xn;
                        if (W_BF16) { u32x2 w; w.x = cvt_pk_bf16(xn[0], xn[1]); w.y = cvt_pk_bf16(xn[2], xn[3]); *(u32x2*)(xb + o) = w; }
                        s += (xn[0] * xn[0] + xn[1] * xn[1]) + (xn[2] * xn[2] + xn[3] * xn[3]); }
                s += __shfl_xor(s, 16); s += __shfl_xor(s, 32);
                if (fq == 0) red[wc * 256 + (r - u.pm * BM)] = s; }
        }
        asm volatile("s_waitcnt lgkmcnt(0)" ::: "memory"); __builtin_amdgcn_s_barrier();
        if (wr == 0) { const int t = (wc * 4 + fq) * 16 + fr; unsafeAtomicAdd(ssn + u.pm * BM + t, (red[t] + red[256 + t]) + (red[512 + t] + red[768 + t])); }
    }
};
template <class Epi, class Sched, bool ALIGN_EPI = false, bool SP2 = false>
__device__ __forceinline__ void gemm_phase(PG8_LAS unsigned char* lds, const Gemm g, const Sched& S, const Epi& E) {
    int tid_l = threadIdx.x; asm volatile("" : "+v"(tid_l));
    const int tid = tid_l, wid = __builtin_amdgcn_readfirstlane(tid >> 6), lane = tid & 63, wr = wid >> 2, wc = wid & 3, fr = lane & 15, fq = lane >> 4;
    const int K = g.K, nt = K / BK;
    unsigned voffA[2], voffB[2];
#pragma unroll
    for (int i = 0; i < 2; ++i) { int R, C; stage_rc(tid * 16 + i * 8192, R, C); const int Rb = Epi::PERM ? ((R & ~31) + perm32(R & 31)) : R;
        voffA[i] = (unsigned)(R * K + C) * 2u; voffB[i] = (unsigned)(Rb * K + C) * 2u; }
    const size_t kstep = (size_t)(BK * 2);
    const size_t hstep = (size_t)HALF * K * 2;
    const size_t tstep = 2 * hstep;
    const unsigned ldsw = (unsigned)wid * 1024u;
    const int aoff = lds_byte(wr * 64 + fr, fq * 8), boff = lds_byte(wc * 32 + fr, fq * 8);
#define PG8_SA(b, h) (((b) * 2 + (h)) * HTB)
#define PG8_SB(b, h) ((4 + (b) * 2 + (h)) * HTB)
#define PG8_STAGE(bufoff, gbase, voff) do { _Pragma("unroll") for (int _i = 0; _i < 2; ++_i) \
        __builtin_amdgcn_global_load_lds((const unsigned*)((const char*)(gbase) + (voff)[_i]), (PG8_LAS unsigned*)(lds + (bufoff) + ldsw + _i * 8192), 16, 0, 0); } while (0)
#define PG8_LDA(dst, b, h) do { _Pragma("unroll") for (int m = 0; m < 4; ++m) _Pragma("unroll") for (int k = 0; k < 2; ++k) dst[m][k] = *(const PG8_LAS bf16x8*)(lds + PG8_SA(b, h) + aoff + m * 2048 + k * 1024); } while (0)
#define PG8_LDB(dst, b, h) do { _Pragma("unroll") for (int n = 0; n < 2; ++n) _Pragma("unroll") for (int k = 0; k < 2; ++k) dst[n][k] = *(const PG8_LAS bf16x8*)(lds + PG8_SB(b, h) + boff + n * 2048 + k * 1024); } while (0)
#define PG8_MMA(ai, bj, At, Bt) do { __builtin_amdgcn_s_setprio(1); _Pragma("unroll") for (int m = 0; m < 4; ++m) _Pragma("unroll") for (int n = 0; n < 2; ++n) _Pragma("unroll") for (int k = 0; k < 2; ++k) \
        acc[ai][bj][m][n] = __builtin_amdgcn_mfma_f32_16x16x32_bf16(Bt[n][k], At[m][k], acc[ai][bj][m][n], 0, 0, 0); __builtin_amdgcn_s_setprio(0); } while (0)
#define PG8_WAIT_V(n) asm volatile("s_waitcnt vmcnt(" #n ")" ::: "memory")
#define PG8_WAIT_L(n) asm volatile("s_waitcnt lgkmcnt(" #n ")" ::: "memory")
#define PG8_BAR __builtin_amdgcn_s_barrier()
#define PG8_SCHED __builtin_amdgcn_sched_barrier(0)
    Unit cur, nxt; int ui = 0;
    if (!S.next(0, cur)) return;
    f32x4 acc[2][2][4][2];
#pragma unroll
    for (int a = 0; a < 2; ++a)
#pragma unroll
        for (int b = 0; b < 2; ++b)
#pragma unroll
            for (int m = 0; m < 4; ++m)
#pragma unroll
                for (int n = 0; n < 2; ++n) acc[a][b][m][n] = (f32x4){0.f, 0.f, 0.f, 0.f};
    bf16x8 At[4][2], B0[2][2], B1[2][2];
    const char* cA = (const char*)g.A + (size_t)cur.pm * tstep; const char* cB = (const char*)g.Bt + (size_t)cur.pn * tstep;
    S.a_ready(cur);
    if constexpr (SP2) {
        PG8_STAGE(PG8_SB(0, 0), cB, voffB); PG8_STAGE(PG8_SB(0, 1), cB + hstep, voffB); PG8_STAGE(PG8_SA(0, 0), cA, voffA); PG8_STAGE(PG8_SA(0, 1), cA + hstep, voffA);
        if (wr == 1) PG8_BAR;
        PG8_WAIT_V(2); PG8_BAR;
        PG8_STAGE(PG8_SB(1, 0), cB + kstep, voffB); PG8_STAGE(PG8_SA(1, 0), cA + kstep, voffA); PG8_STAGE(PG8_SB(1, 1), cB + hstep + kstep, voffB);
        PG8_WAIT_V(6); PG8_BAR;
    } else {
        PG8_STAGE(PG8_SB(0, 0), cB, voffB); PG8_STAGE(PG8_SA(0, 0), cA, voffA); PG8_STAGE(PG8_SB(0, 1), cB + hstep, voffB); PG8_STAGE(PG8_SA(0, 1), cA + hstep, voffA);
        if (wr == 1) PG8_BAR;
        PG8_WAIT_V(4); PG8_BAR;
        PG8_STAGE(PG8_SB(1, 0), cB + kstep, voffB); PG8_STAGE(PG8_SA(1, 0), cA + kstep, voffA); PG8_STAGE(PG8_SB(1, 1), cB + hstep + kstep, voffB);
        PG8_WAIT_V(6); PG8_BAR;
    }
    for (;;) {
        const bool has_next = S.next(ui + 1, nxt);
        const char* nA = has_next ? (const char*)g.A + (size_t)nxt.pm * tstep : cA; const char* nB = has_next ? (const char*)g.Bt + (size_t)nxt.pn * tstep : cB;
        for (int t = 0; t < nt; t += 2) {
            const bool last = (t == nt - 2);
            const char* a1 = cA + (size_t)(t + 1) * kstep;
            const char* a2 = last ? nA : cA + (size_t)(t + 2) * kstep; const char* b2 = last ? nB : cB + (size_t)(t + 2) * kstep;
            const char* a3 = a2 + kstep; const char* b3 = b2 + kstep;
            if (last && has_next) S.a_ready(nxt);
            if constexpr (Epi::HAS_MID) { if (t != 0 && (t & (Epi::MID_EVERY - 1)) == 0) E.mid(acc, cur, t / Epi::MID_EVERY, wr, wc, fr, fq); }
            if constexpr (SP2) {
            PG8_LDB(B0, 0, 0); PG8_LDB(B1, 0, 1); PG8_SCHED; PG8_LDA(At, 0, 0); PG8_STAGE(PG8_SA(1, 1), a1 + hstep, voffA);
            PG8_WAIT_V(8); PG8_WAIT_L(0); PG8_BAR; PG8_MMA(0, 0, At, B0); PG8_MMA(0, 1, At, B1); PG8_BAR; PG8_SCHED;
            PG8_LDA(At, 0, 1); PG8_STAGE(PG8_SB(0, 0), b2, voffB); PG8_STAGE(PG8_SB(0, 1), b2 + hstep, voffB); PG8_STAGE(PG8_SA(0, 0), a2, voffA);
            PG8_WAIT_V(8); PG8_WAIT_L(0); PG8_BAR; PG8_MMA(1, 0, At, B0); PG8_MMA(1, 1, At, B1); PG8_BAR; PG8_SCHED;
            PG8_LDB(B0, 1, 0); PG8_LDB(B1, 1, 1); PG8_SCHED; PG8_LDA(At, 1, 0); PG8_STAGE(PG8_SA(0, 1), a2 + hstep, voffA);
            PG8_WAIT_V(8); PG8_WAIT_L(0); PG8_BAR; PG8_MMA(0, 0, At, B0); PG8_MMA(0, 1, At, B1); PG8_BAR; PG8_SCHED;
            PG8_LDA(At, 1, 1); PG8_STAGE(PG8_SB(1, 0), b3, voffB); PG8_STAGE(PG8_SB(1, 1), b3 + hstep, voffB); PG8_STAGE(PG8_SA(1, 0), a3, voffA);
            PG8_WAIT_V(8); PG8_WAIT_L(0); PG8_BAR; PG8_MMA(1, 0, At, B0); PG8_MMA(1, 1, At, B1); PG8_BAR; PG8_SCHED;
            } else {
            PG8_LDB(B0, 0, 0); PG8_SCHED; PG8_LDA(At, 0, 0); PG8_STAGE(PG8_SA(1, 1), a1 + hstep, voffA);
            PG8_WAIT_L(8); PG8_BAR; PG8_WAIT_L(0); PG8_MMA(0, 0, At, B0); PG8_BAR; PG8_SCHED;
            PG8_LDB(B1, 0, 1); PG8_STAGE(PG8_SB(0, 0), b2, voffB);
            PG8_BAR; PG8_WAIT_L(0); PG8_MMA(0, 1, At, B1); PG8_BAR;
            PG8_LDA(At, 0, 1); PG8_STAGE(PG8_SA(0, 0), a2, voffA);
            PG8_BAR; PG8_WAIT_L(0); PG8_MMA(1, 0, At, B0); PG8_BAR; PG8_SCHED;
            PG8_STAGE(PG8_SB(0, 1), b2 + hstep, voffB);
            PG8_WAIT_V(6); PG8_BAR; PG8_MMA(1, 1, At, B1); PG8_BAR;
            PG8_LDB(B0, 1, 0); PG8_SCHED; PG8_LDA(At, 1, 0); PG8_STAGE(PG8_SA(0, 1), a2 + hstep, voffA);
            PG8_WAIT_L(8); PG8_BAR; PG8_WAIT_L(0); PG8_MMA(0, 0, At, B0); PG8_BAR; PG8_SCHED;
            PG8_LDB(B1, 1, 1); PG8_STAGE(PG8_SB(1, 0), b3, voffB);
            PG8_BAR; PG8_WAIT_L(0); PG8_MMA(0, 1, At, B1); PG8_BAR;
            PG8_LDA(At, 1, 1); PG8_STAGE(PG8_SA(1, 0), a3, voffA);
            PG8_BAR; PG8_WAIT_L(0); PG8_MMA(1, 0, At, B0); PG8_BAR; PG8_SCHED;
            PG8_STAGE(PG8_SB(1, 1), b3 + hstep, voffB);
            PG8_WAIT_V(6); PG8_BAR; PG8_MMA(1, 1, At, B1); PG8_BAR;
            }
        }
        if constexpr (ALIGN_EPI) { if (wr == 0) PG8_BAR; }
        if constexpr (!Epi::AFTER_DRAIN) { E(acc, cur, wr, wc, fr, fq); S.done(cur); }
        if (!has_next) break;
#pragma unroll
        for (int a = 0; a < 2; ++a)
#pragma unroll
            for (int b = 0; b < 2; ++b)
#pragma unroll
                for (int m = 0; m < 4; ++m)
#pragma unroll
                    for (int n = 0; n < 2; ++n) acc[a][b][m][n] = (f32x4){0.f, 0.f, 0.f, 0.f};
        cur = nxt; cA = nA; cB = nB; ++ui;
        if constexpr (ALIGN_EPI) { if (wr == 1) PG8_BAR; }
    }
    PG8_WAIT_V(0);
    if constexpr (!ALIGN_EPI) { if (wr == 0) PG8_BAR; }
    PG8_BAR;
    if constexpr (Epi::AFTER_DRAIN) { E.fused(acc, cur, wr, wc, fr, fq, lds, wid, lane); S.done(cur); }
#undef PG8_SA
#undef PG8_SB
#undef PG8_STAGE
#undef PG8_LDA
#undef PG8_LDB
#undef PG8_MMA
#undef PG8_WAIT_V
#undef PG8_WAIT_L
#undef PG8_BAR
#undef PG8_SCHED
}
}

typedef unsigned short bf16_t;
typedef unsigned u32x4 __attribute__((ext_vector_type(4)));
typedef unsigned u32x2 __attribute__((ext_vector_type(2)));
typedef float f32x4 __attribute__((ext_vector_type(4)));
#define LAS __attribute__((address_space(3)))
#define GAS __attribute__((address_space(1)))
typedef GAS unsigned gu32;
#define RLX_AGENT __ATOMIC_RELAXED, __HIP_MEMORY_SCOPE_AGENT
#define WFENCE() asm volatile("s_waitcnt lgkmcnt(0)" ::: "memory")
using namespace cfg;

__device__ __forceinline__ float bf2f(unsigned short b) { return __uint_as_float(((unsigned)b) << 16); }
__device__ __forceinline__ float bflo(unsigned w) { return __uint_as_float(w << 16); }
__device__ __forceinline__ float bfhi(unsigned w) { return __uint_as_float(w & 0xffff0000u); }
__device__ __forceinline__ unsigned f2bf(float f) { unsigned u = __float_as_uint(f); return (u + 0x7fffu + ((u >> 16) & 1u)) >> 16; }
__device__ __forceinline__ unsigned pk2(float lo, float hi) { return f2bf(lo) | (f2bf(hi) << 16); }
__device__ __forceinline__ float wave_sum(float v) {
#pragma unroll
    for (int o = 1; o < 64; o <<= 1) v += __shfl_xor(v, o);
    return v;
}
__device__ __forceinline__ float wave_max(float v) {
#pragma unroll
    for (int o = 1; o < 64; o <<= 1) v = fmaxf(v, __shfl_xor(v, o));
    return v;
}

constexpr size_t MiB = 1u << 20;
constexpr size_t WS_CTL = 0, CTL_ZERO_BYTES = 1 * MiB;
constexpr int CW_BAR = 4096, CW_Q = 2048, CW_CONV = 3072, CW_RDY = 3328;
constexpr size_t CTL_SS1 = 512 * 1024, CTL_SS2 = 512 * 1024 + 65536;
constexpr size_t SZ_WIN = (size_t)NC * DM * 2, SZ_WMEM = (size_t)2048 * DM * 2, SZ_WBR = (size_t)4 * DM * BW * 2, SZ_WOUT = (size_t)DM * DM * 2;
constexpr size_t WS_WIN = 1 * MiB, WS_WMEM = WS_WIN + 2 * SZ_WIN, WS_WBR = WS_WMEM + 2 * SZ_WMEM, WS_WOUT = WS_WBR + 2 * SZ_WBR;
constexpr size_t WS_XB = WS_WOUT + 2 * SZ_WOUT, WS_X1 = WS_XB + (size_t)MT * DM * 2, WS_X2 = WS_X1 + (size_t)MT * DM * 4, WS_SS0 = WS_X2 + (size_t)MT * DM * 4;
constexpr size_t WS_MEMB = WS_SS0 + 65536, WS_MEMSS = WS_MEMB + (size_t)MEMR * DM * 2, WS_MKV = WS_MEMSS + 65536, WS_PROJ = WS_MKV + 2 * (size_t)MEMR * 2048 * 2;
constexpr size_t WS_KMEAN = WS_PROJ + (size_t)MT * NC * 2, WS_Y = WS_KMEAN + 2 * 256 * 128 * 4, WS_BSCR = WS_Y + (size_t)4 * MT * BW * 2, WS_VN = WS_BSCR + (size_t)MT * 2048 * 4;
constexpr size_t WS_T = WS_VN + (size_t)MT * BW * 4, WS_G8 = WS_T  , WS_MERGED = WS_T + (size_t)MT * DM * 4, WS_MVT = WS_MERGED + (size_t)MT * DM * 2, WS_STATS = WS_MVT + 2 * (size_t)MEMR * 1024 * 2, WS_KN = WS_STATS + (size_t)MT * 16 * 8, WS_END = WS_KN + 4 * 1024 * 4;

constexpr int NWAVES = 8;
constexpr int YS = 4 * BW;
constexpr int RING_BYTES = 131072;
constexpr int LDSCTL_OFF = RING_BYTES, MISC_OFF = LDSCTL_OFF + 320;
constexpr int LDS_BYTES = 147456;
static_assert(MISC_OFF + 128 <= LDS_BYTES, "LDS map");

struct TPItem { const float* W; const float* g; bf16_t* WT; int K, N, idx, nt; };
__device__ __forceinline__ void tp_load(const TPItem& t, f32x4 (&v)[16], float2 (&gv)[8], int lane) {
    const int nblk = t.N / 64, kb = t.idx / nblk, nb = t.idx - kb * nblk, kq = lane >> 4, p = lane & 15;
    const GAS float* src = (const GAS float*)(t.W + (size_t)(64 * kb + 2 * kq) * t.N + 64 * nb + 4 * p); const size_t s1 = (size_t)t.N, s7 = (size_t)7 * t.N;
#pragma unroll
    for (int i = 0; i < 16; ++i) { v[i] = __builtin_nontemporal_load((const GAS f32x4*)src); src += (i & 1) ? s7 : s1; asm volatile("" : "+v"(src)); }
    if (t.g) {
#pragma unroll
        for (int ii = 0; ii < 8; ++ii) gv[ii] = *(const float2*)(t.g + 64 * kb + 2 * kq + 8 * ii);
    } else {
#pragma unroll
        for (int ii = 0; ii < 8; ++ii) gv[ii] = make_float2(1.0f, 1.0f);
    }
    asm volatile("" ::: "memory");
}
__device__ __forceinline__ void tp_store(const TPItem& t, const f32x4 (&v)[16], const float2 (&gv)[8], LAS unsigned char* scr, int lane) {
    const int nblk = t.N / 64, kb = t.idx / nblk, nb = t.idx - kb * nblk, k0 = 64 * kb, n0 = 64 * nb, kq = lane >> 4, p = lane & 15;
#pragma unroll
    for (int ii = 0; ii < 8; ++ii) { const float sa = gv[ii].x, sb = gv[ii].y;
#pragma unroll
        for (int j = 0; j < 4; ++j) { const int n = 4 * p + j;
            *(LAS unsigned*)(scr + n * 128 + (((ii ^ (p & 7)) << 4) | (kq << 2))) = pg8::cvt_pk_bf16(v[2 * ii][j] * sa, v[2 * ii + 1][j] * sb); } }
    WFENCE();
    const int c = lane & 7;
    GAS bf16_t* dst = (GAS bf16_t*)(t.WT + (size_t)(n0 + (lane >> 3)) * t.K + k0 + 8 * c); const size_t dstep = (size_t)8 * t.K;
#pragma unroll
    for (int j = 0; j < 8; ++j) { const int n = (lane >> 3) + 8 * j; const u32x4 o = *(LAS const u32x4*)(scr + n * 128 + ((c ^ ((n >> 2) & 7)) << 4));
        if (t.nt) __builtin_nontemporal_store(o, (GAS u32x4*)dst); else *(GAS u32x4*)dst = o;
        dst += dstep; asm volatile("" : "+v"(dst)); }
    WFENCE();
}
__device__ __forceinline__ void row_item(const float* x, bf16_t* xb, float* ss, int r, int lane) {
    const f32x4* xr = (const f32x4*)(x + (size_t)r * DM) + lane; u32x2* o = (u32x2*)(xb + (size_t)r * DM) + lane; float s = 0.f;
    f32x4 v[16];
#pragma unroll
    for (int j = 0; j < 16; ++j) v[j] = xr[64 * j];
    asm volatile("" ::: "memory");
#pragma unroll
    for (int j = 0; j < 16; ++j) { s += (v[j][0] * v[j][0] + v[j][1] * v[j][1]) + (v[j][2] * v[j][2] + v[j][3] * v[j][3]); u32x2 w; w.x = pk2(v[j][0], v[j][1]); w.y = pk2(v[j][2], v[j][3]); o[64 * j] = w; }
    s = wave_sum(s); if (lane == 0) ss[r] = s;
}

__device__ __forceinline__ float dot8(const u32x4 kk, const LAS float* q) {
    return bflo(kk.x) * q[0] + bfhi(kk.x) * q[1] + bflo(kk.y) * q[2] + bfhi(kk.y) * q[3] + bflo(kk.z) * q[4] + bfhi(kk.z) * q[5] + bflo(kk.w) * q[6] + bfhi(kk.w) * q[7];
}
__device__ __forceinline__ void kmean_task(const bf16_t* proj, float* kmean, int id, int lane) {
    const int n = id & 7, h = (id >> 3) & 7, b = id >> 6, rg = lane >> 4, c8 = lane & 15;
    const bf16_t* p = proj + (size_t)(b * SEQ + n * 256 + rg) * NC + C_KA + h * 128 + c8 * 8; float s[8] = {0.f, 0.f, 0.f, 0.f, 0.f, 0.f, 0.f, 0.f};
#pragma unroll
    for (int q = 0; q < 4; ++q) { u32x4 w[16];
#pragma unroll
        for (int i = 0; i < 16; ++i) w[i] = *(const u32x4*)(p + (size_t)(4 * (q * 16 + i)) * NC);
        asm volatile("" ::: "memory");
#pragma unroll
        for (int i = 0; i < 16; ++i) { s[0] += bflo(w[i].x); s[1] += bfhi(w[i].x); s[2] += bflo(w[i].y); s[3] += bfhi(w[i].y); s[4] += bflo(w[i].z); s[5] += bfhi(w[i].z); s[6] += bflo(w[i].w); s[7] += bfhi(w[i].w); } }
#pragma unroll
    for (int j = 0; j < 8; ++j) { s[j] += __shfl_xor(s[j], 16); s[j] += __shfl_xor(s[j], 32); }
    if (lane < 16) { float* o = kmean + (size_t)id * 128 + c8 * 8; *(f32x4*)o = (f32x4){s[0], s[1], s[2], s[3]} * (1.0f / 256.0f); *(f32x4*)(o + 4) = (f32x4){s[4], s[5], s[6], s[7]} * (1.0f / 256.0f); }
}
__device__ __forceinline__ void knorm_task(const bf16_t* proj, float* kn, int id, int lane) {
    const int tile = id & 31, mp = (id >> 5) & 1, h = (id >> 6) & 3, b = id >> 8;
    const bf16_t* p = proj + (size_t)(b * SEQ + tile * 64 + lane) * NC + C_KB + h * 256 + mp * 128; float s = 0.f;
    { u32x4 w[16];
#pragma unroll
      for (int i = 0; i < 16; ++i) w[i] = *(const u32x4*)(p + 8 * i);
      asm volatile("" ::: "memory");
#pragma unroll
      for (int i = 0; i < 16; ++i) s += (bflo(w[i].x) * bflo(w[i].x) + bfhi(w[i].x) * bfhi(w[i].x)) + (bflo(w[i].y) * bflo(w[i].y) + bfhi(w[i].y) * bfhi(w[i].y)) + (bflo(w[i].z) * bflo(w[i].z) + bfhi(w[i].z) * bfhi(w[i].z)) + (bflo(w[i].w) * bflo(w[i].w) + bfhi(w[i].w) * bfhi(w[i].w)); }
    s = wave_max(s);
    if (lane == 0) kn[id] = sqrtf(s) * 1.0001f;
}
__device__ __forceinline__ void sgu_stats_task(const bf16_t* proj, float* stats, int bt, int lane) {
    const u32x4 a = *(const u32x4*)(proj + (size_t)bt * NC + C_VC + lane * 8), b = *(const u32x4*)(proj + (size_t)bt * NC + C_VC + 512 + lane * 8);
    float v[16] = {bflo(a.x), bfhi(a.x), bflo(a.y), bfhi(a.y), bflo(a.z), bfhi(a.z), bflo(a.w), bfhi(a.w), bflo(b.x), bfhi(b.x), bflo(b.y), bfhi(b.y), bflo(b.z), bfhi(b.z), bflo(b.w), bfhi(b.w)};
    float s = 0.f;
#pragma unroll
    for (int i = 0; i < 16; ++i) s += v[i];
    const float mu = wave_sum(s) * (1.0f / 1024.0f); float q = 0.f;
#pragma unroll
    for (int i = 0; i < 16; ++i) { const float d = v[i] - mu; q += d * d; }
    const float rstd = 1.0f / sqrtf(wave_sum(q) * (1.0f / 1024.0f) + LN_EPS);
    if (lane == 0) { stats[2 * bt] = mu; stats[2 * bt + 1] = rstd; }
}
__device__ __forceinline__ void moba_task(const bf16_t* proj, const float* kmean, bf16_t* Y0, int id, int lane, LAS float* wl) {
    LAS float* qs = wl; LAS float* sc = wl + 128;
    const int h = id & 7, bt = id >> 3, b = bt >> 11, t = bt & 2047, j = t >> 8;
    const unsigned qq = *(const unsigned*)(proj + (size_t)bt * NC + C_QA + h * 128 + 2 * lane);
    const float q0 = bflo(qq), q1 = bfhi(qq);
    qs[2 * lane] = q0; qs[2 * lane + 1] = q1;
    float g[8];
#pragma unroll
    for (int n = 0; n < 8; ++n) { const float* km = kmean + (size_t)((b * 8 + h) * 8 + n) * 128; g[n] = wave_sum(q0 * km[2 * lane] + q1 * km[2 * lane + 1]); }
    unsigned sel = 0;
#pragma unroll
    for (int n = 0; n < 8; ++n) { int rank = 0;
#pragma unroll
        for (int m = 0; m < 8; ++m) if (m != n) rank += (m < j && (g[m] > g[n] || (g[m] == g[n] && m < n))) ? 1 : 0;
        if (n < j && rank < 3) sel |= 1u << n; }
    sel |= 1u << j;
    WFENCE();
    const float scale = 0.08838834764831845f, slope = exp2f(-8.0f * (float)(h + 5) / 12.0f);
    float mx = -INFINITY; int nslots = 0;
    for (int n = 0; n <= j; ++n) { if (!((sel >> n) & 1u)) continue;
        for (int c = 0; c < 4; ++c) { const int key = n * 256 + c * 64 + lane; float s = -INFINITY;
            if (key <= t) { const bf16_t* kr = proj + (size_t)(b * SEQ + key) * NC + C_KA + h * 128; float d = 0.f;
#pragma unroll 4
                for (int i = 0; i < 16; ++i) d += dot8(*(const u32x4*)(kr + 8 * i), qs + 8 * i);
                s = d * scale - slope * (float)(t - key); }
            sc[nslots * 256 + c * 64 + lane] = s; mx = fmaxf(mx, s); }
        ++nslots; }
    mx = wave_max(mx);
    WFENCE();
    float l = 0.f;
    for (int i = lane; i < nslots * 256; i += 64) { const float p = __expf(sc[i] - mx); sc[i] = p; l += p; }
    l = wave_sum(l);
    WFENCE();
    float o0 = 0.f, o1 = 0.f; int slot = 0;
    for (int n = 0; n <= j; ++n) { if (!((sel >> n) & 1u)) continue;
        const int kend = (n == j) ? (t - n * 256) : 255;
        const bf16_t* vr = proj + (size_t)(b * SEQ + n * 256) * NC + C_VA + h * 128 + 2 * lane;
        for (int k = 0; k <= kend; ++k) { const float p = sc[slot * 256 + k]; const unsigned vv = *(const unsigned*)(vr + (size_t)k * NC); o0 += p * bflo(vv); o1 += p * bfhi(vv); }
        ++slot; }
    const float inv = 1.0f / l;
    const unsigned zz = *(const unsigned*)(proj + (size_t)bt * NC + C_ZA + h * 128 + 2 * lane);
    *(unsigned*)(Y0 + (size_t)bt * BW + h * 128 + 2 * lane) = pk2(o0 * inv * bflo(zz), o1 * inv * bfhi(zz));
    WFENCE();
}
__device__ __forceinline__ f32x4 diff_task(const bf16_t* proj, int id, int lane, LAS float* wl) {
    LAS float* qs = wl; LAS float* sc = wl + 128;
    const int mp = id & 1, h = (id >> 1) & 3, bt = id >> 3, b = bt >> 11, t = bt & 2047;
    const unsigned qq = *(const unsigned*)(proj + (size_t)bt * NC + C_QB + h * 256 + mp * 128 + 2 * lane);
    qs[2 * lane] = bflo(qq); qs[2 * lane + 1] = bfhi(qq);
    WFENCE();
    const float scale = 0.08838834764831845f, slope = exp2f(-8.0f * (float)(h + 1) / 12.0f);
    float mx = -INFINITY; const int nch = t / 64 + 1;
    for (int c = 0; c < nch; ++c) { const int key = c * 64 + lane; float s = -INFINITY;
        if (key <= t) { const bf16_t* kr = proj + (size_t)(b * SEQ + key) * NC + C_KB + h * 256 + mp * 128; float d = 0.f;
#pragma unroll 4
            for (int i = 0; i < 16; ++i) d += dot8(*(const u32x4*)(kr + 8 * i), qs + 8 * i);
            s = d * scale - slope * (float)(t - key); }
        sc[key] = s; mx = fmaxf(mx, s); }
    mx = wave_max(mx);
    WFENCE();
    float l = 0.f;
    for (int i = lane; i < nch * 64; i += 64) { const float p = __expf(sc[i] - mx); sc[i] = p; l += p; }
    l = wave_sum(l);
    WFENCE();
    float o0 = 0.f, o1 = 0.f, o2 = 0.f, o3 = 0.f;
    const bf16_t* vr = proj + (size_t)(b * SEQ) * NC + C_VB + h * 256 + 4 * lane;
    for (int k = 0; k <= t; ++k) { const float p = sc[k]; const u32x2 vv = *(const u32x2*)(vr + (size_t)k * NC);
        o0 += p * bflo(vv.x); o1 += p * bfhi(vv.x); o2 += p * bflo(vv.y); o3 += p * bfhi(vv.y); }
    const float inv = 1.0f / l;
    WFENCE();
    return (f32x4){o0 * inv, o1 * inv, o2 * inv, o3 * inv};
}
__device__ __forceinline__ void diff_combine_task(const float* scr, const bf16_t* proj, float lam, float lam_init, const float* subg, bf16_t* Y1, int id, int lane) {
    const int h = id & 3, bt = id >> 2;
    const f32x4 a = *(const f32x4*)(scr + ((size_t)(bt * 4 + h) * 2 + 0) * 256 + 4 * lane), c = *(const f32x4*)(scr + ((size_t)(bt * 4 + h) * 2 + 1) * 256 + 4 * lane);
    const f32x4 o = a - c * lam;
    const float ms = wave_sum((o[0] * o[0] + o[1] * o[1]) + (o[2] * o[2] + o[3] * o[3])) * (1.0f / 256.0f);
    const float rs = (1.0f / sqrtf(ms + RMS_EPS)) * (1.0f - lam_init);
    const f32x4 gg = *(const f32x4*)(subg + 4 * lane);
    const u32x2 zz = *(const u32x2*)(proj + (size_t)bt * NC + C_ZB + h * 256 + 4 * lane);
    u32x2 w; w.x = pk2(o[0] * rs * gg[0] * bflo(zz.x), o[1] * rs * gg[1] * bfhi(zz.x)); w.y = pk2(o[2] * rs * gg[2] * bflo(zz.y), o[3] * rs * gg[3] * bfhi(zz.y));
    *(u32x2*)(Y1 + (size_t)bt * YS + h * 256 + 4 * lane) = w;
}
__device__ __forceinline__ void sgu_ln_task(const bf16_t* proj, const float* lng, const float* lnb, float* VN, int bt, int lane) {
    float v[16]; float s = 0.f;
#pragma unroll
    for (int i = 0; i < 16; ++i) { v[i] = bf2f(proj[(size_t)bt * NC + C_VC + lane + 64 * i]); s += v[i]; }
    const float mu = wave_sum(s) * (1.0f / 1024.0f); float q = 0.f;
#pragma unroll
    for (int i = 0; i < 16; ++i) { v[i] -= mu; q += v[i] * v[i]; }
    const float rstd = 1.0f / sqrtf(wave_sum(q) * (1.0f / 1024.0f) + LN_EPS);
#pragma unroll
    for (int i = 0; i < 16; ++i) { const int c = lane + 64 * i; VN[(size_t)bt * BW + c] = v[i] * rstd * lng[c] + lnb[c]; }
}
__device__ __forceinline__ void sgu_mix_elem(const bf16_t* proj, const float* VN, const float* sw, const float* sb, bf16_t* Y2, int idx) {
    const int c = idx & 1023, bt = idx >> 10, g = c >> 7, t = bt & 2047, tl = t & 127, r0 = bt - tl;
    const float* wrow = sw + ((size_t)g * 128 + tl) * 128; float acc = 0.f;
    for (int s = 0; s <= tl; ++s) acc += wrow[s] * VN[(size_t)(r0 + s) * BW + c];
    acc += sb[g * 128 + tl];
    const float u = bf2f(proj[(size_t)bt * NC + C_UC + c]), z = bf2f(proj[(size_t)bt * NC + C_ZC + c]);
    Y2[(size_t)bt * BW + c] = (bf16_t)f2bf(u * acc * z);
}
__device__ __forceinline__ void memattn_task(const bf16_t* proj, const bf16_t* mkv, bf16_t* Y3, int id, int lane, LAS float* wl) {
    LAS float* qs = wl; LAS float* sc = wl + 256;
    const int h = id & 3, bt = id >> 2, b = bt >> 11;
    const u32x2 qq = *(const u32x2*)(proj + (size_t)bt * NC + C_QM + h * 256 + 4 * lane);
    qs[4 * lane] = bflo(qq.x); qs[4 * lane + 1] = bfhi(qq.x); qs[4 * lane + 2] = bflo(qq.y); qs[4 * lane + 3] = bfhi(qq.y);
    WFENCE();
    float mx = -INFINITY;
    for (int c = 0; c < 4; ++c) { const int key = c * 64 + lane; const bf16_t* kr = mkv + (size_t)(b * MEML + key) * 2048 + h * 256; float d = 0.f;
#pragma unroll 4
        for (int i = 0; i < 32; ++i) d += dot8(*(const u32x4*)(kr + 8 * i), qs + 8 * i);
        const float s = d * 0.0625f; sc[key] = s; mx = fmaxf(mx, s); }
    mx = wave_max(mx);
    WFENCE();
    float l = 0.f;
    for (int i = lane; i < 256; i += 64) { const float p = __expf(sc[i] - mx); sc[i] = p; l += p; }
    l = wave_sum(l);
    WFENCE();
    float o0 = 0.f, o1 = 0.f, o2 = 0.f, o3 = 0.f;
    const bf16_t* vr = mkv + (size_t)(b * MEML) * 2048 + 1024 + h * 256 + 4 * lane;
    for (int k = 0; k < 256; ++k) { const float p = sc[k]; const u32x2 vv = *(const u32x2*)(vr + (size_t)k * 2048);
        o0 += p * bflo(vv.x); o1 += p * bfhi(vv.x); o2 += p * bflo(vv.y); o3 += p * bfhi(vv.y); }
    const float inv = 1.0f / l;
    const u32x2 zz = *(const u32x2*)(proj + (size_t)bt * NC + C_ZM + h * 256 + 4 * lane);
    u32x2 w; w.x = pk2(o0 * inv * bflo(zz.x), o1 * inv * bfhi(zz.x)); w.y = pk2(o2 * inv * bflo(zz.y), o3 * inv * bfhi(zz.y));
    *(u32x2*)(Y3 + (size_t)bt * BW + h * 256 + 4 * lane) = w;
    WFENCE();
}
__device__ __forceinline__ void final_rows(const bf16_t* x, const float* ss, const float* g, float* out, int r0, int step, int lane) {
    f32x4 gv[16]; u32x4 va[8], vb[8];
#pragma unroll
    for (int j = 0; j < 8; ++j) { gv[2 * j] = ((const f32x4*)g)[2 * (64 * j + lane)]; gv[2 * j + 1] = ((const f32x4*)g)[2 * (64 * j + lane) + 1]; }
    float sa = 0.f, sb = 0.f;
    if (r0 < MT) { sa = ss[r0];
#pragma unroll
        for (int j = 0; j < 8; ++j) va[j] = ((const u32x4*)(x + (size_t)r0 * DM))[64 * j + lane]; }
    asm volatile("" ::: "memory");
#define FIN_STORE(V, S, R) do { const float rs = __builtin_amdgcn_rsqf((S) * (1.0f / DM) + RMS_EPS); f32x4* o = (f32x4*)(out + (size_t)(R) * DM); \
        _Pragma("unroll") for (int j = 0; j < 8; ++j) { \
            o[2 * (64 * j + lane)]     = (f32x4){bflo(V[j].x), bfhi(V[j].x), bflo(V[j].y), bfhi(V[j].y)} * rs * gv[2 * j]; \
            o[2 * (64 * j + lane) + 1] = (f32x4){bflo(V[j].z), bfhi(V[j].z), bflo(V[j].w), bfhi(V[j].w)} * rs * gv[2 * j + 1]; } } while (0)
    for (int r = r0; r < MT; r += 2 * step) {
        const int r1 = r + step, r2 = r + 2 * step;
        if (r1 < MT) { sb = ss[r1];
#pragma unroll
            for (int j = 0; j < 8; ++j) vb[j] = ((const u32x4*)(x + (size_t)r1 * DM))[64 * j + lane]; }
        asm volatile("" ::: "memory");
        FIN_STORE(va, sa, r);
        if (r1 >= MT) break;
        if (r2 < MT) { sa = ss[r2];
#pragma unroll
            for (int j = 0; j < 8; ++j) va[j] = ((const u32x4*)(x + (size_t)r2 * DM))[64 * j + lane]; }
        asm volatile("" ::: "memory");
        FIN_STORE(vb, sb, r1);
    }
#undef FIN_STORE
}

namespace att {
typedef short bf16x8 __attribute__((ext_vector_type(8)));
typedef short s16x4 __attribute__((ext_vector_type(4)));
typedef float f32x16 __attribute__((ext_vector_type(16)));
typedef short v4i16_t __attribute__((ext_vector_type(4)));
constexpr int KVBLK = 64, QBLK = 32, SHM_V = KVBLK * 128 * 2, SHM_K = KVBLK * 128 * 2;
constexpr int OFF_K = 2 * SHM_V, OFF_WS = 2 * SHM_V + 2 * SHM_K, OFF_KM = OFF_WS + 8 * 64 * 4, LDS_NEED = OFF_KM + 8 * 128 * 4;
constexpr float LOG2E = 1.4426950408889634f, SCALE = 0.08838834764831845f, CS = SCALE * LOG2E, THRL = 8.0f * LOG2E;
#define ATT_KSWZ(row, colB) ((row) * 256 + ((colB) ^ (((row) & 7) << 4)))
#define ATT_SBAR() __builtin_amdgcn_sched_barrier(0)
__device__ __forceinline__ int crow(int r, int hi) { return (r & 3) + 8 * (r >> 2) + 4 * hi; }
__device__ __forceinline__ unsigned cvtpk(float lo, float hi) { return pg8::cvt_pk_bf16(lo, hi); }
__device__ __forceinline__ int v_st(int k, int c) { const int kk = (k & ~0xC) | ((k & 4) << 1) | ((k & 8) >> 1); return ((kk >> 3) * 4 + (c >> 5)) * 512 + ((kk & 7) * 32 + (c & 31)) * 2; }
__device__ __forceinline__ int v_rd_base(int lane) { return ((lane & 3) << 3) | (((lane >> 2) & 3) << 6) | (((lane >> 4) & 1) << 5) | (((lane >> 5) & 1) << 8); }
constexpr int v_rd_off(int d0, int ks, int half) { return d0 * 512 + ks * 4096 + half * 2048; }
__device__ __forceinline__ s16x4 tr_read(LAS const unsigned char* p) { return __builtin_bit_cast(s16x4, __builtin_amdgcn_ds_read_tr16_b64_v4i16((LAS v4i16_t*)p)); }

__device__ __forceinline__ void qkt(f32x16& p0, f32x16& p1, LAS const unsigned char* Ks, const bf16x8* qr, int r32, int hi) {
    p0 = f32x16{}; p1 = f32x16{};
#pragma unroll
    for (int d0 = 0; d0 < 8; ++d0) { const int cb = (d0 * 16 + hi * 8) * 2;
        const bf16x8 b0 = *(LAS const bf16x8*)(Ks + ATT_KSWZ(r32, cb));
        const bf16x8 b1 = *(LAS const bf16x8*)(Ks + ATT_KSWZ(32 + r32, cb));
        p0 = __builtin_amdgcn_mfma_f32_32x32x16_bf16(b0, qr[d0], p0, 0, 0, 0);
        p1 = __builtin_amdgcn_mfma_f32_32x32x16_bf16(b1, qr[d0], p1, 0, 0, 0); }
}
__device__ __forceinline__ void partialSM(f32x16& p0, f32x16& p1, float& m_reg, float& mn, float& alpha, int dq, float slopeL, bool diag, bool rowmasked) {
    const float NEG = -__builtin_inff(); const float a0 = -slopeL * (float)dq;
#pragma unroll
    for (int r = 0; r < 16; ++r) { const int c = (r & 3) + 8 * (r >> 2);
        p0[r] = fmaf(p0[r], CS, fmaf(slopeL, (float)c, a0)); p1[r] = fmaf(p1[r], CS, fmaf(slopeL, (float)(c + 32), a0)); }
    if (diag) { asm volatile("" ::: "memory");
#pragma unroll
        for (int r = 0; r < 16; ++r) { const int c = (r & 3) + 8 * (r >> 2); if (c > dq) p0[r] = NEG; if (c + 32 > dq) p1[r] = NEG; } }
    if (rowmasked) {
#pragma unroll
        for (int r = 0; r < 16; ++r) { p0[r] = NEG; p1[r] = NEG; } }
    float pmax = p0[0];
#pragma unroll
    for (int r = 1; r < 16; ++r) pmax = fmaxf(pmax, p0[r]);
#pragma unroll
    for (int r = 0; r < 16; ++r) pmax = fmaxf(pmax, p1[r]);
    { auto rr = __builtin_amdgcn_permlane32_swap(__float_as_uint(pmax), __float_as_uint(pmax), false, false);
      pmax = fmaxf(__uint_as_float(rr[0]), __uint_as_float(rr[1])); }
    if (__builtin_expect(__all(pmax - m_reg <= THRL), 1)) { mn = m_reg; alpha = 1.f; }
    else { mn = fmaxf(m_reg, pmax); alpha = __builtin_amdgcn_exp2f(m_reg - mn); m_reg = mn; }
#pragma unroll
    for (int r = 0; r < 16; ++r) { p0[r] = p0[r] - mn; p1[r] = p1[r] - mn; }
#pragma unroll
    for (int r = 0; r < 16; ++r) p0[r] = __builtin_amdgcn_exp2f(p0[r]);
}
__device__ __forceinline__ void finishSM(f32x16& p0, f32x16& p1, float alpha, float& l_reg, bf16x8& pa0, bf16x8& pa1, bf16x8& pa2, bf16x8& pa3) {
#pragma unroll
    for (int r = 0; r < 16; ++r) p1[r] = __builtin_amdgcn_exp2f(p1[r]);
    float ps = 0;
#pragma unroll
    for (int r = 0; r < 16; ++r) ps += p0[r];
#pragma unroll
    for (int r = 0; r < 16; ++r) ps += p1[r];
    { auto rr = __builtin_amdgcn_permlane32_swap(__float_as_uint(ps), __float_as_uint(ps), false, false);
      ps = __uint_as_float(rr[0]) + __uint_as_float(rr[1]); }
    l_reg = l_reg * alpha + ps;
#define ATT_PK4(P, BASE, OUT) do { const unsigned a0_ = cvtpk(P[BASE + 0], P[BASE + 1]), a1_ = cvtpk(P[BASE + 2], P[BASE + 3]);   \
    const unsigned b0_ = cvtpk(P[BASE + 4], P[BASE + 5]), b1_ = cvtpk(P[BASE + 6], P[BASE + 7]);                              \
    auto r0_ = __builtin_amdgcn_permlane32_swap(a0_, b0_, false, false); auto r1_ = __builtin_amdgcn_permlane32_swap(a1_, b1_, false, false); \
    u32x4 w_ = {r0_[0], r1_[0], r0_[1], r1_[1]}; OUT = __builtin_bit_cast(bf16x8, w_); } while (0)
    ATT_PK4(p0, 0, pa0); ATT_PK4(p0, 8, pa1); ATT_PK4(p1, 0, pa2); ATT_PK4(p1, 8, pa3);
#undef ATT_PK4
}
template <int D0> __device__ __forceinline__ void pv_one(f32x16& od, LAS const unsigned char* vb, bf16x8 pa0, bf16x8 pa1, bf16x8 pa2, bf16x8 pa3) {
    const s16x4 l0 = tr_read(vb + v_rd_off(D0, 0, 0)), h0 = tr_read(vb + v_rd_off(D0, 0, 1)), l1 = tr_read(vb + v_rd_off(D0, 1, 0)), h1 = tr_read(vb + v_rd_off(D0, 1, 1));
    const s16x4 l2 = tr_read(vb + v_rd_off(D0, 2, 0)), h2 = tr_read(vb + v_rd_off(D0, 2, 1)), l3 = tr_read(vb + v_rd_off(D0, 3, 0)), h3 = tr_read(vb + v_rd_off(D0, 3, 1));
#define ATT_PK(L, H) (bf16x8){L[0], L[1], L[2], L[3], H[0], H[1], H[2], H[3]}
    od = __builtin_amdgcn_mfma_f32_32x32x16_bf16(pa0, ATT_PK(l0, h0), od, 0, 0, 0);
    od = __builtin_amdgcn_mfma_f32_32x32x16_bf16(pa1, ATT_PK(l1, h1), od, 0, 0, 0);
    od = __builtin_amdgcn_mfma_f32_32x32x16_bf16(pa2, ATT_PK(l2, h2), od, 0, 0, 0);
    od = __builtin_amdgcn_mfma_f32_32x32x16_bf16(pa3, ATT_PK(l3, h3), od, 0, 0, 0);
#undef ATT_PK
}
__device__ __forceinline__ void pv_d0(f32x16* o, LAS const unsigned char* vb, bf16x8 pa0, bf16x8 pa1, bf16x8 pa2, bf16x8 pa3) {
    pv_one<0>(o[0], vb, pa0, pa1, pa2, pa3); pv_one<1>(o[1], vb, pa0, pa1, pa2, pa3); pv_one<2>(o[2], vb, pa0, pa1, pa2, pa3); pv_one<3>(o[3], vb, pa0, pa1, pa2, pa3);
}

__device__ __forceinline__ float knt(const float* kn2, int t) { const f32x4 p = *(const f32x4*)(kn2 + 4 * t); return sqrtf((p[0] + p[1]) + (p[2] + p[3])) * 1.005f; }
struct UnitDesc {
    const bf16_t* Q;
    const bf16_t* K;
    const bf16_t* V;
    int q0;
    int nt;
    float slopeL;
    int moba_j;
    const float* kmean;
    int kt0_in; LAS unsigned* kt0_out;
    const float* knorm;
};
template <bool MOBA>
__device__ __forceinline__ void run_unit(const UnitDesc& U, LAS unsigned char* lds, f32x16 (&o)[4], float (&rli)[16]) {
    int tid_l = threadIdx.x; asm volatile("" : "+v"(tid_l));
    const int tid = tid_l, wid = __builtin_amdgcn_readfirstlane(tid >> 6), lane = tid & 63, r32 = lane & 31, hi = lane >> 5;
    LAS unsigned char* V_lds = lds; LAS unsigned char* K_lds = lds + OFF_K;
    LAS float* wsf = (LAS float*)(lds + OFF_WS) + wid * 64; LAS float* li_l = wsf; LAS float* al_l = wsf + 32;
    float m_reg = -1e30f, l_reg = 0.f; bf16x8 qr[8];
#pragma unroll
    for (int d = 0; d < 4; ++d) o[d] = f32x16{};
    const bf16_t* Qw = U.Q + (size_t)(wid * QBLK + r32) * NC + hi * 8;
#pragma unroll
    for (int d0 = 0; d0 < 8; ++d0) qr[d0] = *(const bf16x8*)(Qw + d0 * 16);
    int qpos = U.q0 + wid * QBLK + r32, qlo = U.q0 + wid * QBLK;
    unsigned sel = 0xffffffffu;
    if (MOBA && U.moba_j > 3) {
        const int j = U.moba_j; LAS float* km = (LAS float*)(lds + OFF_KM);
        for (int i = tid; i < j * 128; i += 512) { const float* kp = U.kmean + (i >> 7) * 256 + (i & 127); km[i] = kp[0] + kp[128]; }
        __syncthreads();
        float g[8];
#pragma unroll
        for (int n = 0; n < 8; ++n) { g[n] = 0.f;
            if (n < j) { float s = 0.f;
#pragma unroll
                for (int d0 = 0; d0 < 8; ++d0) { const LAS float* kp = km + n * 128 + d0 * 16 + hi * 8; const f32x4 k0 = *(LAS const f32x4*)kp, k1 = *(LAS const f32x4*)(kp + 4);
                    const u32x4 qq = __builtin_bit_cast(u32x4, qr[d0]);
                    s += bflo(qq.x) * k0[0] + bfhi(qq.x) * k0[1] + bflo(qq.y) * k0[2] + bfhi(qq.y) * k0[3] + bflo(qq.z) * k1[0] + bfhi(qq.z) * k1[1] + bflo(qq.w) * k1[2] + bfhi(qq.w) * k1[3]; }
                auto rr = __builtin_amdgcn_permlane32_swap(__float_as_uint(s), __float_as_uint(s), false, false);
                g[n] = __uint_as_float(rr[0]) + __uint_as_float(rr[1]); } }
        sel = 0u;
#pragma unroll
        for (int n = 0; n < 8; ++n) { int rank = 0;
#pragma unroll
            for (int m = 0; m < 8; ++m) if (m != n) rank += (m < j && (g[m] > g[n] || (g[m] == g[n] && m < n))) ? 1 : 0;
            if (n < j && rank < 3) sel |= 1u << n; }
        sel |= 1u << j;
        __syncthreads();
    }
    int kt0 = 0;
    if (!MOBA && U.knorm != nullptr && U.kt0_in >= 0) kt0 = U.kt0_in;
    else if (!MOBA && U.knorm != nullptr) {
        LAS float* wm = (LAS float*)(lds + OFF_KM); LAS int* tmin = (LAS int*)(lds + OFF_KM + 64);
        float q2 = 0.f;
#pragma unroll
        for (int d0 = 0; d0 < 8; ++d0) { const u32x4 qq = __builtin_bit_cast(u32x4, qr[d0]);
            q2 += (bflo(qq.x) * bflo(qq.x) + bfhi(qq.x) * bfhi(qq.x)) + (bflo(qq.y) * bflo(qq.y) + bfhi(qq.y) * bfhi(qq.y)) + (bflo(qq.z) * bflo(qq.z) + bfhi(qq.z) * bfhi(qq.z)) + (bflo(qq.w) * bflo(qq.w) + bfhi(qq.w) * bfhi(qq.w)); }
        q2 += __shfl_xor(q2, 32);
#pragma unroll
        for (int off = 1; off < 32; off <<= 1) q2 = fmaxf(q2, __shfl_xor(q2, off));
        if (lane == 0) wm[wid] = q2;
        __syncthreads();
        if (wid == 0) {
            float qm = wm[0];
#pragma unroll
            for (int w = 1; w < 8; ++w) qm = fmaxf(qm, wm[w]);
            const float qc = sqrtf(qm) * (CS * 1.0005f); const int NTd = U.nt - 4;
            const float kown = fmaxf(fmaxf(knt(U.knorm, NTd), knt(U.knorm, NTd + 1)), fmaxf(knt(U.knorm, NTd + 2), knt(U.knorm, NTd + 3)));
            bool ns = false;
            if (lane < NTd) ns = !(U.slopeL * (float)(U.q0 - KVBLK * lane - (KVBLK - 1)) > fmaf(qc, knt(U.knorm, lane) + kown, 35.0f));
            const unsigned long long mk = __ballot(ns);
            if (lane == 0) *tmin = (mk ? (int)__builtin_ctzll(mk) : NTd) & ~1;
        }
        __syncthreads();
        kt0 = *tmin;
        __syncthreads();
        if (tid == 0) *U.kt0_out = (unsigned)kt0;
    }
    const int sr = tid >> 4, sc = (tid & 15) * 8, vst0 = v_st(sr, sc), vst1 = v_st(32 + sr, sc), kst0 = ATT_KSWZ(sr, sc * 2), kst1 = ATT_KSWZ(32 + sr, sc * 2);
    LAS const unsigned char* vb0 = V_lds + v_rd_base(lane);
    const bf16_t* Kh = U.K + (size_t)(sr + kt0 * KVBLK) * NC + sc; const bf16_t* Vh = U.V + (size_t)(sr + kt0 * KVBLK) * NC + sc;
    qpos -= kt0 * KVBLK; qlo -= kt0 * KVBLK;
    bf16x8 sA_v0, sA_v1, sA_k0, sA_k1, sB_v0, sB_v1, sB_k0, sB_k1;
#define ATT_SLOAD(S, k0) do { S##_v0 = *(const bf16x8*)(Vh + (size_t)(k0) * NC); S##_v1 = *(const bf16x8*)(Vh + (size_t)((k0) + 32) * NC); \
    S##_k0 = *(const bf16x8*)(Kh + (size_t)(k0) * NC); S##_k1 = *(const bf16x8*)(Kh + (size_t)((k0) + 32) * NC); } while (0)
#define ATT_SWRITE(b, S) do { *(LAS bf16x8*)(V_lds + (b) * SHM_V + vst0) = S##_v0; *(LAS bf16x8*)(V_lds + (b) * SHM_V + vst1) = S##_v1; \
    *(LAS bf16x8*)(K_lds + (b) * SHM_K + kst0) = S##_k0; *(LAS bf16x8*)(K_lds + (b) * SHM_K + kst1) = S##_k1; } while (0)
#define ATT_SWAIT() asm volatile("s_waitcnt vmcnt(4)" ::: "memory")
#define ATT_RESC(a) do { if (__any((a) < 1.f)) { if (hi == 0) al_l[r32] = (a); asm volatile("s_waitcnt lgkmcnt(0)" ::: "memory"); \
    _Pragma("unroll") for (int d_ = 0; d_ < 4; ++d_) _Pragma("unroll") for (int r = 0; r < 16; ++r) o[d_][r] *= al_l[crow(r, hi)]; } } while (0)
#define ATT_PSM(P0, P1, MN, AL, t) partialSM(P0, P1, m_reg, MN, AL, qpos - (t) * KVBLK - 4 * hi, U.slopeL, (t) * KVBLK + KVBLK - 1 > qlo, MOBA && ((t) >> 2) < U.moba_j && !((sel >> ((t) >> 2)) & 1u))
    f32x16 pA0, pA1, pB0, pB1; float mnA, mnB, alA, alB; bf16x8 pa0, pa1, pa2, pa3; const int NT = U.nt - kt0;
    ATT_SLOAD(sA, 0); ATT_SLOAD(sB, KVBLK); ATT_SWAIT(); ATT_SWRITE(0, sA); __syncthreads();
    qkt(pA0, pA1, K_lds, qr, r32, hi); ATT_PSM(pA0, pA1, mnA, alA, 0);
    ATT_SLOAD(sA, 2 * KVBLK);
    ATT_SWAIT(); ATT_SWRITE(1, sB); __syncthreads();
    for (int j = 1; j + 1 < NT; j += 2) {
        ATT_SBAR(); qkt(pB0, pB1, K_lds + SHM_K, qr, r32, hi);
        finishSM(pA0, pA1, alA, l_reg, pa0, pa1, pa2, pa3); ATT_SBAR();
        ATT_SLOAD(sB, (j + 2) * KVBLK); ATT_SBAR();
        pv_d0(o, vb0, pa0, pa1, pa2, pa3); ATT_PSM(pB0, pB1, mnB, alB, j);
        __syncthreads(); ATT_SWAIT(); ATT_SWRITE(0, sA);
        ATT_RESC(alB); __syncthreads();
        ATT_SBAR(); qkt(pA0, pA1, K_lds, qr, r32, hi);
        finishSM(pB0, pB1, alB, l_reg, pa0, pa1, pa2, pa3); ATT_SBAR();
        if (j + 3 < NT) ATT_SLOAD(sA, (j + 3) * KVBLK);
        ATT_SBAR();
        pv_d0(o, vb0 + SHM_V, pa0, pa1, pa2, pa3); ATT_PSM(pA0, pA1, mnA, alA, j + 1);
        __syncthreads(); ATT_SWAIT(); ATT_SWRITE(1, sB);
        ATT_RESC(alA); __syncthreads();
    }
    ATT_SBAR(); qkt(pB0, pB1, K_lds + SHM_K, qr, r32, hi);
    finishSM(pA0, pA1, alA, l_reg, pa0, pa1, pa2, pa3); ATT_SBAR();
    pv_d0(o, vb0, pa0, pa1, pa2, pa3); ATT_PSM(pB0, pB1, mnB, alB, NT - 1);
    __syncthreads(); ATT_RESC(alB);
    finishSM(pB0, pB1, alB, l_reg, pa0, pa1, pa2, pa3); ATT_SBAR();
    pv_d0(o, vb0 + SHM_V, pa0, pa1, pa2, pa3);
    if (hi == 0) li_l[r32] = l_reg;
    asm volatile("s_waitcnt lgkmcnt(0)" ::: "memory");
#pragma unroll
    for (int r = 0; r < 16; ++r) rli[r] = 1.0f / li_l[crow(r, hi)];
    __syncthreads();
#undef ATT_SLOAD
#undef ATT_SWRITE
#undef ATT_SWAIT
#undef ATT_RESC
#undef ATT_PSM
}
}

namespace sgu {
__device__ __forceinline__ void unit(const bf16_t* proj, const float* stats  , const float* lng, const float* lnb, const float* sw, const float* sb, bf16_t* Y2, int un, LAS unsigned char* lds) {
    int tid_l = threadIdx.x; asm volatile("" : "+v"(tid_l));
    const int tid = tid_l, wid = __builtin_amdgcn_readfirstlane(tid >> 6), lane = tid & 63, r32 = lane & 31, hi = lane >> 5;
    const int g = un & 7, R0 = (un >> 3) * 128;
    const int tb = wid & 3, eh = wid >> 2, t = tb * 32 + r32;
    f32x4 wv[16]; unsigned uu[32], zq[32]; float bias[16];
#pragma unroll
    for (int i = 0; i < 8; ++i) { const int s0 = (i >> 2) * 64 + 16 * (i & 3) + hi * 8; const float* wp = sw + ((size_t)g * 128 + t) * 128 + s0; wv[2 * i] = *(const f32x4*)wp; wv[2 * i + 1] = *(const f32x4*)(wp + 4); }
#pragma unroll
    for (int r = 0; r < 16; ++r) { const int tr = tb * 32 + att::crow(r, hi), bt = R0 + tr; bias[r] = sb[g * 128 + tr];
#pragma unroll
        for (int d = 0; d < 2; ++d) { const int ch = g * 128 + (2 * eh + d) * 32 + (r32 & ~1); uu[r * 2 + d] = *(const unsigned*)(proj + (size_t)bt * NC + C_UC + ch); zq[r * 2 + d] = *(const unsigned*)(proj + (size_t)bt * NC + C_ZC + ch); } }
    { const int sr = tid >> 4, sc = (tid & 15) * 8, ch = g * 128 + sc;
      const f32x4 g0 = *(const f32x4*)(lng + ch), g1 = *(const f32x4*)(lng + ch + 4), b0 = *(const f32x4*)(lnb + ch), b1 = *(const f32x4*)(lnb + ch + 4);
      float mus[4], rss[4];
      { float2 pp[4];
#pragma unroll
        for (int q = 0; q < 4; ++q) pp[q] = *(const float2*)(stats + ((size_t)(R0 + sr + 32 * q) * 16 + (tid & 15)) * 2);
        asm volatile("" ::: "memory");
#pragma unroll
        for (int q = 0; q < 4; ++q) { float s1 = pp[q].x, s2 = pp[q].y;
#pragma unroll
            for (int off = 1; off < 16; off <<= 1) { s1 += __shfl_xor(s1, off); s2 += __shfl_xor(s2, off); }
            mus[q] = s1 * (1.0f / 1024.0f); rss[q] = __builtin_amdgcn_rsqf(fmaxf(s2 * (1.0f / 1024.0f) - mus[q] * mus[q], 0.f) + LN_EPS); } }
#pragma unroll
      for (int q = 0; q < 4; ++q) { const int s = sr + 32 * q, row = R0 + s; const u32x4 vv = *(const u32x4*)(proj + (size_t)row * NC + C_VC + ch);
          const float mu = mus[q], rs = rss[q];
          u32x4 w; w.x = pg8::cvt_pk_bf16((bflo(vv.x) - mu) * rs * g0[0] + b0[0], (bfhi(vv.x) - mu) * rs * g0[1] + b0[1]); w.y = pg8::cvt_pk_bf16((bflo(vv.y) - mu) * rs * g0[2] + b0[2], (bfhi(vv.y) - mu) * rs * g0[3] + b0[3]);
          w.z = pg8::cvt_pk_bf16((bflo(vv.z) - mu) * rs * g1[0] + b1[0], (bfhi(vv.z) - mu) * rs * g1[1] + b1[1]); w.w = pg8::cvt_pk_bf16((bflo(vv.w) - mu) * rs * g1[2] + b1[2], (bfhi(vv.w) - mu) * rs * g1[3] + b1[3]);
          *(LAS u32x4*)(lds + (s >> 6) * att::SHM_V + att::v_st(s & 63, sc)) = w; } }
    __syncthreads();
    att::f32x16 o0 = att::f32x16{}, o1 = att::f32x16{};
    LAS const unsigned char* vb = lds + att::v_rd_base(lane);
#pragma unroll
    for (int st = 0; st < 2; ++st) {
        if (st * 64 > tb * 32 + 31) continue;
        att::bf16x8 pa[4];
#pragma unroll
        for (int k = 0; k < 4; ++k) { const int s0 = st * 64 + 16 * k + hi * 8; const f32x4 w0 = wv[2 * (st * 4 + k)], w1 = wv[2 * (st * 4 + k) + 1];
            float x[8] = {w0[0], w0[1], w0[2], w0[3], w1[0], w1[1], w1[2], w1[3]};
#pragma unroll
            for (int j = 0; j < 8; ++j) x[j] = (s0 + j <= t) ? x[j] : 0.f;
            u32x4 p; p.x = pg8::cvt_pk_bf16(x[0], x[1]); p.y = pg8::cvt_pk_bf16(x[2], x[3]); p.z = pg8::cvt_pk_bf16(x[4], x[5]); p.w = pg8::cvt_pk_bf16(x[6], x[7]); pa[k] = __builtin_bit_cast(att::bf16x8, p); }
        if (eh == 0) { att::pv_one<0>(o0, vb + st * att::SHM_V, pa[0], pa[1], pa[2], pa[3]); att::pv_one<1>(o1, vb + st * att::SHM_V, pa[0], pa[1], pa[2], pa[3]); }
        else         { att::pv_one<2>(o0, vb + st * att::SHM_V, pa[0], pa[1], pa[2], pa[3]); att::pv_one<3>(o1, vb + st * att::SHM_V, pa[0], pa[1], pa[2], pa[3]); }
    }
    {
      asm volatile("" ::: "memory");
#pragma unroll
      for (int r = 0; r < 16; ++r) { const int bt = R0 + tb * 32 + att::crow(r, hi);
#pragma unroll
          for (int d = 0; d < 2; ++d) { const float val = (d == 0 ? o0[r] : o1[r]) + bias[r], vn = __shfl_xor(val, 1); const int ch = g * 128 + (2 * eh + d) * 32 + r32;
              if ((r32 & 1) == 0) *(unsigned*)(Y2 + (size_t)bt * YS + ch) = pk2(val * bflo(uu[r * 2 + d]) * bflo(zq[r * 2 + d]), vn * bfhi(uu[r * 2 + d]) * bfhi(zq[r * 2 + d])); } } }
    __syncthreads();
}
}

namespace memat {
__device__ __forceinline__ void task(const bf16_t* proj, const bf16_t* mk, const bf16_t* mvt, bf16_t* Y3, int tk, int lane) {
    const int rb = tk & 63, h = (tk >> 6) & 3, b = tk >> 8, r32 = lane & 31, hi = lane >> 5, bt0 = b * SEQ + rb * 32;
    att::bf16x8 qr[16];
    const bf16_t* qp = proj + (size_t)(bt0 + r32) * NC + C_QM + h * 256 + hi * 8;
#pragma unroll
    for (int d0 = 0; d0 < 16; ++d0) qr[d0] = *(const att::bf16x8*)(qp + d0 * 16);
    att::f32x16 s[8];
#pragma unroll
    for (int kb = 0; kb < 8; ++kb) { s[kb] = att::f32x16{}; const bf16_t* kp = mk + (size_t)(b * MEML + kb * 32 + r32) * 2048 + h * 256 + hi * 8;
#pragma unroll
        for (int q4 = 0; q4 < 4; ++q4) { att::bf16x8 kf[4];
#pragma unroll
            for (int i = 0; i < 4; ++i) kf[i] = *(const att::bf16x8*)(kp + (q4 * 4 + i) * 16);
            asm volatile("" ::: "memory");
#pragma unroll
            for (int i = 0; i < 4; ++i) s[kb] = __builtin_amdgcn_mfma_f32_32x32x16_bf16(kf[i], qr[q4 * 4 + i], s[kb], 0, 0, 0); } }
    constexpr float C = 0.0625f * att::LOG2E;
    float mx = -__builtin_inff();
#pragma unroll
    for (int kb = 0; kb < 8; ++kb)
#pragma unroll
        for (int r = 0; r < 16; ++r) mx = fmaxf(mx, s[kb][r]);
    { auto rr = __builtin_amdgcn_permlane32_swap(__float_as_uint(mx), __float_as_uint(mx), false, false); mx = fmaxf(__uint_as_float(rr[0]), __uint_as_float(rr[1])); }
    float l = 0.f; const float mc = mx * C;
#pragma unroll
    for (int kb = 0; kb < 8; ++kb)
#pragma unroll
        for (int r = 0; r < 16; ++r) { s[kb][r] = __builtin_amdgcn_exp2f(fmaf(s[kb][r], C, -mc)); l += s[kb][r]; }
    { auto rr = __builtin_amdgcn_permlane32_swap(__float_as_uint(l), __float_as_uint(l), false, false); l = __uint_as_float(rr[0]) + __uint_as_float(rr[1]); }
    const float linv = 1.0f / l;
    att::bf16x8 pa[16];
#define MEM_PK4(P, BASE, OUT) do { const unsigned a0_ = att::cvtpk(P[BASE + 0], P[BASE + 1]), a1_ = att::cvtpk(P[BASE + 2], P[BASE + 3]);   \
    const unsigned b0_ = att::cvtpk(P[BASE + 4], P[BASE + 5]), b1_ = att::cvtpk(P[BASE + 6], P[BASE + 7]);                              \
    auto r0_ = __builtin_amdgcn_permlane32_swap(a0_, b0_, false, false); auto r1_ = __builtin_amdgcn_permlane32_swap(a1_, b1_, false, false); \
    u32x4 w_ = {r0_[0], r1_[0], r0_[1], r1_[1]}; OUT = __builtin_bit_cast(att::bf16x8, w_); } while (0)
#pragma unroll
    for (int kb = 0; kb < 8; ++kb) { MEM_PK4(s[kb], 0, pa[2 * kb]); MEM_PK4(s[kb], 8, pa[2 * kb + 1]); }
#undef MEM_PK4
    float rli[16];
#pragma unroll
    for (int r = 0; r < 16; ++r) rli[r] = __shfl(linv, att::crow(r, hi));
#pragma unroll
    for (int db = 0; db < 8; ++db) { att::f32x16 o = att::f32x16{}; const bf16_t* vp = mvt + ((size_t)((b * 4 + h) * 256 + db * 32 + r32)) * 256 + hi * 8;
        att::bf16x8 vf[16]; unsigned zz[16];
#pragma unroll
        for (int ks = 0; ks < 16; ++ks) vf[ks] = *(const att::bf16x8*)(vp + ks * 16);
#pragma unroll
        for (int r = 0; r < 16; ++r) zz[r] = *(const unsigned*)(proj + (size_t)(bt0 + att::crow(r, hi)) * NC + C_ZM + h * 256 + db * 32 + (r32 & ~1));
        asm volatile("" ::: "memory");
#pragma unroll
        for (int ks = 0; ks < 16; ++ks) o = __builtin_amdgcn_mfma_f32_32x32x16_bf16(pa[ks], vf[ks], o, 0, 0, 0);
#pragma unroll
        for (int r = 0; r < 16; ++r) { const int bt = bt0 + att::crow(r, hi), col = h * 256 + db * 32 + r32; const float val = o[r] * rli[r], vn = __shfl_xor(val, 1);
            if ((r32 & 1) == 0) *(unsigned*)(Y3 + (size_t)bt * YS + col) = pk2(val * bflo(zz[r]), vn * bfhi(zz[r])); } }
}

__device__ __forceinline__ void stage_load(u32x4 (&v)[16], const bf16_t* src, int row_stride, int wave, int lane) {
    const bf16_t* p = src + (size_t)(wave * 2 + (lane >> 5)) * row_stride + (lane & 31) * 8;
#pragma unroll
    for (int i = 0; i < 16; ++i) v[i] = *(const u32x4*)(p + (size_t)(16 * i) * row_stride);
}
__device__ __forceinline__ void stage_store(const u32x4 (&v)[16], LAS unsigned char* lds, int wave, int lane) {
    const int c = lane & 31, r0 = wave * 2 + (lane >> 5);
#pragma unroll
    for (int i = 0; i < 16; ++i) { const int r = r0 + 16 * i; *(LAS u32x4*)(lds + r * 512 + ((c ^ (r & 31)) << 4)) = v[i]; }
}
__device__ __forceinline__ att::bf16x8 frag(LAS const unsigned char* lds, int row, int chunk) { return *(LAS const att::bf16x8*)(lds + row * 512 + ((chunk ^ (row & 31)) << 4)); }
__device__ __forceinline__ void unit(const bf16_t* proj, const bf16_t* mk, const bf16_t* mvt, bf16_t* Y3, int un, LAS unsigned char* lds) {
    int tid_l = threadIdx.x; asm volatile("" : "+v"(tid_l));
    const int tid = tid_l, wave = __builtin_amdgcn_readfirstlane(tid >> 6), lane = tid & 63, r32 = lane & 31, hi = lane >> 5;
    const int tk = un * 8 + wave, rb = tk & 63, h = (tk >> 6) & 3, b = tk >> 8, bt0 = b * SEQ + rb * 32;
    u32x4 st[16]; att::bf16x8 qr[16];
    stage_load(st, mk + (size_t)(b * MEML) * 2048 + h * 256, 2048, wave, lane);
    const bf16_t* qp = proj + (size_t)(bt0 + r32) * NC + C_QM + h * 256 + hi * 8;
#pragma unroll
    for (int d0 = 0; d0 < 16; ++d0) qr[d0] = *(const att::bf16x8*)(qp + d0 * 16);
    asm volatile("" ::: "memory");
    stage_store(st, lds, wave, lane);
    __syncthreads();
    att::f32x16 s[8];
#pragma unroll
    for (int kb = 0; kb < 8; ++kb) { s[kb] = att::f32x16{};
#pragma unroll
        for (int q2 = 0; q2 < 8; ++q2) { att::bf16x8 kf[2]; int rv = r32; asm volatile("" : "+v"(rv));
#pragma unroll
            for (int i = 0; i < 2; ++i) kf[i] = frag(lds, kb * 32 + rv, 2 * (q2 * 2 + i) + hi);
            asm volatile("" ::: "memory");
#pragma unroll
            for (int i = 0; i < 2; ++i) s[kb] = __builtin_amdgcn_mfma_f32_32x32x16_bf16(kf[i], qr[q2 * 2 + i], s[kb], 0, 0, 0); } }
    constexpr float C = 0.0625f * att::LOG2E;
    float mx = -__builtin_inff();
#pragma unroll
    for (int kb = 0; kb < 8; ++kb)
#pragma unroll
        for (int r = 0; r < 16; ++r) mx = fmaxf(mx, s[kb][r]);
    { auto rr = __builtin_amdgcn_permlane32_swap(__float_as_uint(mx), __float_as_uint(mx), false, false); mx = fmaxf(__uint_as_float(rr[0]), __uint_as_float(rr[1])); }
    float l = 0.f; const float mc = mx * C;
#pragma unroll
    for (int kb = 0; kb < 8; ++kb)
#pragma unroll
        for (int r = 0; r < 16; ++r) { s[kb][r] = __builtin_amdgcn_exp2f(fmaf(s[kb][r], C, -mc)); l += s[kb][r]; }
    { auto rr = __builtin_amdgcn_permlane32_swap(__float_as_uint(l), __float_as_uint(l), false, false); l = __uint_as_float(rr[0]) + __uint_as_float(rr[1]); }
    const float linv = 1.0f / l;
    att::bf16x8 pa[16];
#define MEM_PK4(P, BASE, OUT) do { const unsigned a0_ = att::cvtpk(P[BASE + 0], P[BASE + 1]), a1_ = att::cvtpk(P[BASE + 2], P[BASE + 3]);   \
    const unsigned b0_ = att::cvtpk(P[BASE + 4], P[BASE + 5]), b1_ = att::cvtpk(P[BASE + 6], P[BASE + 7]);                              \
    auto r0_ = __builtin_amdgcn_permlane32_swap(a0_, b0_, false, false); auto r1_ = __builtin_amdgcn_permlane32_swap(a1_, b1_, false, false); \
    u32x4 w_ = {r0_[0], r1_[0], r0_[1], r1_[1]}; OUT = __builtin_bit_cast(att::bf16x8, w_); } while (0)
#pragma unroll
    for (int kb = 0; kb < 8; ++kb) { MEM_PK4(s[kb], 0, pa[2 * kb]); MEM_PK4(s[kb], 8, pa[2 * kb + 1]); }
#undef MEM_PK4
#pragma unroll
    for (int i = 0; i < 16; ++i) { u32x4 w_ = __builtin_bit_cast(u32x4, pa[i]); asm volatile("" : "+v"(w_)); pa[i] = __builtin_bit_cast(att::bf16x8, w_); }
    float rli[16];
#pragma unroll
    for (int r = 0; r < 16; ++r) rli[r] = __shfl(linv, att::crow(r, hi));
    stage_load(st, mvt + (size_t)((b * 4 + h) * 256) * 256, 256, wave, lane);
    asm volatile("" ::: "memory");
    __syncthreads();
    stage_store(st, lds, wave, lane);
    __syncthreads();
#pragma unroll
    for (int hf = 0; hf < 4; ++hf) { unsigned zz[32];
#pragma unroll
        for (int dbi = 0; dbi < 2; ++dbi)
#pragma unroll
            for (int r = 0; r < 16; ++r) zz[dbi * 16 + r] = *(const unsigned*)(proj + (size_t)(bt0 + att::crow(r, hi)) * NC + C_ZM + h * 256 + (hf * 2 + dbi) * 32 + (r32 & ~1));
        asm volatile("" ::: "memory");
#pragma unroll
        for (int dbi = 0; dbi < 2; ++dbi) { const int db = hf * 2 + dbi; att::f32x16 o = att::f32x16{};
#pragma unroll
            for (int q4 = 0; q4 < 4; ++q4) { att::bf16x8 vf[4]; int rv = r32; asm volatile("" : "+v"(rv));
#pragma unroll
                for (int i = 0; i < 4; ++i) vf[i] = frag(lds, db * 32 + rv, 2 * (q4 * 4 + i) + hi);
                asm volatile("" ::: "memory");
#pragma unroll
                for (int i = 0; i < 4; ++i) o = __builtin_amdgcn_mfma_f32_32x32x16_bf16(pa[q4 * 4 + i], vf[i], o, 0, 0, 0); }
#pragma unroll
            for (int r = 0; r < 16; ++r) { const int bt = bt0 + att::crow(r, hi), col = h * 256 + db * 32 + r32; const float val = o[r] * rli[r], vn = __shfl_xor(val, 1);
                if ((r32 & 1) == 0) *(unsigned*)(Y3 + (size_t)bt * YS + col) = pk2(val * bflo(zz[dbi * 16 + r]), vn * bfhi(zz[dbi * 16 + r])); } } }
    __syncthreads();
}
}
#define XB_TMO      128
#define XB_XCNT(j)  (256  + 64 * (j))
#define XB_XSUB(j)  (1280 + 64 * (j))
#define XB_XGEN(j)  (2304 + 64 * (j))
#define XB_TOP      3328
#define XB_TOPGEN   3392
#define XCD_BAR_WORDS 3456
#define XB_SPIN_CAP (1u << 18)

__device__ __forceinline__ unsigned xb_ld(unsigned* p)              { return __hip_atomic_load(p, __ATOMIC_RELAXED, __HIP_MEMORY_SCOPE_AGENT); }
__device__ __forceinline__ unsigned xb_add(unsigned* p, unsigned v) { return __hip_atomic_fetch_add(p, v, __ATOMIC_RELAXED, __HIP_MEMORY_SCOPE_AGENT); }
__device__ __forceinline__ unsigned xb_xcc_id() { return (unsigned)__builtin_amdgcn_s_getreg((3 << 11) | 20) & 0xFu; }
#define XB_SPIN(cond, bar) do { unsigned _sp = 0; while (cond) { __builtin_amdgcn_s_sleep(1); \
    if ((++_sp & 255u) == 0u) { if (xb_ld(&(bar)[XB_TMO])) break; if (_sp > XB_SPIN_CAP) { atomicAdd(&(bar)[XB_TMO], 1u); break; } } } } while (0)

struct XcdBarrier {
    unsigned* bar; unsigned x;
    volatile LAS unsigned* st;
};

__device__ __forceinline__ XcdBarrier xcd_barrier_post(unsigned* bar, volatile LAS unsigned* st) {
    XcdBarrier b; b.bar = bar; b.x = xb_xcc_id(); b.st = st;
    if (threadIdx.x == 0) (void)xb_add(&bar[XB_XCNT(b.x)], 1u);
    return b;
}
__device__ __forceinline__ void xcd_barrier_complete(unsigned* bar, unsigned x, unsigned& nloc, unsigned& nx) {
    const unsigned G = gridDim.x * gridDim.y * gridDim.z;
    unsigned sum, cnt, mine, sp = 0u;
    for (;;) {
        sum = 0u; cnt = 0u; mine = 0u;
#pragma unroll
        for (unsigned j = 0; j < 16; ++j) { const unsigned c = xb_ld(&bar[XB_XCNT(j)]); sum += c; cnt += (c > 0u) ? 1u : 0u; mine = (j == x) ? c : mine; }
        if (sum == G) break;
        __builtin_amdgcn_s_sleep(1);
        if ((++sp & 255u) == 0u) { if (xb_ld(&bar[XB_TMO])) break; if (sp > XB_SPIN_CAP) { atomicAdd(&bar[XB_TMO], 1u); break; } }
    }
    nloc = mine > 0u ? mine : 1u; nx = cnt > 0u ? cnt : 1u;
}

__device__ __forceinline__ void xcd_barrier(const XcdBarrier& b) {
    asm volatile("s_waitcnt vmcnt(0)" ::: "memory");
    __syncthreads();
    if (threadIdx.x == 0) {
        unsigned* bar = b.bar;
        __builtin_amdgcn_s_waitcnt(0);
        unsigned nloc = b.st[0], nx = b.st[1];
        if (nloc == 0u) { xcd_barrier_complete(bar, b.x, nloc, nx); b.st[0] = nloc; b.st[1] = nx; }
        const unsigned old = xb_add(&bar[XB_XSUB(b.x)], 1u);
        const unsigned gen = old / nloc;
        if (old + 1u == (gen + 1u) * nloc) {
            __builtin_amdgcn_fence(__ATOMIC_RELEASE, "agent");
            asm volatile("s_waitcnt vmcnt(0)" ::: "memory");
            const unsigned og = xb_add(&bar[XB_TOP], 1u);
            const unsigned tg = og / nx;
            if (og + 1u == (tg + 1u) * nx) xb_add(&bar[XB_TOPGEN], 1u);
            else XB_SPIN(xb_ld(&bar[XB_TOPGEN]) == tg, bar);
            __builtin_amdgcn_fence(__ATOMIC_ACQUIRE, "agent");
            xb_add(&bar[XB_XGEN(b.x)], 1u);
            asm volatile("s_waitcnt vmcnt(0)" ::: "memory");
        } else {
            XB_SPIN(xb_ld(&bar[XB_XGEN(b.x)]) == gen, bar);
            __builtin_amdgcn_fence(__ATOMIC_ACQUIRE, "agent");
            asm volatile("s_waitcnt vmcnt(0)" ::: "memory");
        }
    }
    __syncthreads();
}

__device__ __forceinline__ const float* launder_p(const float* p) { const GAS float* g = (const GAS float*)p; asm volatile("" : "+s"(g)); return (const float*)g; }
#ifndef MK_TWICE
#define MK_TWICE -1
#endif
#define REPS(k, l_) ((MK_TWICE == (k) && (l_) == 0) ? 2 : 1)
#ifndef TP_MODE
#define TP_MODE 0
#endif
#ifndef TP_K
#define TP_K 8
#endif
#define TP_BEGIN(c) do { if (TP_MODE != 0 && (c) && threadIdx.x == 0) MISC[25] = (unsigned)__builtin_amdgcn_s_memrealtime(); } while (0)
#define TP_END(c)   do { if (TP_MODE != 0 && (c) && threadIdx.x == 0) MISC[24] = MISC[24] + ((unsigned)__builtin_amdgcn_s_memrealtime() - MISC[25]); } while (0)
constexpr int CONV_I_IN = (DM / 64) * (NC / 64), CONV_I_MEM = (DM / 64) * (2048 / 64), CONV_I_BR = (4 * BW / 64) * (DM / 64), CONV_I_OUT = (DM / 64) * (DM / 64);
constexpr int CONV_PER_L = CONV_I_IN + CONV_I_MEM + CONV_I_BR + CONV_I_OUT;
#define CONV_DECODE(t_, l_, it_) do { int r_ = (it_); \
    if (r_ < CONV_I_IN) { t_.W = INP(3) + (size_t)(l_) * DM * NC; t_.g = INP(2) + (size_t)(l_) * DM; t_.WT = (bf16_t*)(ws + WS_WIN) + (size_t)(l_) * NC * DM; t_.K = DM; t_.N = NC; } \
    else if ((r_ -= CONV_I_IN) < CONV_I_MEM) { t_.W = INP(5) + (size_t)(l_) * DM * 2048; t_.g = INP(4) + (size_t)(l_) * DM; t_.WT = (bf16_t*)(ws + WS_WMEM) + (size_t)(l_) * 2048 * DM; t_.K = DM; t_.N = 2048; } \
    else if ((r_ -= CONV_I_MEM) < CONV_I_BR) { t_.W = INP(15) + (size_t)(l_) * 4 * BW * DM; t_.g = nullptr; t_.WT = (bf16_t*)(ws + WS_WBR) + (size_t)(l_) * DM * 4 * BW; t_.K = 4 * BW; t_.N = DM; } \
    else { r_ -= CONV_I_BR; t_.W = INP(16) + (size_t)(l_) * DM * DM; t_.g = nullptr; t_.WT = (bf16_t*)(ws + WS_WOUT) + (size_t)(l_) * DM * DM; t_.K = DM; t_.N = DM; } \
    t_.idx = r_; t_.nt = ((l_) > 0 || (it_) >= CONV_P0_ITEMS) ? 1 : 0; } while (0)
#define CONV_RUN(l_, first_, stride_, end_, lane_) do { TPItem ta_, tb_; f32x4 va_[16], vb_[16]; float2 ga_[8], gb_[8]; int it_ = (first_); bool ha_ = it_ < (end_); \
    if (ha_) { CONV_DECODE(ta_, l_, it_); tp_load(ta_, va_, ga_, lane_); } \
    while (ha_) { const int itb_ = it_ + (stride_); const bool hb_ = itb_ < (end_); if (hb_) { CONV_DECODE(tb_, l_, itb_); tp_load(tb_, vb_, gb_, lane_); } \
        tp_store(ta_, va_, ga_, (LAS unsigned char*)wl, lane_); if (!hb_) break; \
        it_ = itb_ + (stride_); ha_ = it_ < (end_); if (ha_) { CONV_DECODE(ta_, l_, it_); tp_load(ta_, va_, ga_, lane_); } \
        tp_store(tb_, vb_, gb_, (LAS unsigned char*)wl, lane_); } } while (0)
static_assert(CONV_PER_L % 32 == 0, "conversion chunks of 32 items");
constexpr int CONV_P0_ITEMS = CONV_I_IN + CONV_I_MEM, CONV_D0 = (CONV_PER_L - CONV_P0_ITEMS) / 32, CONV_NCH = CONV_D0 + CONV_P0_ITEMS / 32;
static_assert(CONV_P0_ITEMS % 32 == 0 && (CONV_PER_L - CONV_P0_ITEMS) % 32 == 0, "chunk alignment");
#define CONV_CHUNK(ch_, lane_) do { if ((ch_) < CONV_D0) CONV_RUN4(0, CONV_P0_ITEMS + (ch_) * 32 + wave * 4, lane_); else CONV_RUN4(DEPTH - 1, ((ch_) - CONV_D0) * 32 + wave * 4, lane_); } while (0)
#define CONV_RUN4(l_, i0_, lane_) do { TPItem t0_, t1_, t2_, t3_; f32x4 va_[16], vb_[16]; float2 ga_[8], gb_[8]; \
    CONV_DECODE(t0_, l_, (i0_)); CONV_DECODE(t1_, l_, (i0_) + 1); tp_load(t0_, va_, ga_, lane_); tp_load(t1_, vb_, gb_, lane_); \
    tp_store(t0_, va_, ga_, (LAS unsigned char*)wl, lane_); CONV_DECODE(t2_, l_, (i0_) + 2); tp_load(t2_, va_, ga_, lane_); \
    tp_store(t1_, vb_, gb_, (LAS unsigned char*)wl, lane_); CONV_DECODE(t3_, l_, (i0_) + 3); tp_load(t3_, vb_, gb_, lane_); \
    tp_store(t2_, va_, ga_, (LAS unsigned char*)wl, lane_); tp_store(t3_, vb_, gb_, (LAS unsigned char*)wl, lane_); } while (0)
struct Args { const float* in[18]; float* out; unsigned char* ws; int ph_lo, ph_hi, li, pad; };
__global__ void __launch_bounds__(NWAVES * 64, 2) mega_fwd(Args args) {
    extern __shared__ __attribute__((aligned(16))) unsigned char lds_raw[];
    LAS unsigned char* lds = (LAS unsigned char*)lds_raw;
    volatile LAS unsigned* MISC = (volatile LAS unsigned*)(lds + MISC_OFF);
    const int G = (int)gridDim.x, NGW = G * NWAVES;
    for (int u = threadIdx.x; u < (LDS_BYTES - LDSCTL_OFF) / 4; u += NWAVES * 64) ((LAS unsigned*)(lds + LDSCTL_OFF))[u] = 0u;
    __syncthreads();
    XcdBarrier bar = xcd_barrier_post((unsigned*)((gu32*)(args.ws + WS_CTL) + CW_BAR) + args.li * XCD_BAR_WORDS, MISC + 8);
    const int lo = args.ph_lo, hi = args.ph_hi;
#define IN(k) (lo <= (k) && (k) < hi)
#define SEAM(k) do { if (IN(k) && IN((k) + 1)) { GRID_BAR(); } } while (0)
#define GRID_BAR() do { XcdBarrier bb_ = bar; GAS unsigned* gb_ = (GAS unsigned*)bar.bar; asm volatile("" : "+s"(gb_), "+s"(bb_.x)); bb_.bar = (unsigned*)gb_; xcd_barrier(bb_); } while (0)
#define PHASE_CTX() int tid_ = threadIdx.x; asm volatile("" : "+v"(tid_)); GAS unsigned char* wsg_ = (GAS unsigned char*)args.ws; asm volatile("" : "+s"(wsg_)); unsigned char* ws = (unsigned char*)wsg_; \
    const int tid = tid_, lane = tid & 63, wave = __builtin_amdgcn_readfirstlane(tid >> 6), gw = (int)blockIdx.x * NWAVES + wave; \
    LAS float* wl = (LAS float*)(lds + wave * 16384); (void)lane; (void)gw; (void)ws; (void)wl; (void)tid
#define INP(k) launder_p(args.in[k])

    if (IN(0)) for (int rep = 0; rep < REPS(0, 0); ++rep) {
        if (rep) GRID_BAR();
        PHASE_CTX();
        const float* x = INP(0); const float* mem = INP(1);
        CONV_RUN(0, gw, NGW, CONV_P0_ITEMS, lane);
        for (int r = gw; r < MT; r += NGW) row_item(x, (bf16_t*)(ws + WS_XB), (float*)(ws + WS_SS0), r, lane);
        for (int r = gw; r < MEMR; r += NGW) row_item(mem, (bf16_t*)(ws + WS_MEMB), (float*)(ws + WS_MEMSS), r, lane);
    }
    SEAM(0);

    for (int l = 0; l < DEPTH; ++l) {
        const int pb = 1 + 5 * l;
        if (IN(pb)) for (int rep = 0; rep < REPS(1, l); ++rep) {
            if (rep) GRID_BAR();
            { PHASE_CTX();
            { pg8::Gemm g{(const bf16_t*)(ws + WS_MEMB), (const bf16_t*)(ws + WS_WMEM) + (size_t)l * 2048 * DM, MEMR, 2048, DM}; pg8::StaticOrder S; S.init(MEMR, 2048, G, (int)((blockIdx.x + G / 2) % G));
              pg8::EpiMem E{(bf16_t*)(ws + WS_MKV) + (size_t)l * MEMR * 2048, (const float*)(ws + WS_MEMSS), (bf16_t*)(ws + WS_MVT) + (size_t)l * MEMR * 1024}; pg8::gemm_phase<pg8::EpiMem, pg8::StaticOrder, true, true>(lds, g, S, E); }
            }
#pragma nounroll
            for (int rg = 0; rg < 2; ++rg) {
                { PHASE_CTX();
                  const int pn0 = rg * 52, ncol = rg == 0 ? 13 * BW : NC - 13 * BW;
                  pg8::Gemm g{(const bf16_t*)(ws + WS_XB), (const bf16_t*)(ws + WS_WIN) + (size_t)l * NC * DM + (size_t)pn0 * 256 * DM, MT, ncol, DM}; pg8::StaticOrder S; S.init(MT, ncol, G, (int)blockIdx.x);
                  pg8::EpiProj E{(bf16_t*)(ws + WS_PROJ), (const float*)(ws + (l == 0 ? WS_SS0 : WS_CTL + CTL_SS1)), ws + WS_G8, (float*)(ws + WS_KMEAN), (float*)(ws + WS_KN), (float*)(ws + WS_STATS), pn0}; pg8::gemm_phase<pg8::EpiProj, pg8::StaticOrder, true, true>(lds, g, S, E); }
                if (rg == 0) { PHASE_CTX();
                    asm volatile("s_waitcnt vmcnt(0)" ::: "memory");
                    __syncthreads();
                    if (threadIdx.x < 64) { __builtin_amdgcn_fence(__ATOMIC_RELEASE, "agent"); asm volatile("s_waitcnt vmcnt(0)" ::: "memory");
                        if (threadIdx.x == 0) (void)__hip_atomic_fetch_add((gu32*)(ws + WS_CTL) + CW_RDY + 64 * l, 1u, RLX_AGENT); }
                }
            }
            if (l + 1 < DEPTH) {
                if ((int)blockIdx.x >= G / 2 + MEMR / 256 * 8 && 3712 % G != 0) {
                    PHASE_CTX();
                    gu32* chead = (gu32*)(ws + WS_CTL) + CW_CONV;
                    for (int k = 0; k < 7; ++k) {
                        if (tid == 0) MISC[17] = __hip_atomic_fetch_add(chead, 1u, RLX_AGENT);
                        __syncthreads(); const int cu = (int)MISC[17]; __syncthreads();
                        if (cu >= CONV_NCH) break;
                        CONV_CHUNK(cu, lane);
                    }
                }
            } else {
                PHASE_CTX();
                gu32* chead = (gu32*)(ws + WS_CTL) + CW_CONV + 64;
                for (;;) {
                    if (tid == 0) MISC[17] = __hip_atomic_fetch_add(chead, 1u, RLX_AGENT);
                    __syncthreads(); const int cu = (int)MISC[17]; __syncthreads();
                    if (cu >= CONV_D0) break;
                    CONV_RUN4(DEPTH - 1, CONV_P0_ITEMS + cu * 32 + wave * 4, lane);
                }
            }
        }
        { PHASE_CTX(); gu32* rdy = (gu32*)(ws + WS_CTL) + CW_RDY + 64 * l;
          if (threadIdx.x == 0) { unsigned* tb_ = (unsigned*)bar.bar; XB_SPIN(xb_ld((unsigned*)rdy) < (unsigned)G, tb_); }
          __syncthreads();
          __builtin_amdgcn_fence(__ATOMIC_ACQUIRE, "agent"); }
        TP_BEGIN((TP_MODE == 1 || TP_MODE == 6) && l == 1);
        if (IN(pb + 2)) for (int rep = 0; rep < REPS(3, l); ++rep) {
            if (rep) GRID_BAR();
            { PHASE_CTX();
            const bf16_t* PROJ = (const bf16_t*)(ws + WS_PROJ); bf16_t* Y = (bf16_t*)(ws + WS_Y);
            const bf16_t* mkv = (const bf16_t*)(ws + WS_MKV) + (size_t)l * MEMR * 2048;
            gu32* qhead = (gu32*)(ws + WS_CTL) + CW_Q + 64 * (l + 2 * rep);
            const float lam_init = l == 0 ? 0.2f : 0.35550907f;
            for (;;) {
                if (tid == 0) MISC[16] = __hip_atomic_fetch_add(qhead, 1u, RLX_AGENT);
                __syncthreads(); const int uq = (int)MISC[16]; __syncthreads();
                int lane_u = lane; asm volatile("" : "+v"(lane_u));
                constexpr int NCONV = CONV_NCH;
                int u = uq; bool xtra = false; (void)xtra;
                if (l + 1 < DEPTH) {
                    if (uq >= 1024 + NCONV) break;
                    int cu = -1;
                    if (uq < 2048) { if (uq & 1) cu = uq >> 1; else u = uq >> 1; } else cu = uq - 1024;
                    if (cu >= 0) {
                        if (tid == 0) MISC[17] = __hip_atomic_fetch_add((gu32*)(ws + WS_CTL) + CW_CONV, 1u, RLX_AGENT);
                        __syncthreads(); const int ch = (int)MISC[17]; __syncthreads();
                        if (ch < NCONV) CONV_CHUNK(ch, lane_u);
                        continue; }
                } else {
#ifndef MQ_PROBE
#define MQ_PROBE 0
#endif
                    constexpr int MQX = MQ_PROBE == 1 ? 256 : (MQ_PROBE == 2 || MQ_PROBE == 5) ? 128 : MQ_PROBE == 3 ? 128 : MQ_PROBE == 4 ? 512 : 0;
                    if (uq >= 1024 + MQX) break;
                    if (uq < MQX) { xtra = true; if (MQ_PROBE == 1) u = (uq / 32) * 48 + 16 + uq % 32; else if (MQ_PROBE == 2 || MQ_PROBE == 5) u = (uq / 16) * 48 + uq % 16; else if (MQ_PROBE == 3) u = 384 + uq; else u = 512 + uq; }
                    else u = uq - MQX;
                }
                if (u < 128) u = (u >> 4) * 48 + (u & 15);
                else if (u < 384) { const int e_ = u - 128; u = (e_ >> 5) * 48 + 16 + (e_ & 31); }
                if (u >= 512) {
                    TP_BEGIN(TP_MODE == 8 && l == 1 && u == 512);
                    sgu::unit(PROJ, (const float*)(ws + WS_STATS), INP(11) + l * BW, INP(12) + l * BW, INP(13) + (size_t)l * 8 * 128 * 128, INP(14) + l * 8 * 128, Y + 2 * BW, u - 512, lds);
                    TP_END(TP_MODE == 8 && l == 1 && u == 512);
                    continue; }
                if (u >= 384) {
                    TP_BEGIN(TP_MODE == 7 && l == 1 && u == 384);
                    memat::unit(PROJ, mkv, (const bf16_t*)(ws + WS_MVT) + (size_t)l * MEMR * 1024, Y + 3 * BW, u - 384, lds);
                    TP_END(TP_MODE == 7 && l == 1 && u == 384);
                    continue; }
                const int L = 7 - u / 48, v = u % 48;
                att::f32x16 o[4]; float rli[16];
                TP_BEGIN((TP_MODE == 2 && l == 1 && u == 3) || (TP_MODE == 4 && l == 1 && u == 16));
                if (v < 16) {
                    const int b = v >> 2, h = v & 3;
                    float* S1 = (float*)(ws + WS_BSCR) + (size_t)blockIdx.x * 65536; float* S2 = S1 + 32768;
#pragma nounroll
                    for (int ps = 0; ps < 4; ++ps) { const int mp = ps & 1, vh = ps >> 1;
                        att::UnitDesc U; U.Q = PROJ + (size_t)(b * SEQ + L * 256) * NC + C_QB + h * 256 + mp * 128; U.K = PROJ + (size_t)(b * SEQ) * NC + C_KB + h * 256 + mp * 128;
                        U.V = PROJ + (size_t)(b * SEQ) * NC + C_VB + h * 256 + vh * 128; U.q0 = L * 256; U.nt = 4 * (L + 1); U.slopeL = exp2f(-8.0f * (float)(h + 1) / 12.0f) * att::LOG2E; U.moba_j = -1; U.kmean = nullptr;
                        U.knorm = (const float*)(ws + WS_KN) + ((b * 4 + h) * 2 + mp) * 128;
                        U.kt0_out = (LAS unsigned*)(MISC + 20 + mp); U.kt0_in = vh == 0 ? -1 : (int)MISC[20 + mp];
                        TP_BEGIN(TP_MODE == 3 && l == 1 && u == 3 && ps == 0);
                        att::run_unit<false>(U, lds, o, rli);
                        TP_END(TP_MODE == 3 && l == 1 && u == 3 && ps == 0);
                        if (MQ_PROBE == 5 && xtra) { S1[(size_t)ps * 512 + threadIdx.x] = o[0][0] + o[1][1] + o[2][2] + o[3][3] + rli[0]; continue; }
                        int lane_p = threadIdx.x & 63; asm volatile("" : "+v"(lane_p)); const int r32 = lane_p & 31, hi = lane_p >> 5;
                        float* sp = S1 + (size_t)(wave * 64 + lane_p) * 64;
                        if (mp == 0) {
#pragma unroll
                            for (int r = 0; r < 16; ++r) *(f32x4*)(sp + r * 4) = (f32x4){o[0][r], o[1][r], o[2][r], o[3][r]} * rli[r];
                        } else {
                            const float* q1 = INP(6) + l * 128; const float* k1 = INP(7) + l * 128; const float* q2 = INP(8) + l * 128; const float* k2 = INP(9) + l * 128;
                            const float s1 = wave_sum(q1[lane_p] * k1[lane_p] + q1[lane_p + 64] * k1[lane_p + 64]), s2 = wave_sum(q2[lane_p] * k2[lane_p] + q2[lane_p + 64] * k2[lane_p + 64]);
                            const float lam = expf(s1) - expf(s2) + lam_init;
                            asm volatile("s_waitcnt vmcnt(0)" ::: "memory");
                            { f32x4 t[16];
#pragma unroll
                              for (int r = 0; r < 16; ++r) t[r] = *(const f32x4*)(sp + r * 4);
                              asm volatile("" ::: "memory");
#pragma unroll
                              for (int r = 0; r < 16; ++r) { const float a_ = lam * rli[r];
#pragma unroll
                                  for (int d0 = 0; d0 < 4; ++d0) o[d0][r] = t[r][d0] - a_ * o[d0][r]; } }
                            float* sq = S2 + (size_t)(wave * 64 + lane_p) * 64;
                            if (vh == 0) {
#pragma unroll
                                for (int r = 0; r < 16; ++r) *(f32x4*)(sq + r * 4) = (f32x4){o[0][r], o[1][r], o[2][r], o[3][r]};
                            } else { const float* subg = INP(10) + l * 256;
                                asm volatile("s_waitcnt vmcnt(0)" ::: "memory");
                                float sg[8];
#pragma unroll
                                for (int i = 0; i < 8; ++i) sg[i] = subg[(i >> 2) * 128 + (i & 3) * 32 + r32];
                                { f32x4 t[16];
#pragma unroll
                                  for (int r = 0; r < 16; ++r) t[r] = *(const f32x4*)(sq + r * 4);
                                  asm volatile("" ::: "memory");
#pragma unroll
                                  for (int r = 0; r < 16; ++r) { float ssq = 0.f;
#pragma unroll
                                      for (int d0 = 0; d0 < 4; ++d0) ssq += t[r][d0] * t[r][d0] + o[d0][r] * o[d0][r];
#pragma unroll
                                      for (int off = 1; off < 32; off <<= 1) ssq += __shfl_xor(ssq, off);
                                      rli[r] = __builtin_amdgcn_rsqf(ssq * (1.0f / 256.0f) + RMS_EPS) * (1.0f - lam_init); } }
#pragma unroll
                                for (int hv = 0; hv < 2; ++hv)
#pragma unroll
                                  for (int rq = 0; rq < 4; ++rq) { unsigned zz[16]; f32x4 t[4];
                                    int wv_ = wave; asm volatile("" : "+s"(wv_));
#pragma unroll
                                    for (int rr = 0; rr < 4; ++rr) { const int r = rq * 4 + rr; const bf16_t* zp = PROJ + (size_t)(b * SEQ + L * 256 + wv_ * 32 + att::crow(r, hi)) * NC + C_ZB + h * 256 + hv * 128 + (r32 & ~1);
#pragma unroll
                                        for (int d0 = 0; d0 < 4; ++d0) zz[rr * 4 + d0] = *(const unsigned*)(zp + d0 * 32);
                                        if (hv == 0) t[rr] = *(const f32x4*)(sq + r * 4); else t[rr] = (f32x4){o[0][r], o[1][r], o[2][r], o[3][r]}; }
                                    asm volatile("" ::: "memory");
#pragma unroll
                                    for (int rr = 0; rr < 4; ++rr) { const int r = rq * 4 + rr; bf16_t* yp = Y + (size_t)(b * SEQ + L * 256 + wv_ * 32 + att::crow(r, hi)) * YS + BW + h * 256 + hv * 128 + r32;
#pragma unroll
                                        for (int d0 = 0; d0 < 4; ++d0) { const float val = t[rr][d0] * rli[r] * sg[hv * 4 + d0], vn = __shfl_xor(val, 1);
                                            if ((r32 & 1) == 0) *(unsigned*)(yp + d0 * 32) = pk2(val * bflo(zz[rr * 4 + d0]), vn * bfhi(zz[rr * 4 + d0])); } } }
                            }
                        }
                    }
                    TP_END(TP_MODE == 2 && l == 1 && u == 3);
                } else {
                    const int bh = v - 16, b = bh >> 3, h = bh & 7;
                    att::UnitDesc U; U.Q = PROJ + (size_t)(b * SEQ + L * 256) * NC + C_QA + h * 128; U.K = PROJ + (size_t)(b * SEQ) * NC + C_KA + h * 128;
                    U.V = PROJ + (size_t)(b * SEQ) * NC + C_VA + h * 128; U.q0 = L * 256; U.nt = 4 * (L + 1); U.slopeL = exp2f(-8.0f * (float)(h + 5) / 12.0f) * att::LOG2E; U.moba_j = L;
                    U.kmean = (const float*)(ws + WS_KMEAN) + (size_t)(b * 8 + h) * 8 * 256; U.knorm = nullptr; U.kt0_out = nullptr; U.kt0_in = -1;
                    att::run_unit<true>(U, lds, o, rli);
                    int lane_p = threadIdx.x & 63; asm volatile("" : "+v"(lane_p)); const int r32 = lane_p & 31, hi = lane_p >> 5;
                    { unsigned zz[64];
#pragma unroll
                      for (int r = 0; r < 16; ++r) { const int bt = b * SEQ + L * 256 + wave * 32 + att::crow(r, hi);
#pragma unroll
                          for (int d0 = 0; d0 < 4; ++d0) zz[r * 4 + d0] = *(const unsigned*)(PROJ + (size_t)bt * NC + C_ZA + h * 128 + d0 * 32 + (r32 & ~1)); }
                      asm volatile("" ::: "memory");
#pragma unroll
                      for (int r = 0; r < 16; ++r) { const int bt = b * SEQ + L * 256 + wave * 32 + att::crow(r, hi);
#pragma unroll
                          for (int d0 = 0; d0 < 4; ++d0) { const float val = o[d0][r] * rli[r], vn = __shfl_xor(val, 1); const int col = h * 128 + d0 * 32 + r32;
                              if ((r32 & 1) == 0) *(unsigned*)(Y + (size_t)bt * YS + col) = pk2(val * bflo(zz[r * 4 + d0]), vn * bfhi(zz[r * 4 + d0])); } } }
                }
                TP_END(TP_MODE == 4 && l == 1 && u == 16);
            }
            }
        }
        TP_END(TP_MODE == 6 && l == 1);
        SEAM(pb + 2);
        TP_END(TP_MODE == 1 && l == 1);
        if (IN(pb + 3)) for (int rep = 0; rep < REPS(4, l); ++rep) {
            if (rep) GRID_BAR();
            PHASE_CTX();
            pg8::Gemm g{(const bf16_t*)(ws + WS_Y), (const bf16_t*)(ws + WS_WBR) + (size_t)l * DM * 4 * BW, MT, DM, 4 * BW}; pg8::StaticOrder S; S.init(MT, DM, G, (int)blockIdx.x);
            pg8::EpiGate2 E{ws + WS_G8, (bf16_t*)(ws + WS_MERGED)}; pg8::gemm_phase<pg8::EpiGate2, pg8::StaticOrder, true, true>(lds, g, S, E);
        }
        SEAM(pb + 3);
        if (IN(pb + 4)) for (int rep = 0; rep < REPS(5, l); ++rep) {
            if (rep) GRID_BAR();
            PHASE_CTX();
            pg8::Gemm g{(const bf16_t*)(ws + WS_MERGED), (const bf16_t*)(ws + WS_WOUT) + (size_t)l * DM * DM, MT, DM, DM}; pg8::StaticOrder S; S.init(MT, DM, G, (int)blockIdx.x);
            { typedef pg8::EpiResid<true, false, true> ER; ER E{nullptr, (const bf16_t*)(ws + WS_XB), nullptr, (bf16_t*)(ws + WS_XB), (float*)(ws + WS_CTL + (l == 0 ? CTL_SS1 : CTL_SS2)), (LAS float*)(lds + MISC_OFF + 1024)}; pg8::gemm_phase<ER, pg8::StaticOrder, true, true>(lds, g, S, E); }
        }
        SEAM(pb + 4);
    }
    if (IN(11)) { PHASE_CTX(); const float* fg = INP(17); float* outp = args.out; final_rows((const bf16_t*)(ws + WS_XB), (const float*)(ws + WS_CTL + CTL_SS2), fg, outp, gw, NGW, lane); }
    if (TP_MODE != 0) { __syncthreads(); if (threadIdx.x == 0) { const unsigned w_ = MISC[24] * (unsigned)TP_K; const unsigned t0_ = (unsigned)__builtin_amdgcn_s_memrealtime();
        while ((unsigned)__builtin_amdgcn_s_memrealtime() - t0_ < w_) __builtin_amdgcn_s_sleep(8); } __syncthreads(); }
#undef IN
#undef SEAM
}

extern "C" void kernel_launch(void* const* d_in, const int* in_sizes, int n_in, void* d_out, int out_size, void* d_ws, size_t ws_size, hipStream_t stream) {
    static int grid = 0;
    if (grid == 0) {
        if (n_in != 18 || in_sizes[0] != MT * DM || out_size != MT * DM || ws_size < WS_END) { fprintf(stderr, "kernel_launch: unexpected shapes (n_in %d in0 %d out %d ws %zu need %zu)\n", n_in, n_in > 0 ? in_sizes[0] : -1, out_size, ws_size, (size_t)WS_END); grid = -1; return; }
        int dev = 0, cus = 0, per_cu = 0;
        if (hipGetDevice(&dev) != hipSuccess || hipDeviceGetAttribute(&cus, hipDeviceAttributeMultiprocessorCount, dev) != hipSuccess) { fprintf(stderr, "kernel_launch: device query failed\n"); grid = -1; return; }
        if (hipFuncSetAttribute((const void*)mega_fwd, hipFuncAttributeMaxDynamicSharedMemorySize, LDS_BYTES) != hipSuccess) { fprintf(stderr, "kernel_launch: hipFuncSetAttribute failed\n"); grid = -1; return; }
        if (hipOccupancyMaxActiveBlocksPerMultiprocessor(&per_cu, (const void*)mega_fwd, NWAVES * 64, LDS_BYTES) != hipSuccess || per_cu < 1) fprintf(stderr, "kernel_launch: occupancy query reports %d workgroups per CU\n", per_cu);
        (void)hipGetLastError();
        grid = cus;
        if (grid != 256) fprintf(stderr, "kernel_launch: %d CUs (built and tuned for 256)\n", grid);
    }
    if (grid < 0) return;
    if (hipMemsetAsync((char*)d_ws + WS_CTL, 0, CTL_ZERO_BYTES, stream) != hipSuccess) { fprintf(stderr, "kernel_launch: memset failed\n"); return; }
    Args a{};
    for (int i = 0; i < 18; ++i) a.in[i] = (const float*)d_in[i];
    a.out = (float*)d_out; a.ws = (unsigned char*)d_ws;
#ifndef MK_SPLIT
    a.ph_lo = 0; a.ph_hi = 12; a.li = 0;
    hipLaunchKernelGGL(mega_fwd, dim3(grid), dim3(NWAVES * 64), LDS_BYTES, stream, a);
#else
    for (int p = 0; p < 12; ++p) { a.ph_lo = p; a.ph_hi = p + 1; a.li = p; hipLaunchKernelGGL(mega_fwd, dim3(grid), dim3(NWAVES * 64), LDS_BYTES, stream, a); }
#endif
    const hipError_t le = hipPeekAtLastError();
    if (le != hipSuccess) fprintf(stderr, "kernel_launch: launch failed: %s\n", hipGetErrorName(le));
}
```

```cpp
#include <hip/hip_runtime.h>
#include <cstdio>
#include <cstdint>

namespace cfg {
constexpr int DM = 4096, NBATCH = 4, SEQ = 2048, MT = NBATCH * SEQ, DEPTH = 2, MEML = 256, MEMR = NBATCH * MEML, BW = 1024;
constexpr int NC = 13 * BW + 4 * DM;
constexpr int C_QA = 0, C_KA = 1024, C_VA = 2048, C_ZA = 3072, C_QB = 4096, C_KB = 5120, C_VB = 6144, C_ZB = 7168, C_UC = 8192, C_VC = 9216, C_ZC = 10240, C_QM = 11264, C_ZM = 12288, C_G = 13312;
constexpr float RMS_EPS = 1e-6f, LN_EPS = 1e-5f;
}
namespace pg8 {
#define PG8_LAS __attribute__((address_space(3)))
typedef unsigned short bf16_t;
typedef short bf16x8 __attribute__((ext_vector_type(8)));
typedef float f32x4 __attribute__((ext_vector_type(4)));
typedef unsigned u32x4 __attribute__((ext_vector_type(4)));
constexpr int BM = 256, BK = 64, HALF = 128, HTB = HALF * BK * 2  , STAGE_BYTES = 8 * HTB, NXCD = 8, WGM = 4;

__host__ __device__ __forceinline__ int lds_byte(int r, int c) { const int st = (r >> 4) * 2 + (c >> 5), rr = r & 15, cc = c & 31, ob = rr * 64 + cc * 2; return st * 1024 + (ob ^ (((ob >> 9) & 1) << 5)); }
__host__ __device__ __forceinline__ void stage_rc(int b, int& R, int& C) { const int st = b / 1024, sb = b % 1024, swz = sb ^ (((sb >> 9) & 1) << 5); R = (st >> 1) * 16 + swz / 64; C = (st & 1) * 32 + (swz % 64) / 2; }
__host__ __device__ __forceinline__ int perm32(int rho) { const int n = rho >> 4, i = rho & 15; return 8 * (i >> 2) + 4 * n + (i & 3); }

struct Unit { int pm, pn; };
struct Gemm { const bf16_t* A; const bf16_t* Bt; int M, N, K; };

struct StaticOrder {
    int nM, nN, nwg, G, c;
    __host__ __device__ void init(int M, int N, int G_, int c_) { nM = M / BM; nN = N / BM; nwg = nM * nN; G = G_; c = c_; }
    __host__ __device__ bool next(int i, Unit& u) const {
        const long L = (long)i * G + c; if (L >= nwg) return false;
        int wgid = (int)L; { const int q = nwg / NXCD, r = nwg % NXCD, xcd = wgid % NXCD, off = wgid / NXCD; wgid = (xcd < r ? xcd * (q + 1) : r * (q + 1) + (xcd - r) * q) + off; }
        const int nig = WGM * nN, gid = wgid / nig, fm = gid * WGM, gsz = (nM - fm) < WGM ? (nM - fm) : WGM;
        u.pm = fm + ((wgid % nig) % gsz); u.pn = (wgid % nig) / gsz; return true;
    }
    __device__ __forceinline__ void a_ready(const Unit&) const {}
    __device__ __forceinline__ void done(const Unit&) const {}
};

typedef float f32x2_t __attribute__((ext_vector_type(2))); typedef __bf16 bf16x2_t __attribute__((ext_vector_type(2)));
__device__ __forceinline__ unsigned cvt_pk_bf16(float lo, float hi) { f32x2_t v = {lo, hi}; bf16x2_t b = __builtin_convertvector(v, bf16x2_t); return __builtin_bit_cast(unsigned, b); }
typedef float f32x2 __attribute__((ext_vector_type(2)));
typedef unsigned u32x2 __attribute__((ext_vector_type(2)));
__device__ __forceinline__ float bf_lo(unsigned w) { return __uint_as_float(w << 16); }
__device__ __forceinline__ float bf_hi(unsigned w) { return __uint_as_float(w & 0xffff0000u); }
__device__ __forceinline__ float sigmoid_f(float x) { return __builtin_amdgcn_rcpf(1.0f + __builtin_amdgcn_exp2f(-1.4426950408889634f * x)); }
template <int ACT> __device__ __forceinline__ float act_f(float v) {
    if (ACT == 1) return v * sigmoid_f(v);
    if (ACT == 2) { const float u2 = 1.5957691216057308f * (v + 0.044715f * v * v * v); return v * sigmoid_f(u2); }
    if (ACT == 3) return sigmoid_f(v);
    return v;
}
struct EpiProj {
    static constexpr bool PERM = true, AFTER_DRAIN = false, HAS_MID = false;
    bf16_t* O; const float* ss;
    unsigned char* g8;
    float* kms; float* kn2; float* st2; int pn0; unsigned* rdy; PG8_LAS unsigned* flag; unsigned tag;
    template <int ACT, int AUX> __device__ __forceinline__ void run(const f32x4 (&acc)[2][2][4][2], const Unit& uu, int wr, int wc, int fr, int fq) const {
        Unit u = uu; u.pn += pn0;
        const int row0 = u.pm * BM + wr * 64 + fr, col0 = u.pn * BM + wc * 32 + 8 * fq;
        float rsv[8];
#pragma unroll
        for (int i = 0; i < 8; ++i) rsv[i] = ss[row0 + (i >> 2) * HALF + (i & 3) * 16];
        asm volatile("" ::: "memory");
#pragma unroll
        for (int i = 0; i < 8; ++i) rsv[i] = __builtin_amdgcn_rsqf(rsv[i] * (1.0f / cfg::DM) + cfg::RMS_EPS);
        float cs[2][8]; float mx[2][2];
        if (AUX == 1) {
#pragma unroll
            for (int i = 0; i < 16; ++i) cs[i >> 3][i & 7] = 0.f; }
        if (AUX == 2) { mx[0][0] = mx[0][1] = mx[1][0] = mx[1][1] = 0.f; }
#pragma unroll
        for (int ai = 0; ai < 2; ++ai)
#pragma unroll
            for (int m = 0; m < 4; ++m) { const int r = row0 + ai * HALF + m * 16; const float rs = rsv[ai * 4 + m];
                bf16_t* rowp = O + (size_t)r * cfg::NC + col0; float s1 = 0.f, s2 = 0.f;
#pragma unroll
                for (int bj = 0; bj < 2; ++bj) { f32x4 v0 = acc[ai][bj][m][0] * rs, v1 = acc[ai][bj][m][1] * rs;
#pragma unroll
                    for (int j = 0; j < 4; ++j) { v0[j] = act_f<ACT>(v0[j]); v1[j] = act_f<ACT>(v1[j]); }
                    if (AUX == 4) {
                        unsigned q[8];
#pragma unroll
                        for (int j = 0; j < 4; ++j) { q[j] = (unsigned)fminf(fmaxf(fmaf(v0[j], 255.0f, 0.5f), 1.0f), 255.0f); q[4 + j] = (unsigned)fminf(fmaxf(fmaf(v1[j], 255.0f, 0.5f), 1.0f), 255.0f); }
                        u32x2 w8; w8.x = q[0] | (q[1] << 8) | (q[2] << 16) | (q[3] << 24); w8.y = q[4] | (q[5] << 8) | (q[6] << 16) | (q[7] << 24);
                        __builtin_nontemporal_store(w8, (u32x2*)(g8 + ((size_t)((u.pn - 52) >> 4) * cfg::MT + r) * cfg::DM + ((u.pn - 52) & 15) * BM + wc * 32 + 8 * fq + bj * HALF));
                    } else {
                    u32x4 w; w.x = cvt_pk_bf16(v0[0], v0[1]); w.y = cvt_pk_bf16(v0[2], v0[3]); w.z = cvt_pk_bf16(v1[0], v1[1]); w.w = cvt_pk_bf16(v1[2], v1[3]);
                    __builtin_nontemporal_store(w, (u32x4*)(rowp + bj * HALF)); }
                    if (AUX == 1) {
#pragma unroll
                        for (int j = 0; j < 4; ++j) { cs[bj][j] += v0[j]; cs[bj][4 + j] += v1[j]; } }
                    if (AUX == 2) { float p = (v0[0] * v0[0] + v0[1] * v0[1]) + (v0[2] * v0[2] + v0[3] * v0[3]) + (v1[0] * v1[0] + v1[1] * v1[1]) + (v1[2] * v1[2] + v1[3] * v1[3]);
                        p += __shfl_xor(p, 16); p += __shfl_xor(p, 32); mx[ai][bj] = fmaxf(mx[ai][bj], p); }
                    if (AUX == 3) { s1 += (v0[0] + v0[1]) + (v0[2] + v0[3]) + (v1[0] + v1[1]) + (v1[2] + v1[3]);
                        s2 += (v0[0] * v0[0] + v0[1] * v0[1]) + (v0[2] * v0[2] + v0[3] * v0[3]) + (v1[0] * v1[0] + v1[1] * v1[1]) + (v1[2] * v1[2] + v1[3] * v1[3]); } }
                if (AUX == 3) { s1 += __shfl_xor(s1, 16); s1 += __shfl_xor(s1, 32); s2 += __shfl_xor(s2, 16); s2 += __shfl_xor(s2, 32);
                    if (fq == 0) *(float2*)(st2 + ((size_t)r * 16 + (u.pn - 36) * 4 + wc) * 2) = make_float2(s1, s2); } }
        if (AUX == 1) {
#pragma unroll
            for (int i = 0; i < 16; ++i) { float x = cs[i >> 3][i & 7]; x += __shfl_xor(x, 1); x += __shfl_xor(x, 2); x += __shfl_xor(x, 4); x += __shfl_xor(x, 8); cs[i >> 3][i & 7] = x; }
            if (fr == 0) {
#pragma unroll
                for (int bj = 0; bj < 2; ++bj) { float* o = kms + ((size_t)(((u.pm >> 3) * 8 + (u.pn - 4) * 2 + bj) * 8 + (u.pm & 7)) * 2 + wr) * 128 + wc * 32 + 8 * fq;
                    *(f32x4*)o = (f32x4){cs[bj][0], cs[bj][1], cs[bj][2], cs[bj][3]}; *(f32x4*)(o + 4) = (f32x4){cs[bj][4], cs[bj][5], cs[bj][6], cs[bj][7]}; } }
        }
        if (AUX == 2) {
#pragma unroll
            for (int i = 0; i < 4; ++i) { float x = mx[i >> 1][i & 1]; x = fmaxf(x, __shfl_xor(x, 1)); x = fmaxf(x, __shfl_xor(x, 2)); x = fmaxf(x, __shfl_xor(x, 4)); x = fmaxf(x, __shfl_xor(x, 8));
                if (fr == 0 && fq == 0) kn2[((size_t)((((u.pm >> 3) * 4 + (u.pn - 20)) * 2 + (i & 1)) * 32 + (u.pm & 7) * 4 + (i >> 1) * 2 + wr)) * 4 + wc] = x; }
        }
    }
    __device__ __forceinline__ void operator()(const f32x4 (&acc)[2][2][4][2], const Unit& u, int wr, int wc, int fr, int fq) const {
        const int seg = (u.pn + pn0) >> 2;
        if (seg >= 13) run<3, 4>(acc, u, wr, wc, fr, fq);
        else if (seg == 3 || seg == 7 || seg == 10 || seg == 12) run<1, 0>(acc, u, wr, wc, fr, fq);
        else if (seg == 8) run<2, 0>(acc, u, wr, wc, fr, fq);
        else if (seg == 9) run<2, 3>(acc, u, wr, wc, fr, fq);
        else if (seg == 1) run<0, 1>(acc, u, wr, wc, fr, fq);
        else if (seg == 5) run<0, 2>(acc, u, wr, wc, fr, fq);
        else run<0, 0>(acc, u, wr, wc, fr, fq);
        if ((u.pn + pn0) >= 52 && *(volatile PG8_LAS unsigned*)flag != tag) {
            asm volatile("s_waitcnt vmcnt(0)" ::: "memory");
            __builtin_amdgcn_s_barrier();
            if (wr == 0 && wc == 0) { __builtin_amdgcn_fence(__ATOMIC_RELEASE, "agent"); asm volatile("s_waitcnt vmcnt(0)" ::: "memory");
                if (fr == 0 && fq == 0) { (void)__hip_atomic_fetch_add(rdy, 1u, __ATOMIC_RELAXED, __HIP_MEMORY_SCOPE_AGENT); *(volatile PG8_LAS unsigned*)flag = tag; } } }
    }
};
struct EpiMem {
    static constexpr bool PERM = true, AFTER_DRAIN = false, HAS_MID = false;
    bf16_t* O; const float* ss; bf16_t* VT;
    __device__ __forceinline__ void operator()(const f32x4 (&acc)[2][2][4][2], const Unit& u, int wr, int wc, int fr, int fq) const {
        const int row0 = u.pm * BM + wr * 64 + fr, col0 = u.pn * BM + wc * 32 + 8 * fq;
        float rsv[8];
#pragma unroll
        for (int i = 0; i < 8; ++i) rsv[i] = ss[row0 + (i >> 2) * HALF + (i & 3) * 16];
        asm volatile("" ::: "memory");
#pragma unroll
        for (int i = 0; i < 8; ++i) rsv[i] = __builtin_amdgcn_rsqf(rsv[i] * (1.0f / cfg::DM) + cfg::RMS_EPS);
        if (u.pn < 4) {
#pragma unroll
            for (int ai = 0; ai < 2; ++ai)
#pragma unroll
                for (int m = 0; m < 4; ++m) { const int r = row0 + ai * HALF + m * 16; const float rs = rsv[ai * 4 + m];
                    bf16_t* rowp = O + (size_t)r * 2048 + col0;
#pragma unroll
                    for (int bj = 0; bj < 2; ++bj) { const f32x4 v0 = acc[ai][bj][m][0] * rs, v1 = acc[ai][bj][m][1] * rs;
                        u32x4 w; w.x = cvt_pk_bf16(v0[0], v0[1]); w.y = cvt_pk_bf16(v0[2], v0[3]); w.z = cvt_pk_bf16(v1[0], v1[1]); w.w = cvt_pk_bf16(v1[2], v1[3]);
                        *(u32x4*)(rowp + bj * HALF) = w; } }
        } else {
            bf16_t* vt = VT + (size_t)((u.pm * 4 + (u.pn - 4)) * 256) * 256;
#pragma unroll
            for (int ai = 0; ai < 2; ++ai)
#pragma unroll
                for (int m = 0; m < 4; ++m) { const int key = wr * 64 + fr + ai * HALF + m * 16; const float rs = rsv[ai * 4 + m];
#pragma unroll
                    for (int bj = 0; bj < 2; ++bj) { const f32x4 v0 = acc[ai][bj][m][0] * rs, v1 = acc[ai][bj][m][1] * rs; const int dv = bj * HALF + wc * 32 + 8 * fq;
                        const unsigned w0 = cvt_pk_bf16(v0[0], v0[1]), w1 = cvt_pk_bf16(v0[2], v0[3]), w2 = cvt_pk_bf16(v1[0], v1[1]), w3 = cvt_pk_bf16(v1[2], v1[3]);
                        bf16_t* p = vt + (size_t)dv * 256 + key;
                        p[0 * 256] = (bf16_t)(w0 & 0xffffu); p[1 * 256] = (bf16_t)(w0 >> 16); p[2 * 256] = (bf16_t)(w1 & 0xffffu); p[3 * 256] = (bf16_t)(w1 >> 16);
                        p[4 * 256] = (bf16_t)(w2 & 0xffffu); p[5 * 256] = (bf16_t)(w2 >> 16); p[6 * 256] = (bf16_t)(w3 & 0xffffu); p[7 * 256] = (bf16_t)(w3 >> 16); } }
        }
    }
};
struct EpiGate2 {
    static constexpr bool PERM = true, AFTER_DRAIN = false, HAS_MID = true; static constexpr int MID_EVERY = 16;
    const unsigned char* g8; bf16_t* merged;
    static __device__ __forceinline__ float ub(unsigned w, int k) { return (float)((w >> (8 * k)) & 0xffu); }
    __device__ __forceinline__ void mid(f32x4 (&acc)[2][2][4][2], const Unit& u, int b, int wr, int wc, int fr, int fq) const {
        const unsigned char* pa = g8 + ((size_t)(b - 1) * cfg::MT + u.pm * BM + wr * 64 + fr) * cfg::DM + u.pn * BM + wc * 32 + 8 * fq; const unsigned char* pb = pa + (size_t)cfg::MT * cfg::DM;
        u32x2 ga[16], gb[16];
#pragma unroll
        for (int i = 0; i < 16; ++i) { const size_t o = (size_t)(((i >> 3) & 1) * HALF + ((i >> 1) & 3) * 16) * cfg::DM + (i & 1) * HALF;
            ga[i] = *(const u32x2*)(pa + o); gb[i] = *(const u32x2*)(pb + o); }
        asm volatile("" ::: "memory");
#pragma unroll
        for (int i = 0; i < 16; ++i) { const int ai = (i >> 3) & 1, m = (i >> 1) & 3, bj = i & 1;
            f32x4 r0, r1;
#pragma unroll
            for (int j = 0; j < 4; ++j) { r0[j] = ub(ga[i].x, j) * __builtin_amdgcn_rcpf(ub(gb[i].x, j)); r1[j] = ub(ga[i].y, j) * __builtin_amdgcn_rcpf(ub(gb[i].y, j)); }
            acc[ai][bj][m][0] *= r0; acc[ai][bj][m][1] *= r1; }
    }
    __device__ __forceinline__ void operator()(const f32x4 (&acc)[2][2][4][2], const Unit& u, int wr, int wc, int fr, int fq) const {
        const int row0 = u.pm * BM + wr * 64 + fr, col0 = u.pn * BM + wc * 32 + 8 * fq;
        const unsigned char* pa = g8 + ((size_t)3 * cfg::MT + row0) * cfg::DM + col0;
        u32x2 ga[16];
#pragma unroll
        for (int i = 0; i < 16; ++i) ga[i] = *(const u32x2*)(pa + (size_t)(((i >> 3) & 1) * HALF + ((i >> 1) & 3) * 16) * cfg::DM + (i & 1) * HALF);
        asm volatile("" ::: "memory");
#pragma unroll
        for (int i = 0; i < 16; ++i) { const int ai = (i >> 3) & 1, m = (i >> 1) & 3, bj = i & 1; const int r = row0 + ai * HALF + m * 16, c = col0 + bj * HALF;
            f32x4 s0, s1;
#pragma unroll
            for (int j = 0; j < 4; ++j) { s0[j] = ub(ga[i].x, j) * (1.0f / 255.0f); s1[j] = ub(ga[i].y, j) * (1.0f / 255.0f); }
            const f32x4 v0 = acc[ai][bj][m][0] * s0, v1 = acc[ai][bj][m][1] * s1;
            u32x4 w; w.x = cvt_pk_bf16(v0[0], v0[1]); w.y = cvt_pk_bf16(v0[2], v0[3]); w.z = cvt_pk_bf16(v1[0], v1[1]); w.w = cvt_pk_bf16(v1[2], v1[3]);
            *(u32x4*)(merged + (size_t)r * cfg::DM + c) = w; }
    }
};
template <bool OLD_BF16, bool W_F32, bool W_BF16> struct EpiResid {
    static constexpr bool PERM = false, AFTER_DRAIN = false, HAS_MID = false;
    const float* xold; const bf16_t* xoldb; float* xnew; bf16_t* xb; float* ssn; PG8_LAS float* red;
    __device__ __forceinline__ void operator()(const f32x4 (&acc)[2][2][4][2], const Unit& u, int wr, int wc, int fr, int fq) const {
        typedef unsigned u32x2 __attribute__((ext_vector_type(2)));
        const int row0 = u.pm * BM + wr * 64 + fr, col0 = u.pn * BM + wc * 32 + 4 * fq;
#pragma unroll
        for (int ai = 0; ai < 2; ++ai) {
            f32x4 xo[16];
#pragma unroll
            for (int i = 0; i < 16; ++i) { const int m = i >> 2, bj = (i >> 1) & 1, n = i & 1; const size_t o = (size_t)(row0 + ai * HALF + m * 16) * cfg::DM + col0 + bj * HALF + n * 16;
                if (OLD_BF16) { const u32x2 ww = *(const u32x2*)(xoldb + o); xo[i] = (f32x4){bf_lo(ww.x), bf_hi(ww.x), bf_lo(ww.y), bf_hi(ww.y)}; } else xo[i] = *(const f32x4*)(xold + o); }
            asm volatile("" ::: "memory");
#pragma unroll
            for (int m = 0; m < 4; ++m) { const int r = row0 + ai * HALF + m * 16; float s = 0.f;
#pragma unroll
                for (int bj = 0; bj < 2; ++bj)
#pragma unroll
                    for (int n = 0; n < 2; ++n) { const size_t o = (size_t)r * cfg::DM + col0 + bj * HALF + n * 16; const f32x4 xn = xo[m * 4 + bj * 2 + n] + acc[ai][bj][m][n];
                        if (W_F32) *(f32x4*)(xnew + o) = xn;
                        if (W_BF16) { u32x2 w; w.x = cvt_pk_bf16(xn[0], xn[1]); w.y = cvt_pk_bf16(xn[2], xn[3]); *(u32x2*)(xb + o) = w; }
                        s += (xn[0] * xn[0] + xn[1] * xn[1]) + (xn[2] * xn[2] + xn[3] * xn[3]); }
                s += __shfl_xor(s, 16); s += __shfl_xor(s, 32);
                if (fq == 0) red[wc * 256 + (r - u.pm * BM)] = s; }
        }
        asm volatile("s_waitcnt lgkmcnt(0)" ::: "memory"); __builtin_amdgcn_s_barrier();
        if (wr == 0) { const int t = (wc * 4 + fq) * 16 + fr; unsafeAtomicAdd(ssn + u.pm * BM + t, (red[t] + red[256 + t]) + (red[512 + t] + red[768 + t])); }
    }
};
template <class Epi, class Sched, bool ALIGN_EPI = false, bool SP2 = false>
__device__ __forceinline__ void gemm_phase(PG8_LAS unsigned char* lds, const Gemm g, const Sched& S, const Epi& E) {
    int tid_l = threadIdx.x; asm volatile("" : "+v"(tid_l));
    const int tid = tid_l, wid = __builtin_amdgcn_readfirstlane(tid >> 6), lane = tid & 63, wr = wid >> 2, wc = wid & 3, fr = lane & 15, fq = lane >> 4;
    const int K = g.K, nt = K / BK;
    unsigned voffA[2], voffB[2];
#pragma unroll
    for (int i = 0; i < 2; ++i) { int R, C; stage_rc(tid * 16 + i * 8192, R, C); const int Rb = Epi::PERM ? ((R & ~31) + perm32(R & 31)) : R;
        voffA[i] = (unsigned)(R * K + C) * 2u; voffB[i] = (unsigned)(Rb * K + C) * 2u; }
    const size_t kstep = (size_t)(BK * 2);
    const size_t hstep = (size_t)HALF * K * 2;
    const size_t tstep = 2 * hstep;
    const unsigned ldsw = (unsigned)wid * 1024u;
    const int aoff = lds_byte(wr * 64 + fr, fq * 8), boff = lds_byte(wc * 32 + fr, fq * 8);
#define PG8_SA(b, h) (((b) * 2 + (h)) * HTB)
#define PG8_SB(b, h) ((4 + (b) * 2 + (h)) * HTB)
#define PG8_STAGE(bufoff, gbase, voff) do { _Pragma("unroll") for (int _i = 0; _i < 2; ++_i) \
        __builtin_amdgcn_global_load_lds((const unsigned*)((const char*)(gbase) + (voff)[_i]), (PG8_LAS unsigned*)(lds + (bufoff) + ldsw + _i * 8192), 16, 0, 0); } while (0)
#define PG8_LDA(dst, b, h) do { _Pragma("unroll") for (int m = 0; m < 4; ++m) _Pragma("unroll") for (int k = 0; k < 2; ++k) dst[m][k] = *(const PG8_LAS bf16x8*)(lds + PG8_SA(b, h) + aoff + m * 2048 + k * 1024); } while (0)
#define PG8_LDB(dst, b, h) do { _Pragma("unroll") for (int n = 0; n < 2; ++n) _Pragma("unroll") for (int k = 0; k < 2; ++k) dst[n][k] = *(const PG8_LAS bf16x8*)(lds + PG8_SB(b, h) + boff + n * 2048 + k * 1024); } while (0)
#define PG8_MMA(ai, bj, At, Bt) do { __builtin_amdgcn_s_setprio(1); _Pragma("unroll") for (int m = 0; m < 4; ++m) _Pragma("unroll") for (int n = 0; n < 2; ++n) _Pragma("unroll") for (int k = 0; k < 2; ++k) \
        acc[ai][bj][m][n] = __builtin_amdgcn_mfma_f32_16x16x32_bf16(Bt[n][k], At[m][k], acc[ai][bj][m][n], 0, 0, 0); __builtin_amdgcn_s_setprio(0); } while (0)
#define PG8_WAIT_V(n) asm volatile("s_waitcnt vmcnt(" #n ")" ::: "memory")
#define PG8_WAIT_L(n) asm volatile("s_waitcnt lgkmcnt(" #n ")" ::: "memory")
#define PG8_BAR __builtin_amdgcn_s_barrier()
#define PG8_SCHED __builtin_amdgcn_sched_barrier(0)
    Unit cur, nxt; int ui = 0;
    if (!S.next(0, cur)) return;
    f32x4 acc[2][2][4][2];
#pragma unroll
    for (int a = 0; a < 2; ++a)
#pragma unroll
        for (int b = 0; b < 2; ++b)
#pragma unroll
            for (int m = 0; m < 4; ++m)
#pragma unroll
                for (int n = 0; n < 2; ++n) acc[a][b][m][n] = (f32x4){0.f, 0.f, 0.f, 0.f};
    bf16x8 At[4][2], B0[2][2], B1[2][2];
    const char* cA = (const char*)g.A + (size_t)cur.pm * tstep; const char* cB = (const char*)g.Bt + (size_t)cur.pn * tstep;
    S.a_ready(cur);
    if constexpr (SP2) {
        PG8_STAGE(PG8_SB(0, 0), cB, voffB); PG8_STAGE(PG8_SB(0, 1), cB + hstep, voffB); PG8_STAGE(PG8_SA(0, 0), cA, voffA); PG8_STAGE(PG8_SA(0, 1), cA + hstep, voffA);
        if (wr == 1) PG8_BAR;
        PG8_WAIT_V(2); PG8_BAR;
        PG8_STAGE(PG8_SB(1, 0), cB + kstep, voffB); PG8_STAGE(PG8_SA(1, 0), cA + kstep, voffA); PG8_STAGE(PG8_SB(1, 1), cB + hstep + kstep, voffB);
        PG8_WAIT_V(6); PG8_BAR;
    } else {
        PG8_STAGE(PG8_SB(0, 0), cB, voffB); PG8_STAGE(PG8_SA(0, 0), cA, voffA); PG8_STAGE(PG8_SB(0, 1), cB + hstep, voffB); PG8_STAGE(PG8_SA(0, 1), cA + hstep, voffA);
        if (wr == 1) PG8_BAR;
        PG8_WAIT_V(4); PG8_BAR;
        PG8_STAGE(PG8_SB(1, 0), cB + kstep, voffB); PG8_STAGE(PG8_SA(1, 0), cA + kstep, voffA); PG8_STAGE(PG8_SB(1, 1), cB + hstep + kstep, voffB);
        PG8_WAIT_V(6); PG8_BAR;
    }
    for (;;) {
        const bool has_next = S.next(ui + 1, nxt);
        const char* nA = has_next ? (const char*)g.A + (size_t)nxt.pm * tstep : cA; const char* nB = has_next ? (const char*)g.Bt + (size_t)nxt.pn * tstep : cB;
        for (int t = 0; t < nt; t += 2) {
            const bool last = (t == nt - 2);
            const char* a1 = cA + (size_t)(t + 1) * kstep;
            const char* a2 = last ? nA : cA + (size_t)(t + 2) * kstep; const char* b2 = last ? nB : cB + (size_t)(t + 2) * kstep;
            const char* a3 = a2 + kstep; const char* b3 = b2 + kstep;
            if (last && has_next) S.a_ready(nxt);
            if constexpr (Epi::HAS_MID) { if (t != 0 && (t & (Epi::MID_EVERY - 1)) == 0) E.mid(acc, cur, t / Epi::MID_EVERY, wr, wc, fr, fq); }
            if constexpr (SP2) {
            PG8_LDB(B0, 0, 0); PG8_LDB(B1, 0, 1); PG8_SCHED; PG8_LDA(At, 0, 0); PG8_STAGE(PG8_SA(1, 1), a1 + hstep, voffA);
            PG8_WAIT_V(8); PG8_WAIT_L(0); PG8_BAR; PG8_MMA(0, 0, At, B0); PG8_MMA(0, 1, At, B1); PG8_BAR; PG8_SCHED;
            PG8_LDA(At, 0, 1); PG8_STAGE(PG8_SB(0, 0), b2, voffB); PG8_STAGE(PG8_SB(0, 1), b2 + hstep, voffB); PG8_STAGE(PG8_SA(0, 0), a2, voffA);
            PG8_WAIT_V(8); PG8_WAIT_L(0); PG8_BAR; PG8_MMA(1, 0, At, B0); PG8_MMA(1, 1, At, B1); PG8_BAR; PG8_SCHED;
            PG8_LDB(B0, 1, 0); PG8_LDB(B1, 1, 1); PG8_SCHED; PG8_LDA(At, 1, 0); PG8_STAGE(PG8_SA(0, 1), a2 + hstep, voffA);
            PG8_WAIT_V(8); PG8_WAIT_L(0); PG8_BAR; PG8_MMA(0, 0, At, B0); PG8_MMA(0, 1, At, B1); PG8_BAR; PG8_SCHED;
            PG8_LDA(At, 1, 1); PG8_STAGE(PG8_SB(1, 0), b3, voffB); PG8_STAGE(PG8_SB(1, 1), b3 + hstep, voffB); PG8_STAGE(PG8_SA(1, 0), a3, voffA);
            PG8_WAIT_V(8); PG8_WAIT_L(0); PG8_BAR; PG8_MMA(1, 0, At, B0); PG8_MMA(1, 1, At, B1); PG8_BAR; PG8_SCHED;
            } else {
            PG8_LDB(B0, 0, 0); PG8_SCHED; PG8_LDA(At, 0, 0); PG8_STAGE(PG8_SA(1, 1), a1 + hstep, voffA);
            PG8_WAIT_L(8); PG8_BAR; PG8_WAIT_L(0); PG8_MMA(0, 0, At, B0); PG8_BAR; PG8_SCHED;
            PG8_LDB(B1, 0, 1); PG8_STAGE(PG8_SB(0, 0), b2, voffB);
            PG8_BAR; PG8_WAIT_L(0); PG8_MMA(0, 1, At, B1); PG8_BAR;
            PG8_LDA(At, 0, 1); PG8_STAGE(PG8_SA(0, 0), a2, voffA);
            PG8_BAR; PG8_WAIT_L(0); PG8_MMA(1, 0, At, B0); PG8_BAR; PG8_SCHED;
            PG8_STAGE(PG8_SB(0, 1), b2 + hstep, voffB);
            PG8_WAIT_V(6); PG8_BAR; PG8_MMA(1, 1, At, B1); PG8_BAR;
            PG8_LDB(B0, 1, 0); PG8_SCHED; PG8_LDA(At, 1, 0); PG8_STAGE(PG8_SA(0, 1), a2 + hstep, voffA);
            PG8_WAIT_L(8); PG8_BAR; PG8_WAIT_L(0); PG8_MMA(0, 0, At, B0); PG8_BAR; PG8_SCHED;
            PG8_LDB(B1, 1, 1); PG8_STAGE(PG8_SB(1, 0), b3, voffB);
            PG8_BAR; PG8_WAIT_L(0); PG8_MMA(0, 1, At, B1); PG8_BAR;
            PG8_LDA(At, 1, 1); PG8_STAGE(PG8_SA(1, 0), a3, voffA);
            PG8_BAR; PG8_WAIT_L(0); PG8_MMA(1, 0, At, B0); PG8_BAR; PG8_SCHED;
            PG8_STAGE(PG8_SB(1, 1), b3 + hstep, voffB);
            PG8_WAIT_V(6); PG8_BAR; PG8_MMA(1, 1, At, B1); PG8_BAR;
            }
        }
        if constexpr (ALIGN_EPI) { if (wr == 0) PG8_BAR; }
        if constexpr (!Epi::AFTER_DRAIN) { E(acc, cur, wr, wc, fr, fq); S.done(cur); }
        if (!has_next) break;
#pragma unroll
        for (int a = 0; a < 2; ++a)
#pragma unroll
            for (int b = 0; b < 2; ++b)
#pragma unroll
                for (int m = 0; m < 4; ++m)
#pragma unroll
                    for (int n = 0; n < 2; ++n) acc[a][b][m][n] = (f32x4){0.f, 0.f, 0.f, 0.f};
        cur = nxt; cA = nA; cB = nB; ++ui;
        if constexpr (ALIGN_EPI) { if (wr == 1) PG8_BAR; }
    }
    PG8_WAIT_V(0);
    if constexpr (!ALIGN_EPI) { if (wr == 0) PG8_BAR; }
    PG8_BAR;
    if constexpr (Epi::AFTER_DRAIN) { E.fused(acc, cur, wr, wc, fr, fq, lds, wid, lane); S.done(cur); }
#undef PG8_SA
#undef PG8_SB
#undef PG8_STAGE
#undef PG8_LDA
#undef PG8_LDB
#undef PG8_MMA
#undef PG8_WAIT_V
#undef PG8_WAIT_L
#undef PG8_BAR
#undef PG8_SCHED
}
}

typedef unsigned short bf16_t;
typedef unsigned u32x4 __attribute__((ext_vector_type(4)));
typedef unsigned u32x2 __attribute__((ext_vector_type(2)));
typedef float f32x4 __attribute__((ext_vector_type(4)));
#define LAS __attribute__((address_space(3)))
#define GAS __attribute__((address_space(1)))
typedef GAS unsigned gu32;
#define RLX_AGENT __ATOMIC_RELAXED, __HIP_MEMORY_SCOPE_AGENT
#define WFENCE() asm volatile("s_waitcnt lgkmcnt(0)" ::: "memory")
using namespace cfg;

__device__ __forceinline__ float bf2f(unsigned short b) { return __uint_as_float(((unsigned)b) << 16); }
__device__ __forceinline__ float bflo(unsigned w) { return __uint_as_float(w << 16); }
__device__ __forceinline__ float bfhi(unsigned w) { return __uint_as_float(w & 0xffff0000u); }
__device__ __forceinline__ unsigned f2bf(float f) { unsigned u = __float_as_uint(f); return (u + 0x7fffu + ((u >> 16) & 1u)) >> 16; }
__device__ __forceinline__ unsigned pk2(float lo, float hi) { return f2bf(lo) | (f2bf(hi) << 16); }
__device__ __forceinline__ float wave_sum(float v) {
#pragma unroll
    for (int o = 1; o < 64; o <<= 1) v += __shfl_xor(v, o);
    return v;
}
__device__ __forceinline__ float wave_max(float v) {
#pragma unroll
    for (int o = 1; o < 64; o <<= 1) v = fmaxf(v, __shfl_xor(v, o));
    return v;
}

constexpr size_t MiB = 1u << 20;
constexpr size_t WS_CTL = 0, CTL_ZERO_BYTES = 1 * MiB;
constexpr int CW_BAR = 4096, CW_Q = 2048, CW_CONV = 3072, CW_RDY = 3328;
constexpr size_t CTL_SS1 = 512 * 1024, CTL_SS2 = 512 * 1024 + 65536;
constexpr size_t SZ_WIN = (size_t)NC * DM * 2, SZ_WMEM = (size_t)2048 * DM * 2, SZ_WBR = (size_t)4 * DM * BW * 2, SZ_WOUT = (size_t)DM * DM * 2;
constexpr size_t WS_WIN = 1 * MiB, WS_WMEM = WS_WIN + 2 * SZ_WIN, WS_WBR = WS_WMEM + 2 * SZ_WMEM, WS_WOUT = WS_WBR + 2 * SZ_WBR;
constexpr size_t WS_XB = WS_WOUT + 2 * SZ_WOUT, WS_X1 = WS_XB + (size_t)MT * DM * 2, WS_X2 = WS_X1 + (size_t)MT * DM * 4, WS_SS0 = WS_X2 + (size_t)MT * DM * 4;
constexpr size_t WS_MEMB = WS_SS0 + 65536, WS_MEMSS = WS_MEMB + (size_t)MEMR * DM * 2, WS_MKV = WS_MEMSS + 65536, WS_PROJ = WS_MKV + 2 * (size_t)MEMR * 2048 * 2;
constexpr size_t WS_KMEAN = WS_PROJ + (size_t)MT * NC * 2, WS_Y = WS_KMEAN + 2 * 256 * 128 * 4, WS_BSCR = WS_Y + (size_t)4 * MT * BW * 2, WS_VN = WS_BSCR + (size_t)MT * 2048 * 4;
constexpr size_t WS_T = WS_VN + (size_t)MT * BW * 4, WS_G8 = WS_T  , WS_MERGED = WS_T + (size_t)MT * DM * 4, WS_MVT = WS_MERGED + (size_t)MT * DM * 2, WS_STATS = WS_MVT + 2 * (size_t)MEMR * 1024 * 2, WS_KN = WS_STATS + (size_t)MT * 16 * 8, WS_END = WS_KN + 4 * 1024 * 4;

constexpr int NWAVES = 8;
constexpr int YS = 4 * BW;
constexpr int RING_BYTES = 131072;
constexpr int LDSCTL_OFF = RING_BYTES, MISC_OFF = LDSCTL_OFF + 320;
constexpr int LDS_BYTES = 147456;
static_assert(MISC_OFF + 128 <= LDS_BYTES, "LDS map");

struct TPItem { const float* W; const float* g; bf16_t* WT; int K, N, idx, nt; };
__device__ __forceinline__ void tp_load(const TPItem& t, f32x4 (&v)[16], float2 (&gv)[8], int lane) {
    const int nblk = t.N / 64, kb = t.idx / nblk, nb = t.idx - kb * nblk, kq = lane >> 4, p = lane & 15;
    const GAS float* src = (const GAS float*)(t.W + (size_t)(64 * kb + 2 * kq) * t.N + 64 * nb + 4 * p); const size_t s1 = (size_t)t.N, s7 = (size_t)7 * t.N;
#pragma unroll
    for (int i = 0; i < 16; ++i) { v[i] = __builtin_nontemporal_load((const GAS f32x4*)src); src += (i & 1) ? s7 : s1; asm volatile("" : "+v"(src)); }
    if (t.g) {
#pragma unroll
        for (int ii = 0; ii < 8; ++ii) gv[ii] = *(const float2*)(t.g + 64 * kb + 2 * kq + 8 * ii);
    } else {
#pragma unroll
        for (int ii = 0; ii < 8; ++ii) gv[ii] = make_float2(1.0f, 1.0f);
    }
    asm volatile("" ::: "memory");
}
__device__ __forceinline__ void tp_store(const TPItem& t, const f32x4 (&v)[16], const float2 (&gv)[8], LAS unsigned char* scr, int lane) {
    const int nblk = t.N / 64, kb = t.idx / nblk, nb = t.idx - kb * nblk, k0 = 64 * kb, n0 = 64 * nb, kq = lane >> 4, p = lane & 15;
#pragma unroll
    for (int ii = 0; ii < 8; ++ii) { const float sa = gv[ii].x, sb = gv[ii].y;
#pragma unroll
        for (int j = 0; j < 4; ++j) { const int n = 4 * p + j;
            *(LAS unsigned*)(scr + n * 128 + (((ii ^ (p & 7)) << 4) | (kq << 2))) = pg8::cvt_pk_bf16(v[2 * ii][j] * sa, v[2 * ii + 1][j] * sb); } }
    WFENCE();
    const int c = lane & 7;
    GAS bf16_t* dst = (GAS bf16_t*)(t.WT + (size_t)(n0 + (lane >> 3)) * t.K + k0 + 8 * c); const size_t dstep = (size_t)8 * t.K;
#pragma unroll
    for (int j = 0; j < 8; ++j) { const int n = (lane >> 3) + 8 * j; const u32x4 o = *(LAS const u32x4*)(scr + n * 128 + ((c ^ ((n >> 2) & 7)) << 4));
        if (t.nt) __builtin_nontemporal_store(o, (GAS u32x4*)dst); else *(GAS u32x4*)dst = o;
        dst += dstep; asm volatile("" : "+v"(dst)); }
    WFENCE();
}
__device__ __forceinline__ void row_item(const float* x, bf16_t* xb, float* ss, int r, int lane) {
    const f32x4* xr = (const f32x4*)(x + (size_t)r * DM) + lane; u32x2* o = (u32x2*)(xb + (size_t)r * DM) + lane; float s = 0.f;
    f32x4 v[16];
#pragma unroll
    for (int j = 0; j < 16; ++j) v[j] = xr[64 * j];
    asm volatile("" ::: "memory");
#pragma unroll
    for (int j = 0; j < 16; ++j) { s += (v[j][0] * v[j][0] + v[j][1] * v[j][1]) + (v[j][2] * v[j][2] + v[j][3] * v[j][3]); u32x2 w; w.x = pk2(v[j][0], v[j][1]); w.y = pk2(v[j][2], v[j][3]); o[64 * j] = w; }
    s = wave_sum(s); if (lane == 0) ss[r] = s;
}

__device__ __forceinline__ float dot8(const u32x4 kk, const LAS float* q) {
    return bflo(kk.x) * q[0] + bfhi(kk.x) * q[1] + bflo(kk.y) * q[2] + bfhi(kk.y) * q[3] + bflo(kk.z) * q[4] + bfhi(kk.z) * q[5] + bflo(kk.w) * q[6] + bfhi(kk.w) * q[7];
}
__device__ __forceinline__ void kmean_task(const bf16_t* proj, float* kmean, int id, int lane) {
    const int n = id & 7, h = (id >> 3) & 7, b = id >> 6, rg = lane >> 4, c8 = lane & 15;
    const bf16_t* p = proj + (size_t)(b * SEQ + n * 256 + rg) * NC + C_KA + h * 128 + c8 * 8; float s[8] = {0.f, 0.f, 0.f, 0.f, 0.f, 0.f, 0.f, 0.f};
#pragma unroll
    for (int q = 0; q < 4; ++q) { u32x4 w[16];
#pragma unroll
        for (int i = 0; i < 16; ++i) w[i] = *(const u32x4*)(p + (size_t)(4 * (q * 16 + i)) * NC);
        asm volatile("" ::: "memory");
#pragma unroll
        for (int i = 0; i < 16; ++i) { s[0] += bflo(w[i].x); s[1] += bfhi(w[i].x); s[2] += bflo(w[i].y); s[3] += bfhi(w[i].y); s[4] += bflo(w[i].z); s[5] += bfhi(w[i].z); s[6] += bflo(w[i].w); s[7] += bfhi(w[i].w); } }
#pragma unroll
    for (int j = 0; j < 8; ++j) { s[j] += __shfl_xor(s[j], 16); s[j] += __shfl_xor(s[j], 32); }
    if (lane < 16) { float* o = kmean + (size_t)id * 128 + c8 * 8; *(f32x4*)o = (f32x4){s[0], s[1], s[2], s[3]} * (1.0f / 256.0f); *(f32x4*)(o + 4) = (f32x4){s[4], s[5], s[6], s[7]} * (1.0f / 256.0f); }
}
__device__ __forceinline__ void knorm_task(const bf16_t* proj, float* kn, int id, int lane) {
    const int tile = id & 31, mp = (id >> 5) & 1, h = (id >> 6) & 3, b = id >> 8;
    const bf16_t* p = proj + (size_t)(b * SEQ + tile * 64 + lane) * NC + C_KB + h * 256 + mp * 128; float s = 0.f;
    { u32x4 w[16];
#pragma unroll
      for (int i = 0; i < 16; ++i) w[i] = *(const u32x4*)(p + 8 * i);
      asm volatile("" ::: "memory");
#pragma unroll
      for (int i = 0; i < 16; ++i) s += (bflo(w[i].x) * bflo(w[i].x) + bfhi(w[i].x) * bfhi(w[i].x)) + (bflo(w[i].y) * bflo(w[i].y) + bfhi(w[i].y) * bfhi(w[i].y)) + (bflo(w[i].z) * bflo(w[i].z) + bfhi(w[i].z) * bfhi(w[i].z)) + (bflo(w[i].w) * bflo(w[i].w) + bfhi(w[i].w) * bfhi(w[i].w)); }
    s = wave_max(s);
    if (lane == 0) kn[id] = sqrtf(s) * 1.0001f;
}
__device__ __forceinline__ void sgu_stats_task(const bf16_t* proj, float* stats, int bt, int lane) {
    const u32x4 a = *(const u32x4*)(proj + (size_t)bt * NC + C_VC + lane * 8), b = *(const u32x4*)(proj + (size_t)bt * NC + C_VC + 512 + lane * 8);
    float v[16] = {bflo(a.x), bfhi(a.x), bflo(a.y), bfhi(a.y), bflo(a.z), bfhi(a.z), bflo(a.w), bfhi(a.w), bflo(b.x), bfhi(b.x), bflo(b.y), bfhi(b.y), bflo(b.z), bfhi(b.z), bflo(b.w), bfhi(b.w)};
    float s = 0.f;
#pragma unroll
    for (int i = 0; i < 16; ++i) s += v[i];
    const float mu = wave_sum(s) * (1.0f / 1024.0f); float q = 0.f;
#pragma unroll
    for (int i = 0; i < 16; ++i) { const float d = v[i] - mu; q += d * d; }
    const float rstd = 1.0f / sqrtf(wave_sum(q) * (1.0f / 1024.0f) + LN_EPS);
    if (lane == 0) { stats[2 * bt] = mu; stats[2 * bt + 1] = rstd; }
}
__device__ __forceinline__ void moba_task(const bf16_t* proj, const float* kmean, bf16_t* Y0, int id, int lane, LAS float* wl) {
    LAS float* qs = wl; LAS float* sc = wl + 128;
    const int h = id & 7, bt = id >> 3, b = bt >> 11, t = bt & 2047, j = t >> 8;
    const unsigned qq = *(const unsigned*)(proj + (size_t)bt * NC + C_QA + h * 128 + 2 * lane);
    const float q0 = bflo(qq), q1 = bfhi(qq);
    qs[2 * lane] = q0; qs[2 * lane + 1] = q1;
    float g[8];
#pragma unroll
    for (int n = 0; n < 8; ++n) { const float* km = kmean + (size_t)((b * 8 + h) * 8 + n) * 128; g[n] = wave_sum(q0 * km[2 * lane] + q1 * km[2 * lane + 1]); }
    unsigned sel = 0;
#pragma unroll
    for (int n = 0; n < 8; ++n) { int rank = 0;
#pragma unroll
        for (int m = 0; m < 8; ++m) if (m != n) rank += (m < j && (g[m] > g[n] || (g[m] == g[n] && m < n))) ? 1 : 0;
        if (n < j && rank < 3) sel |= 1u << n; }
    sel |= 1u << j;
    WFENCE();
    const float scale = 0.08838834764831845f, slope = exp2f(-8.0f * (float)(h + 5) / 12.0f);
    float mx = -INFINITY; int nslots = 0;
    for (int n = 0; n <= j; ++n) { if (!((sel >> n) & 1u)) continue;
        for (int c = 0; c < 4; ++c) { const int key = n * 256 + c * 64 + lane; float s = -INFINITY;
            if (key <= t) { const bf16_t* kr = proj + (size_t)(b * SEQ + key) * NC + C_KA + h * 128; float d = 0.f;
#pragma unroll 4
                for (int i = 0; i < 16; ++i) d += dot8(*(const u32x4*)(kr + 8 * i), qs + 8 * i);
                s = d * scale - slope * (float)(t - key); }
            sc[nslots * 256 + c * 64 + lane] = s; mx = fmaxf(mx, s); }
        ++nslots; }
    mx = wave_max(mx);
    WFENCE();
    float l = 0.f;
    for (int i = lane; i < nslots * 256; i += 64) { const float p = __expf(sc[i] - mx); sc[i] = p; l += p; }
    l = wave_sum(l);
    WFENCE();
    float o0 = 0.f, o1 = 0.f; int slot = 0;
    for (int n = 0; n <= j; ++n) { if (!((sel >> n) & 1u)) continue;
        const int kend = (n == j) ? (t - n * 256) : 255;
        const bf16_t* vr = proj + (size_t)(b * SEQ + n * 256) * NC + C_VA + h * 128 + 2 * lane;
        for (int k = 0; k <= kend; ++k) { const float p = sc[slot * 256 + k]; const unsigned vv = *(const unsigned*)(vr + (size_t)k * NC); o0 += p * bflo(vv); o1 += p * bfhi(vv); }
        ++slot; }
    const float inv = 1.0f / l;
    const unsigned zz = *(const unsigned*)(proj + (size_t)bt * NC + C_ZA + h * 128 + 2 * lane);
    *(unsigned*)(Y0 + (size_t)bt * BW + h * 128 + 2 * lane) = pk2(o0 * inv * bflo(zz), o1 * inv * bfhi(zz));
    WFENCE();
}
__device__ __forceinline__ f32x4 diff_task(const bf16_t* proj, int id, int lane, LAS float* wl) {
    LAS float* qs = wl; LAS float* sc = wl + 128;
    const int mp = id & 1, h = (id >> 1) & 3, bt = id >> 3, b = bt >> 11, t = bt & 2047;
    const unsigned qq = *(const unsigned*)(proj + (size_t)bt * NC + C_QB + h * 256 + mp * 128 + 2 * lane);
    qs[2 * lane] = bflo(qq); qs[2 * lane + 1] = bfhi(qq);
    WFENCE();
    const float scale = 0.08838834764831845f, slope = exp2f(-8.0f * (float)(h + 1) / 12.0f);
    float mx = -INFINITY; const int nch = t / 64 + 1;
    for (int c = 0; c < nch; ++c) { const int key = c * 64 + lane; float s = -INFINITY;
        if (key <= t) { const bf16_t* kr = proj + (size_t)(b * SEQ + key) * NC + C_KB + h * 256 + mp * 128; float d = 0.f;
#pragma unroll 4
            for (int i = 0; i < 16; ++i) d += dot8(*(const u32x4*)(kr + 8 * i), qs + 8 * i);
            s = d * scale - slope * (float)(t - key); }
        sc[key] = s; mx = fmaxf(mx, s); }
    mx = wave_max(mx);
    WFENCE();
    float l = 0.f;
    for (int i = lane; i < nch * 64; i += 64) { const float p = __expf(sc[i] - mx); sc[i] = p; l += p; }
    l = wave_sum(l);
    WFENCE();
    float o0 = 0.f, o1 = 0.f, o2 = 0.f, o3 = 0.f;
    const bf16_t* vr = proj + (size_t)(b * SEQ) * NC + C_VB + h * 256 + 4 * lane;
    for (int k = 0; k <= t; ++k) { const float p = sc[k]; const u32x2 vv = *(const u32x2*)(vr + (size_t)k * NC);
        o0 += p * bflo(vv.x); o1 += p * bfhi(vv.x); o2 += p * bflo(vv.y); o3 += p * bfhi(vv.y); }
    const float inv = 1.0f / l;
    WFENCE();
    return (f32x4){o0 * inv, o1 * inv, o2 * inv, o3 * inv};
}
__device__ __forceinline__ void diff_combine_task(const float* scr, const bf16_t* proj, float lam, float lam_init, const float* subg, bf16_t* Y1, int id, int lane) {
    const int h = id & 3, bt = id >> 2;
    const f32x4 a = *(const f32x4*)(scr + ((size_t)(bt * 4 + h) * 2 + 0) * 256 + 4 * lane), c = *(const f32x4*)(scr + ((size_t)(bt * 4 + h) * 2 + 1) * 256 + 4 * lane);
    const f32x4 o = a - c * lam;
    const float ms = wave_sum((o[0] * o[0] + o[1] * o[1]) + (o[2] * o[2] + o[3] * o[3])) * (1.0f / 256.0f);
    const float rs = (1.0f / sqrtf(ms + RMS_EPS)) * (1.0f - lam_init);
    const f32x4 gg = *(const f32x4*)(subg + 4 * lane);
    const u32x2 zz = *(const u32x2*)(proj + (size_t)bt * NC + C_ZB + h * 256 + 4 * lane);
    u32x2 w; w.x = pk2(o[0] * rs * gg[0] * bflo(zz.x), o[1] * rs * gg[1] * bfhi(zz.x)); w.y = pk2(o[2] * rs * gg[2] * bflo(zz.y), o[3] * rs * gg[3] * bfhi(zz.y));
    *(u32x2*)(Y1 + (size_t)bt * YS + h * 256 + 4 * lane) = w;
}
__device__ __forceinline__ void sgu_ln_task(const bf16_t* proj, const float* lng, const float* lnb, float* VN, int bt, int lane) {
    float v[16]; float s = 0.f;
#pragma unroll
    for (int i = 0; i < 16; ++i) { v[i] = bf2f(proj[(size_t)bt * NC + C_VC + lane + 64 * i]); s += v[i]; }
    const float mu = wave_sum(s) * (1.0f / 1024.0f); float q = 0.f;
#pragma unroll
    for (int i = 0; i < 16; ++i) { v[i] -= mu; q += v[i] * v[i]; }
    const float rstd = 1.0f / sqrtf(wave_sum(q) * (1.0f / 1024.0f) + LN_EPS);
#pragma unroll
    for (int i = 0; i < 16; ++i) { const int c = lane + 64 * i; VN[(size_t)bt * BW + c] = v[i] * rstd * lng[c] + lnb[c]; }
}
__device__ __forceinline__ void sgu_mix_elem(const bf16_t* proj, const float* VN, const float* sw, const float* sb, bf16_t* Y2, int idx) {
    const int c = idx & 1023, bt = idx >> 10, g = c >> 7, t = bt & 2047, tl = t & 127, r0 = bt - tl;
    const float* wrow = sw + ((size_t)g * 128 + tl) * 128; float acc = 0.f;
    for (int s = 0; s <= tl; ++s) acc += wrow[s] * VN[(size_t)(r0 + s) * BW + c];
    acc += sb[g * 128 + tl];
    const float u = bf2f(proj[(size_t)bt * NC + C_UC + c]), z = bf2f(proj[(size_t)bt * NC + C_ZC + c]);
    Y2[(size_t)bt * BW + c] = (bf16_t)f2bf(u * acc * z);
}
__device__ __forceinline__ void memattn_task(const bf16_t* proj, const bf16_t* mkv, bf16_t* Y3, int id, int lane, LAS float* wl) {
    LAS float* qs = wl; LAS float* sc = wl + 256;
    const int h = id & 3, bt = id >> 2, b = bt >> 11;
    const u32x2 qq = *(const u32x2*)(proj + (size_t)bt * NC + C_QM + h * 256 + 4 * lane);
    qs[4 * lane] = bflo(qq.x); qs[4 * lane + 1] = bfhi(qq.x); qs[4 * lane + 2] = bflo(qq.y); qs[4 * lane + 3] = bfhi(qq.y);
    WFENCE();
    float mx = -INFINITY;
    for (int c = 0; c < 4; ++c) { const int key = c * 64 + lane; const bf16_t* kr = mkv + (size_t)(b * MEML + key) * 2048 + h * 256; float d = 0.f;
#pragma unroll 4
        for (int i = 0; i < 32; ++i) d += dot8(*(const u32x4*)(kr + 8 * i), qs + 8 * i);
        const float s = d * 0.0625f; sc[key] = s; mx = fmaxf(mx, s); }
    mx = wave_max(mx);
    WFENCE();
    float l = 0.f;
    for (int i = lane; i < 256; i += 64) { const float p = __expf(sc[i] - mx); sc[i] = p; l += p; }
    l = wave_sum(l);
    WFENCE();
    float o0 = 0.f, o1 = 0.f, o2 = 0.f, o3 = 0.f;
    const bf16_t* vr = mkv + (size_t)(b * MEML) * 2048 + 1024 + h * 256 + 4 * lane;
    for (int k = 0; k < 256; ++k) { const float p = sc[k]; const u32x2 vv = *(const u32x2*)(vr + (size_t)k * 2048);
        o0 += p * bflo(vv.x); o1 += p * bfhi(vv.x); o2 += p * bflo(vv.y); o3 += p * bfhi(vv.y); }
    const float inv = 1.0f / l;
    const u32x2 zz = *(const u32x2*)(proj + (size_t)bt * NC + C_ZM + h * 256 + 4 * lane);
    u32x2 w; w.x = pk2(o0 * inv * bflo(zz.x), o1 * inv * bfhi(zz.x)); w.y = pk2(o2 * inv * bflo(zz.y), o3 * inv * bfhi(zz.y));
    *(u32x2*)(Y3 + (size_t)bt * BW + h * 256 + 4 * lane) = w;
    WFENCE();
}
__device__ __forceinline__ void final_rows(const bf16_t* x, const float* ss, const float* g, float* out, int r0, int step, int lane) {
    f32x4 gv[16]; u32x4 va[8], vb[8];
#pragma unroll
    for (int j = 0; j < 8; ++j) { gv[2 * j] = ((const f32x4*)g)[2 * (64 * j + lane)]; gv[2 * j + 1] = ((const f32x4*)g)[2 * (64 * j + lane) + 1]; }
    float sa = 0.f, sb = 0.f;
    if (r0 < MT) { sa = ss[r0];
#pragma unroll
        for (int j = 0; j < 8; ++j) va[j] = ((const u32x4*)(x + (size_t)r0 * DM))[64 * j + lane]; }
    asm volatile("" ::: "memory");
#define FIN_STORE(V, S, R) do { const float rs = __builtin_amdgcn_rsqf((S) * (1.0f / DM) + RMS_EPS); f32x4* o = (f32x4*)(out + (size_t)(R) * DM); \
        _Pragma("unroll") for (int j = 0; j < 8; ++j) { \
            o[2 * (64 * j + lane)]     = (f32x4){bflo(V[j].x), bfhi(V[j].x), bflo(V[j].y), bfhi(V[j].y)} * rs * gv[2 * j]; \
            o[2 * (64 * j + lane) + 1] = (f32x4){bflo(V[j].z), bfhi(V[j].z), bflo(V[j].w), bfhi(V[j].w)} * rs * gv[2 * j + 1]; } } while (0)
    for (int r = r0; r < MT; r += 2 * step) {
        const int r1 = r + step, r2 = r + 2 * step;
        if (r1 < MT) { sb = ss[r1];
#pragma unroll
            for (int j = 0; j < 8; ++j) vb[j] = ((const u32x4*)(x + (size_t)r1 * DM))[64 * j + lane]; }
        asm volatile("" ::: "memory");
        FIN_STORE(va, sa, r);
        if (r1 >= MT) break;
        if (r2 < MT) { sa = ss[r2];
#pragma unroll
            for (int j = 0; j < 8; ++j) va[j] = ((const u32x4*)(x + (size_t)r2 * DM))[64 * j + lane]; }
        asm volatile("" ::: "memory");
        FIN_STORE(vb, sb, r1);
    }
#undef FIN_STORE
}

namespace att {
typedef short bf16x8 __attribute__((ext_vector_type(8)));
typedef short s16x4 __attribute__((ext_vector_type(4)));
typedef float f32x16 __attribute__((ext_vector_type(16)));
typedef short v4i16_t __attribute__((ext_vector_type(4)));
constexpr int KVBLK = 64, QBLK = 32, SHM_V = KVBLK * 128 * 2, SHM_K = KVBLK * 128 * 2;
constexpr int OFF_K = 2 * SHM_V, OFF_WS = 2 * SHM_V + 2 * SHM_K, OFF_KM = OFF_WS + 8 * 64 * 4, LDS_NEED = OFF_KM + 8 * 128 * 4;
constexpr float LOG2E = 1.4426950408889634f, SCALE = 0.08838834764831845f, CS = SCALE * LOG2E, THRL = 8.0f * LOG2E;
#define ATT_KSWZ(row, colB) ((row) * 256 + ((colB) ^ (((row) & 7) << 4)))
#define ATT_SBAR() __builtin_amdgcn_sched_barrier(0)
__device__ __forceinline__ int crow(int r, int hi) { return (r & 3) + 8 * (r >> 2) + 4 * hi; }
__device__ __forceinline__ unsigned cvtpk(float lo, float hi) { return pg8::cvt_pk_bf16(lo, hi); }
__device__ __forceinline__ int v_st(int k, int c) { const int kk = (k & ~0xC) | ((k & 4) << 1) | ((k & 8) >> 1); return ((kk >> 3) * 4 + (c >> 5)) * 512 + ((kk & 7) * 32 + (c & 31)) * 2; }
__device__ __forceinline__ int v_rd_base(int lane) { return ((lane & 3) << 3) | (((lane >> 2) & 3) << 6) | (((lane >> 4) & 1) << 5) | (((lane >> 5) & 1) << 8); }
constexpr int v_rd_off(int d0, int ks, int half) { return d0 * 512 + ks * 4096 + half * 2048; }
__device__ __forceinline__ s16x4 tr_read(LAS const unsigned char* p) { return __builtin_bit_cast(s16x4, __builtin_amdgcn_ds_read_tr16_b64_v4i16((LAS v4i16_t*)p)); }

__device__ __forceinline__ void qkt(f32x16& p0, f32x16& p1, LAS const unsigned char* Ks, const bf16x8* qr, int r32, int hi) {
    p0 = f32x16{}; p1 = f32x16{};
#pragma unroll
    for (int d0 = 0; d0 < 8; ++d0) { const int cb = (d0 * 16 + hi * 8) * 2;
        const bf16x8 b0 = *(LAS const bf16x8*)(Ks + ATT_KSWZ(r32, cb));
        const bf16x8 b1 = *(LAS const bf16x8*)(Ks + ATT_KSWZ(32 + r32, cb));
        p0 = __builtin_amdgcn_mfma_f32_32x32x16_bf16(b0, qr[d0], p0, 0, 0, 0);
        p1 = __builtin_amdgcn_mfma_f32_32x32x16_bf16(b1, qr[d0], p1, 0, 0, 0); }
}
__device__ __forceinline__ void partialSM(f32x16& p0, f32x16& p1, float& m_reg, float& mn, float& alpha, int dq, float slopeL, bool diag, bool rowmasked) {
    const float NEG = -__builtin_inff(); const float a0 = -slopeL * (float)dq;
#pragma unroll
    for (int r = 0; r < 16; ++r) { const int c = (r & 3) + 8 * (r >> 2);
        p0[r] = fmaf(p0[r], CS, fmaf(slopeL, (float)c, a0)); p1[r] = fmaf(p1[r], CS, fmaf(slopeL, (float)(c + 32), a0)); }
    if (diag) { asm volatile("" ::: "memory");
#pragma unroll
        for (int r = 0; r < 16; ++r) { const int c = (r & 3) + 8 * (r >> 2); if (c > dq) p0[r] = NEG; if (c + 32 > dq) p1[r] = NEG; } }
    if (rowmasked) {
#pragma unroll
        for (int r = 0; r < 16; ++r) { p0[r] = NEG; p1[r] = NEG; } }
    float pmax = p0[0];
#pragma unroll
    for (int r = 1; r < 16; ++r) pmax = fmaxf(pmax, p0[r]);
#pragma unroll
    for (int r = 0; r < 16; ++r) pmax = fmaxf(pmax, p1[r]);
    { auto rr = __builtin_amdgcn_permlane32_swap(__float_as_uint(pmax), __float_as_uint(pmax), false, false);
      pmax = fmaxf(__uint_as_float(rr[0]), __uint_as_float(rr[1])); }
    if (__builtin_expect(__all(pmax - m_reg <= THRL), 1)) { mn = m_reg; alpha = 1.f; }
    else { mn = fmaxf(m_reg, pmax); alpha = __builtin_amdgcn_exp2f(m_reg - mn); m_reg = mn; }
#pragma unroll
    for (int r = 0; r < 16; ++r) { p0[r] = p0[r] - mn; p1[r] = p1[r] - mn; }
#pragma unroll
    for (int r = 0; r < 16; ++r) p0[r] = __builtin_amdgcn_exp2f(p0[r]);
}
__device__ __forceinline__ void finishSM(f32x16& p0, f32x16& p1, float alpha, float& l_reg, bf16x8& pa0, bf16x8& pa1, bf16x8& pa2, bf16x8& pa3) {
#pragma unroll
    for (int r = 0; r < 16; ++r) p1[r] = __builtin_amdgcn_exp2f(p1[r]);
    float ps = 0;
#pragma unroll
    for (int r = 0; r < 16; ++r) ps += p0[r];
#pragma unroll
    for (int r = 0; r < 16; ++r) ps += p1[r];
    { auto rr = __builtin_amdgcn_permlane32_swap(__float_as_uint(ps), __float_as_uint(ps), false, false);
      ps = __uint_as_float(rr[0]) + __uint_as_float(rr[1]); }
    l_reg = l_reg * alpha + ps;
#define ATT_PK4(P, BASE, OUT) do { const unsigned a0_ = cvtpk(P[BASE + 0], P[BASE + 1]), a1_ = cvtpk(P[BASE + 2], P[BASE + 3]);   \
    const unsigned b0_ = cvtpk(P[BASE + 4], P[BASE + 5]), b1_ = cvtpk(P[BASE + 6], P[BASE + 7]);                              \
    auto r0_ = __builtin_amdgcn_permlane32_swap(a0_, b0_, false, false); auto r1_ = __builtin_amdgcn_permlane32_swap(a1_, b1_, false, false); \
    u32x4 w_ = {r0_[0], r1_[0], r0_[1], r1_[1]}; OUT = __builtin_bit_cast(bf16x8, w_); } while (0)
    ATT_PK4(p0, 0, pa0); ATT_PK4(p0, 8, pa1); ATT_PK4(p1, 0, pa2); ATT_PK4(p1, 8, pa3);
#undef ATT_PK4
}
template <int D0> __device__ __forceinline__ void pv_one(f32x16& od, LAS const unsigned char* vb, bf16x8 pa0, bf16x8 pa1, bf16x8 pa2, bf16x8 pa3) {
    const s16x4 l0 = tr_read(vb + v_rd_off(D0, 0, 0)), h0 = tr_read(vb + v_rd_off(D0, 0, 1)), l1 = tr_read(vb + v_rd_off(D0, 1, 0)), h1 = tr_read(vb + v_rd_off(D0, 1, 1));
    const s16x4 l2 = tr_read(vb + v_rd_off(D0, 2, 0)), h2 = tr_read(vb + v_rd_off(D0, 2, 1)), l3 = tr_read(vb + v_rd_off(D0, 3, 0)), h3 = tr_read(vb + v_rd_off(D0, 3, 1));
#define ATT_PK(L, H) (bf16x8){L[0], L[1], L[2], L[3], H[0], H[1], H[2], H[3]}
    od = __builtin_amdgcn_mfma_f32_32x32x16_bf16(pa0, ATT_PK(l0, h0), od, 0, 0, 0);
    od = __builtin_amdgcn_mfma_f32_32x32x16_bf16(pa1, ATT_PK(l1, h1), od, 0, 0, 0);
    od = __builtin_amdgcn_mfma_f32_32x32x16_bf16(pa2, ATT_PK(l2, h2), od, 0, 0, 0);
    od = __builtin_amdgcn_mfma_f32_32x32x16_bf16(pa3, ATT_PK(l3, h3), od, 0, 0, 0);
#undef ATT_PK
}
__device__ __forceinline__ void pv_d0(f32x16* o, LAS const unsigned char* vb, bf16x8 pa0, bf16x8 pa1, bf16x8 pa2, bf16x8 pa3) {
    pv_one<0>(o[0], vb, pa0, pa1, pa2, pa3); pv_one<1>(o[1], vb, pa0, pa1, pa2, pa3); pv_one<2>(o[2], vb, pa0, pa1, pa2, pa3); pv_one<3>(o[3], vb, pa0, pa1, pa2, pa3);
}

__device__ __forceinline__ float knt(const float* kn2, int t) { const f32x4 p = *(const f32x4*)(kn2 + 4 * t); return sqrtf((p[0] + p[1]) + (p[2] + p[3])) * 1.005f; }
struct UnitDesc {
    const bf16_t* Q;
    const bf16_t* K;
    const bf16_t* V;
    int q0;
    int nt;
    float slopeL;
    int moba_j;
    const float* kmean;
    int kt0_in; LAS unsigned* kt0_out;
    const float* knorm;
};
template <bool MOBA>
__device__ __forceinline__ void run_unit(const UnitDesc& U, LAS unsigned char* lds, f32x16 (&o)[4], float (&rli)[16]) {
    int tid_l = threadIdx.x; asm volatile("" : "+v"(tid_l));
    const int tid = tid_l, wid = __builtin_amdgcn_readfirstlane(tid >> 6), lane = tid & 63, r32 = lane & 31, hi = lane >> 5;
    LAS unsigned char* V_lds = lds; LAS unsigned char* K_lds = lds + OFF_K;
    LAS float* wsf = (LAS float*)(lds + OFF_WS) + wid * 64; LAS float* li_l = wsf; LAS float* al_l = wsf + 32;
    float m_reg = -1e30f, l_reg = 0.f; bf16x8 qr[8];
#pragma unroll
    for (int d = 0; d < 4; ++d) o[d] = f32x16{};
    const bf16_t* Qw = U.Q + (size_t)(wid * QBLK + r32) * NC + hi * 8;
#pragma unroll
    for (int d0 = 0; d0 < 8; ++d0) qr[d0] = *(const bf16x8*)(Qw + d0 * 16);
    int qpos = U.q0 + wid * QBLK + r32, qlo = U.q0 + wid * QBLK;
    unsigned sel = 0xffffffffu;
    if (MOBA && U.moba_j > 3) {
        const int j = U.moba_j; LAS float* km = (LAS float*)(lds + OFF_KM);
        for (int i = tid; i < j * 128; i += 512) { const float* kp = U.kmean + (i >> 7) * 256 + (i & 127); km[i] = kp[0] + kp[128]; }
        __syncthreads();
        float g[8];
#pragma unroll
        for (int n = 0; n < 8; ++n) { g[n] = 0.f;
            if (n < j) { float s = 0.f;
#pragma unroll
                for (int d0 = 0; d0 < 8; ++d0) { const LAS float* kp = km + n * 128 + d0 * 16 + hi * 8; const f32x4 k0 = *(LAS const f32x4*)kp, k1 = *(LAS const f32x4*)(kp + 4);
                    const u32x4 qq = __builtin_bit_cast(u32x4, qr[d0]);
                    s += bflo(qq.x) * k0[0] + bfhi(qq.x) * k0[1] + bflo(qq.y) * k0[2] + bfhi(qq.y) * k0[3] + bflo(qq.z) * k1[0] + bfhi(qq.z) * k1[1] + bflo(qq.w) * k1[2] + bfhi(qq.w) * k1[3]; }
                auto rr = __builtin_amdgcn_permlane32_swap(__float_as_uint(s), __float_as_uint(s), false, false);
                g[n] = __uint_as_float(rr[0]) + __uint_as_float(rr[1]); } }
        sel = 0u;
#pragma unroll
        for (int n = 0; n < 8; ++n) { int rank = 0;
#pragma unroll
            for (int m = 0; m < 8; ++m) if (m != n) rank += (m < j && (g[m] > g[n] || (g[m] == g[n] && m < n))) ? 1 : 0;
            if (n < j && rank < 3) sel |= 1u << n; }
        sel |= 1u << j;
        __syncthreads();
    }
    int kt0 = 0;
    if (!MOBA && U.knorm != nullptr && U.kt0_in >= 0) kt0 = U.kt0_in;
    else if (!MOBA && U.knorm != nullptr) {
        LAS float* wm = (LAS float*)(lds + OFF_KM); LAS int* tmin = (LAS int*)(lds + OFF_KM + 64);
        float q2 = 0.f;
#pragma unroll
        for (int d0 = 0; d0 < 8; ++d0) { const u32x4 qq = __builtin_bit_cast(u32x4, qr[d0]);
            q2 += (bflo(qq.x) * bflo(qq.x) + bfhi(qq.x) * bfhi(qq.x)) + (bflo(qq.y) * bflo(qq.y) + bfhi(qq.y) * bfhi(qq.y)) + (bflo(qq.z) * bflo(qq.z) + bfhi(qq.z) * bfhi(qq.z)) + (bflo(qq.w) * bflo(qq.w) + bfhi(qq.w) * bfhi(qq.w)); }
        q2 += __shfl_xor(q2, 32);
#pragma unroll
        for (int off = 1; off < 32; off <<= 1) q2 = fmaxf(q2, __shfl_xor(q2, off));
        if (lane == 0) wm[wid] = q2;
        __syncthreads();
        if (wid == 0) {
            float qm = wm[0];
#pragma unroll
            for (int w = 1; w < 8; ++w) qm = fmaxf(qm, wm[w]);
            const float qc = sqrtf(qm) * (CS * 1.0005f); const int NTd = U.nt - 4;
            const float kown = fmaxf(fmaxf(knt(U.knorm, NTd), knt(U.knorm, NTd + 1)), fmaxf(knt(U.knorm, NTd + 2), knt(U.knorm, NTd + 3)));
            bool ns = false;
            if (lane < NTd) ns = !(U.slopeL * (float)(U.q0 - KVBLK * lane - (KVBLK - 1)) > fmaf(qc, knt(U.knorm, lane) + kown, 35.0f));
            const unsigned long long mk = __ballot(ns);
            if (lane == 0) *tmin = (mk ? (int)__builtin_ctzll(mk) : NTd) & ~1;
        }
        __syncthreads();
        kt0 = *tmin;
        __syncthreads();
        if (tid == 0) *U.kt0_out = (unsigned)kt0;
    }
    const int sr = tid >> 4, sc = (tid & 15) * 8, vst0 = v_st(sr, sc), vst1 = v_st(32 + sr, sc), kst0 = ATT_KSWZ(sr, sc * 2), kst1 = ATT_KSWZ(32 + sr, sc * 2);
    LAS const unsigned char* vb0 = V_lds + v_rd_base(lane);
    const bf16_t* Kh = U.K + (size_t)(sr + kt0 * KVBLK) * NC + sc; const bf16_t* Vh = U.V + (size_t)(sr + kt0 * KVBLK) * NC + sc;
    qpos -= kt0 * KVBLK; qlo -= kt0 * KVBLK;
    bf16x8 sA_v0, sA_v1, sA_k0, sA_k1, sB_v0, sB_v1, sB_k0, sB_k1;
#define ATT_SLOAD(S, k0) do { S##_v0 = *(const bf16x8*)(Vh + (size_t)(k0) * NC); S##_v1 = *(const bf16x8*)(Vh + (size_t)((k0) + 32) * NC); \
    S##_k0 = *(const bf16x8*)(Kh + (size_t)(k0) * NC); S##_k1 = *(const bf16x8*)(Kh + (size_t)((k0) + 32) * NC); } while (0)
#define ATT_SWRITE(b, S) do { *(LAS bf16x8*)(V_lds + (b) * SHM_V + vst0) = S##_v0; *(LAS bf16x8*)(V_lds + (b) * SHM_V + vst1) = S##_v1; \
    *(LAS bf16x8*)(K_lds + (b) * SHM_K + kst0) = S##_k0; *(LAS bf16x8*)(K_lds + (b) * SHM_K + kst1) = S##_k1; } while (0)
#define ATT_SWAIT() asm volatile("s_waitcnt vmcnt(4)" ::: "memory")
#define ATT_RESC(a) do { if (__any((a) < 1.f)) { if (hi == 0) al_l[r32] = (a); asm volatile("s_waitcnt lgkmcnt(0)" ::: "memory"); \
    _Pragma("unroll") for (int d_ = 0; d_ < 4; ++d_) _Pragma("unroll") for (int r = 0; r < 16; ++r) o[d_][r] *= al_l[crow(r, hi)]; } } while (0)
#define ATT_PSM(P0, P1, MN, AL, t) partialSM(P0, P1, m_reg, MN, AL, qpos - (t) * KVBLK - 4 * hi, U.slopeL, (t) * KVBLK + KVBLK - 1 > qlo, MOBA && ((t) >> 2) < U.moba_j && !((sel >> ((t) >> 2)) & 1u))
    f32x16 pA0, pA1, pB0, pB1; float mnA, mnB, alA, alB; bf16x8 pa0, pa1, pa2, pa3; const int NT = U.nt - kt0;
    ATT_SLOAD(sA, 0); ATT_SLOAD(sB, KVBLK); ATT_SWAIT(); ATT_SWRITE(0, sA); __syncthreads();
    qkt(pA0, pA1, K_lds, qr, r32, hi); ATT_PSM(pA0, pA1, mnA, alA, 0);
    ATT_SLOAD(sA, 2 * KVBLK);
    ATT_SWAIT(); ATT_SWRITE(1, sB); __syncthreads();
    for (int j = 1; j + 1 < NT; j += 2) {
        ATT_SBAR(); qkt(pB0, pB1, K_lds + SHM_K, qr, r32, hi);
        finishSM(pA0, pA1, alA, l_reg, pa0, pa1, pa2, pa3); ATT_SBAR();
        ATT_SLOAD(sB, (j + 2) * KVBLK); ATT_SBAR();
        pv_d0(o, vb0, pa0, pa1, pa2, pa3); ATT_PSM(pB0, pB1, mnB, alB, j);
        __syncthreads(); ATT_SWAIT(); ATT_SWRITE(0, sA);
        ATT_RESC(alB); __syncthreads();
        ATT_SBAR(); qkt(pA0, pA1, K_lds, qr, r32, hi);
        finishSM(pB0, pB1, alB, l_reg, pa0, pa1, pa2, pa3); ATT_SBAR();
        if (j + 3 < NT) ATT_SLOAD(sA, (j + 3) * KVBLK);
        ATT_SBAR();
        pv_d0(o, vb0 + SHM_V, pa0, pa1, pa2, pa3); ATT_PSM(pA0, pA1, mnA, alA, j + 1);
        __syncthreads(); ATT_SWAIT(); ATT_SWRITE(1, sB);
        ATT_RESC(alA); __syncthreads();
    }
    ATT_SBAR(); qkt(pB0, pB1, K_lds + SHM_K, qr, r32, hi);
    finishSM(pA0, pA1, alA, l_reg, pa0, pa1, pa2, pa3); ATT_SBAR();
    pv_d0(o, vb0, pa0, pa1, pa2, pa3); ATT_PSM(pB0, pB1, mnB, alB, NT - 1);
    __syncthreads(); ATT_RESC(alB);
    finishSM(pB0, pB1, alB, l_reg, pa0, pa1, pa2, pa3); ATT_SBAR();
    pv_d0(o, vb0 + SHM_V, pa0, pa1, pa2, pa3);
    if (hi == 0) li_l[r32] = l_reg;
    asm volatile("s_waitcnt lgkmcnt(0)" ::: "memory");
#pragma unroll
    for (int r = 0; r < 16; ++r) rli[r] = 1.0f / li_l[crow(r, hi)];
    __syncthreads();
#undef ATT_SLOAD
#undef ATT_SWRITE
#undef ATT_SWAIT
#undef ATT_RESC
#undef ATT_PSM
}
}

namespace sgu {
__device__ __forceinline__ void unit(const bf16_t* proj, const float* stats  , const float* lng, const float* lnb, const float* sw, const float* sb, bf16_t* Y2, int un, LAS unsigned char* lds) {
    int tid_l = threadIdx.x; asm volatile("" : "+v"(tid_l));
    const int tid = tid_l, wid = __builtin_amdgcn_readfirstlane(tid >> 6), lane = tid & 63, r32 = lane & 31, hi = lane >> 5;
    const int g = un & 7, R0 = (un >> 3) * 128;
    const int tb = wid & 3, eh = wid >> 2, t = tb * 32 + r32;
    f32x4 wv[16]; unsigned uu[32], zq[32]; float bias[16];
#pragma unroll
    for (int i = 0; i < 8; ++i) { const int s0 = (i >> 2) * 64 + 16 * (i & 3) + hi * 8; const float* wp = sw + ((size_t)g * 128 + t) * 128 + s0; wv[2 * i] = *(const f32x4*)wp; wv[2 * i + 1] = *(const f32x4*)(wp + 4); }
#pragma unroll
    for (int r = 0; r < 16; ++r) { const int tr = tb * 32 + att::crow(r, hi), bt = R0 + tr; bias[r] = sb[g * 128 + tr];
#pragma unroll
        for (int d = 0; d < 2; ++d) { const int ch = g * 128 + (2 * eh + d) * 32 + (r32 & ~1); uu[r * 2 + d] = *(const unsigned*)(proj + (size_t)bt * NC + C_UC + ch); zq[r * 2 + d] = *(const unsigned*)(proj + (size_t)bt * NC + C_ZC + ch); } }
    { const int sr = tid >> 4, sc = (tid & 15) * 8, ch = g * 128 + sc;
      const f32x4 g0 = *(const f32x4*)(lng + ch), g1 = *(const f32x4*)(lng + ch + 4), b0 = *(const f32x4*)(lnb + ch), b1 = *(const f32x4*)(lnb + ch + 4);
      float mus[4], rss[4];
      { float2 pp[4];
#pragma unroll
        for (int q = 0; q < 4; ++q) pp[q] = *(const float2*)(stats + ((size_t)(R0 + sr + 32 * q) * 16 + (tid & 15)) * 2);
        asm volatile("" ::: "memory");
#pragma unroll
        for (int q = 0; q < 4; ++q) { float s1 = pp[q].x, s2 = pp[q].y;
#pragma unroll
            for (int off = 1; off < 16; off <<= 1) { s1 += __shfl_xor(s1, off); s2 += __shfl_xor(s2, off); }
            mus[q] = s1 * (1.0f / 1024.0f); rss[q] = __builtin_amdgcn_rsqf(fmaxf(s2 * (1.0f / 1024.0f) - mus[q] * mus[q], 0.f) + LN_EPS); } }
#pragma unroll
      for (int q = 0; q < 4; ++q) { const int s = sr + 32 * q, row = R0 + s; const u32x4 vv = *(const u32x4*)(proj + (size_t)row * NC + C_VC + ch);
          const float mu = mus[q], rs = rss[q];
          u32x4 w; w.x = pg8::cvt_pk_bf16((bflo(vv.x) - mu) * rs * g0[0] + b0[0], (bfhi(vv.x) - mu) * rs * g0[1] + b0[1]); w.y = pg8::cvt_pk_bf16((bflo(vv.y) - mu) * rs * g0[2] + b0[2], (bfhi(vv.y) - mu) * rs * g0[3] + b0[3]);
          w.z = pg8::cvt_pk_bf16((bflo(vv.z) - mu) * rs * g1[0] + b1[0], (bfhi(vv.z) - mu) * rs * g1[1] + b1[1]); w.w = pg8::cvt_pk_bf16((bflo(vv.w) - mu) * rs * g1[2] + b1[2], (bfhi(vv.w) - mu) * rs * g1[3] + b1[3]);
          *(LAS u32x4*)(lds + (s >> 6) * att::SHM_V + att::v_st(s & 63, sc)) = w; } }
    __syncthreads();
    att::f32x16 o0 = att::f32x16{}, o1 = att::f32x16{};
    LAS const unsigned char* vb = lds + att::v_rd_base(lane);
#pragma unroll
    for (int st = 0; st < 2; ++st) {
        if (st * 64 > tb * 32 + 31) continue;
        att::bf16x8 pa[4];
#pragma unroll
        for (int k = 0; k < 4; ++k) { const int s0 = st * 64 + 16 * k + hi * 8; const f32x4 w0 = wv[2 * (st * 4 + k)], w1 = wv[2 * (st * 4 + k) + 1];
            float x[8] = {w0[0], w0[1], w0[2], w0[3], w1[0], w1[1], w1[2], w1[3]};
#pragma unroll
            for (int j = 0; j < 8; ++j) x[j] = (s0 + j <= t) ? x[j] : 0.f;
            u32x4 p; p.x = pg8::cvt_pk_bf16(x[0], x[1]); p.y = pg8::cvt_pk_bf16(x[2], x[3]); p.z = pg8::cvt_pk_bf16(x[4], x[5]); p.w = pg8::cvt_pk_bf16(x[6], x[7]); pa[k] = __builtin_bit_cast(att::bf16x8, p); }
        if (eh == 0) { att::pv_one<0>(o0, vb + st * att::SHM_V, pa[0], pa[1], pa[2], pa[3]); att::pv_one<1>(o1, vb + st * att::SHM_V, pa[0], pa[1], pa[2], pa[3]); }
        else         { att::pv_one<2>(o0, vb + st * att::SHM_V, pa[0], pa[1], pa[2], pa[3]); att::pv_one<3>(o1, vb + st * att::SHM_V, pa[0], pa[1], pa[2], pa[3]); }
    }
    {
      asm volatile("" ::: "memory");
#pragma unroll
      for (int r = 0; r < 16; ++r) { const int bt = R0 + tb * 32 + att::crow(r, hi);
#pragma unroll
          for (int d = 0; d < 2; ++d) { const float val = (d == 0 ? o0[r] : o1[r]) + bias[r], vn = __shfl_xor(val, 1); const int ch = g * 128 + (2 * eh + d) * 32 + r32;
              if ((r32 & 1) == 0) *(unsigned*)(Y2 + (size_t)bt * YS + ch) = pk2(val * bflo(uu[r * 2 + d]) * bflo(zq[r * 2 + d]), vn * bfhi(uu[r * 2 + d]) * bfhi(zq[r * 2 + d])); } } }
    __syncthreads();
}
}

namespace memat {
__device__ __forceinline__ void task(const bf16_t* proj, const bf16_t* mk, const bf16_t* mvt, bf16_t* Y3, int tk, int lane) {
    const int rb = tk & 63, h = (tk >> 6) & 3, b = tk >> 8, r32 = lane & 31, hi = lane >> 5, bt0 = b * SEQ + rb * 32;
    att::bf16x8 qr[16];
    const bf16_t* qp = proj + (size_t)(bt0 + r32) * NC + C_QM + h * 256 + hi * 8;
#pragma unroll
    for (int d0 = 0; d0 < 16; ++d0) qr[d0] = *(const att::bf16x8*)(qp + d0 * 16);
    att::f32x16 s[8];
#pragma unroll
    for (int kb = 0; kb < 8; ++kb) { s[kb] = att::f32x16{}; const bf16_t* kp = mk + (size_t)(b * MEML + kb * 32 + r32) * 2048 + h * 256 + hi * 8;
#pragma unroll
        for (int q4 = 0; q4 < 4; ++q4) { att::bf16x8 kf[4];
#pragma unroll
            for (int i = 0; i < 4; ++i) kf[i] = *(const att::bf16x8*)(kp + (q4 * 4 + i) * 16);
            asm volatile("" ::: "memory");
#pragma unroll
            for (int i = 0; i < 4; ++i) s[kb] = __builtin_amdgcn_mfma_f32_32x32x16_bf16(kf[i], qr[q4 * 4 + i], s[kb], 0, 0, 0); } }
    constexpr float C = 0.0625f * att::LOG2E;
    float mx = -__builtin_inff();
#pragma unroll
    for (int kb = 0; kb < 8; ++kb)
#pragma unroll
        for (int r = 0; r < 16; ++r) mx = fmaxf(mx, s[kb][r]);
    { auto rr = __builtin_amdgcn_permlane32_swap(__float_as_uint(mx), __float_as_uint(mx), false, false); mx = fmaxf(__uint_as_float(rr[0]), __uint_as_float(rr[1])); }
    float l = 0.f; const float mc = mx * C;
#pragma unroll
    for (int kb = 0; kb < 8; ++kb)
#pragma unroll
        for (int r = 0; r < 16; ++r) { s[kb][r] = __builtin_amdgcn_exp2f(fmaf(s[kb][r], C, -mc)); l += s[kb][r]; }
    { auto rr = __builtin_amdgcn_permlane32_swap(__float_as_uint(l), __float_as_uint(l), false, false); l = __uint_as_float(rr[0]) + __uint_as_float(rr[1]); }
    const float linv = 1.0f / l;
    att::bf16x8 pa[16];
#define MEM_PK4(P, BASE, OUT) do { const unsigned a0_ = att::cvtpk(P[BASE + 0], P[BASE + 1]), a1_ = att::cvtpk(P[BASE + 2], P[BASE + 3]);   \
    const unsigned b0_ = att::cvtpk(P[BASE + 4], P[BASE + 5]), b1_ = att::cvtpk(P[BASE + 6], P[BASE + 7]);                              \
    auto r0_ = __builtin_amdgcn_permlane32_swap(a0_, b0_, false, false); auto r1_ = __builtin_amdgcn_permlane32_swap(a1_, b1_, false, false); \
    u32x4 w_ = {r0_[0], r1_[0], r0_[1], r1_[1]}; OUT = __builtin_bit_cast(att::bf16x8, w_); } while (0)
#pragma unroll
    for (int kb = 0; kb < 8; ++kb) { MEM_PK4(s[kb], 0, pa[2 * kb]); MEM_PK4(s[kb], 8, pa[2 * kb + 1]); }
#undef MEM_PK4
    float rli[16];
#pragma unroll
    for (int r = 0; r < 16; ++r) rli[r] = __shfl(linv, att::crow(r, hi));
#pragma unroll
    for (int db = 0; db < 8; ++db) { att::f32x16 o = att::f32x16{}; const bf16_t* vp = mvt + ((size_t)((b * 4 + h) * 256 + db * 32 + r32)) * 256 + hi * 8;
        att::bf16x8 vf[16]; unsigned zz[16];
#pragma unroll
        for (int ks = 0; ks < 16; ++ks) vf[ks] = *(const att::bf16x8*)(vp + ks * 16);
#pragma unroll
        for (int r = 0; r < 16; ++r) zz[r] = *(const unsigned*)(proj + (size_t)(bt0 + att::crow(r, hi)) * NC + C_ZM + h * 256 + db * 32 + (r32 & ~1));
        asm volatile("" ::: "memory");
#pragma unroll
        for (int ks = 0; ks < 16; ++ks) o = __builtin_amdgcn_mfma_f32_32x32x16_bf16(pa[ks], vf[ks], o, 0, 0, 0);
#pragma unroll
        for (int r = 0; r < 16; ++r) { const int bt = bt0 + att::crow(r, hi), col = h * 256 + db * 32 + r32; const float val = o[r] * rli[r], vn = __shfl_xor(val, 1);
            if ((r32 & 1) == 0) *(unsigned*)(Y3 + (size_t)bt * YS + col) = pk2(val * bflo(zz[r]), vn * bfhi(zz[r])); } }
}

__device__ __forceinline__ void stage_load(u32x4 (&v)[16], const bf16_t* src, int row_stride, int wave, int lane) {
    const bf16_t* p = src + (size_t)(wave * 2 + (lane >> 5)) * row_stride + (lane & 31) * 8;
#pragma unroll
    for (int i = 0; i < 16; ++i) v[i] = *(const u32x4*)(p + (size_t)(16 * i) * row_stride);
}
__device__ __forceinline__ void stage_store(const u32x4 (&v)[16], LAS unsigned char* lds, int wave, int lane) {
    const int c = lane & 31, r0 = wave * 2 + (lane >> 5);
#pragma unroll
    for (int i = 0; i < 16; ++i) { const int r = r0 + 16 * i; *(LAS u32x4*)(lds + r * 512 + ((c ^ (r & 31)) << 4)) = v[i]; }
}
__device__ __forceinline__ att::bf16x8 frag(LAS const unsigned char* lds, int row, int chunk) { return *(LAS const att::bf16x8*)(lds + row * 512 + ((chunk ^ (row & 31)) << 4)); }
__device__ __forceinline__ void unit(const bf16_t* proj, const bf16_t* mk, const bf16_t* mvt, bf16_t* Y3, int un, LAS unsigned char* lds) {
    int tid_l = threadIdx.x; asm volatile("" : "+v"(tid_l));
    const int tid = tid_l, wave = __builtin_amdgcn_readfirstlane(tid >> 6), lane = tid & 63, r32 = lane & 31, hi = lane >> 5;
    const int tk = un * 8 + wave, rb = tk & 63, h = (tk >> 6) & 3, b = tk >> 8, bt0 = b * SEQ + rb * 32;
    u32x4 st[16]; att::bf16x8 qr[16];
    stage_load(st, mk + (size_t)(b * MEML) * 2048 + h * 256, 2048, wave, lane);
    const bf16_t* qp = proj + (size_t)(bt0 + r32) * NC + C_QM + h * 256 + hi * 8;
#pragma unroll
    for (int d0 = 0; d0 < 16; ++d0) qr[d0] = *(const att::bf16x8*)(qp + d0 * 16);
    asm volatile("" ::: "memory");
    stage_store(st, lds, wave, lane);
    __syncthreads();
    att::f32x16 s[8];
#pragma unroll
    for (int kb = 0; kb < 8; ++kb) { s[kb] = att::f32x16{};
#pragma unroll
        for (int q2 = 0; q2 < 8; ++q2) { att::bf16x8 kf[2]; int rv = r32; asm volatile("" : "+v"(rv));
#pragma unroll
            for (int i = 0; i < 2; ++i) kf[i] = frag(lds, kb * 32 + rv, 2 * (q2 * 2 + i) + hi);
            asm volatile("" ::: "memory");
#pragma unroll
            for (int i = 0; i < 2; ++i) s[kb] = __builtin_amdgcn_mfma_f32_32x32x16_bf16(kf[i], qr[q2 * 2 + i], s[kb], 0, 0, 0); } }
    constexpr float C = 0.0625f * att::LOG2E;
    float mx = -__builtin_inff();
#pragma unroll
    for (int kb = 0; kb < 8; ++kb)
#pragma unroll
        for (int r = 0; r < 16; ++r) mx = fmaxf(mx, s[kb][r]);
    { auto rr = __builtin_amdgcn_permlane32_swap(__float_as_uint(mx), __float_as_uint(mx), false, false); mx = fmaxf(__uint_as_float(rr[0]), __uint_as_float(rr[1])); }
    float l = 0.f; const float mc = mx * C;
#pragma unroll
    for (int kb = 0; kb < 8; ++kb)
#pragma unroll
        for (int r = 0; r < 16; ++r) { s[kb][r] = __builtin_amdgcn_exp2f(fmaf(s[kb][r], C, -mc)); l += s[kb][r]; }
    { auto rr = __builtin_amdgcn_permlane32_swap(__float_as_uint(l), __float_as_uint(l), false, false); l = __uint_as_float(rr[0]) + __uint_as_float(rr[1]); }
    const float linv = 1.0f / l;
    att::bf16x8 pa[16];
#define MEM_PK4(P, BASE, OUT) do { const unsigned a0_ = att::cvtpk(P[BASE + 0], P[BASE + 1]), a1_ = att::cvtpk(P[BASE + 2], P[BASE + 3]);   \
    const unsigned b0_ = att::cvtpk(P[BASE + 4], P[BASE + 5]), b1_ = att::cvtpk(P[BASE + 6], P[BASE + 7]);                              \
    auto r0_ = __builtin_amdgcn_permlane32_swap(a0_, b0_, false, false); auto r1_ = __builtin_amdgcn_permlane32_swap(a1_, b1_, false, false); \
    u32x4 w_ = {r0_[0], r1_[0], r0_[1], r1_[1]}; OUT = __builtin_bit_cast(att::bf16x8, w_); } while (0)
#pragma unroll
    for (int kb = 0; kb < 8; ++kb) { MEM_PK4(s[kb], 0, pa[2 * kb]); MEM_PK4(s[kb], 8, pa[2 * kb + 1]); }
#undef MEM_PK4
#pragma unroll
    for (int i = 0; i < 16; ++i) { u32x4 w_ = __builtin_bit_cast(u32x4, pa[i]); asm volatile("" : "+v"(w_)); pa[i] = __builtin_bit_cast(att::bf16x8, w_); }
    float rli[16];
#pragma unroll
    for (int r = 0; r < 16; ++r) rli[r] = __shfl(linv, att::crow(r, hi));
    stage_load(st, mvt + (size_t)((b * 4 + h) * 256) * 256, 256, wave, lane);
    asm volatile("" ::: "memory");
    __syncthreads();
    stage_store(st, lds, wave, lane);
    __syncthreads();
#pragma unroll
    for (int hf = 0; hf < 4; ++hf) { unsigned zz[32];
#pragma unroll
        for (int dbi = 0; dbi < 2; ++dbi)
#pragma unroll
            for (int r = 0; r < 16; ++r) zz[dbi * 16 + r] = *(const unsigned*)(proj + (size_t)(bt0 + att::crow(r, hi)) * NC + C_ZM + h * 256 + (hf * 2 + dbi) * 32 + (r32 & ~1));
        asm volatile("" ::: "memory");
#pragma unroll
        for (int dbi = 0; dbi < 2; ++dbi) { const int db = hf * 2 + dbi; att::f32x16 o = att::f32x16{};
#pragma unroll
            for (int q4 = 0; q4 < 4; ++q4) { att::bf16x8 vf[4]; int rv = r32; asm volatile("" : "+v"(rv));
#pragma unroll
                for (int i = 0; i < 4; ++i) vf[i] = frag(lds, db * 32 + rv, 2 * (q4 * 4 + i) + hi);
                asm volatile("" ::: "memory");
#pragma unroll
                for (int i = 0; i < 4; ++i) o = __builtin_amdgcn_mfma_f32_32x32x16_bf16(pa[q4 * 4 + i], vf[i], o, 0, 0, 0); }
#pragma unroll
            for (int r = 0; r < 16; ++r) { const int bt = bt0 + att::crow(r, hi), col = h * 256 + db * 32 + r32; const float val = o[r] * rli[r], vn = __shfl_xor(val, 1);
                if ((r32 & 1) == 0) *(unsigned*)(Y3 + (size_t)bt * YS + col) = pk2(val * bflo(zz[dbi * 16 + r]), vn * bfhi(zz[dbi * 16 + r])); } } }
    __syncthreads();
}
}
#define XB_TMO      128
#define XB_XCNT(j)  (256  + 64 * (j))
#define XB_XSUB(j)  (1280 + 64 * (j))
#define XB_XGEN(j)  (2304 + 64 * (j))
#define XB_TOP      3328
#define XB_TOPGEN   3392
#define XCD_BAR_WORDS 3456
#define XB_SPIN_CAP (1u << 18)

__device__ __forceinline__ unsigned xb_ld(unsigned* p)              { return __hip_atomic_load(p, __ATOMIC_RELAXED, __HIP_MEMORY_SCOPE_AGENT); }
__device__ __forceinline__ unsigned xb_add(unsigned* p, unsigned v) { return __hip_atomic_fetch_add(p, v, __ATOMIC_RELAXED, __HIP_MEMORY_SCOPE_AGENT); }
__device__ __forceinline__ unsigned xb_xcc_id() { return (unsigned)__builtin_amdgcn_s_getreg((3 << 11) | 20) & 0xFu; }
#define XB_SPIN(cond, bar) do { unsigned _sp = 0; while (cond) { __builtin_amdgcn_s_sleep(1); \
    if ((++_sp & 255u) == 0u) { if (xb_ld(&(bar)[XB_TMO])) break; if (_sp > XB_SPIN_CAP) { atomicAdd(&(bar)[XB_TMO], 1u); break; } } } } while (0)

struct XcdBarrier {
    unsigned* bar; unsigned x;
    volatile LAS unsigned* st;
};

__device__ __forceinline__ XcdBarrier xcd_barrier_post(unsigned* bar, volatile LAS unsigned* st) {
    XcdBarrier b; b.bar = bar; b.x = xb_xcc_id(); b.st = st;
    if (threadIdx.x == 0) (void)xb_add(&bar[XB_XCNT(b.x)], 1u);
    return b;
}
__device__ __forceinline__ void xcd_barrier_complete(unsigned* bar, unsigned x, unsigned& nloc, unsigned& nx) {
    const unsigned G = gridDim.x * gridDim.y * gridDim.z;
    unsigned sum, cnt, mine, sp = 0u;
    for (;;) {
        sum = 0u; cnt = 0u; mine = 0u;
#pragma unroll
        for (unsigned j = 0; j < 16; ++j) { const unsigned c = xb_ld(&bar[XB_XCNT(j)]); sum += c; cnt += (c > 0u) ? 1u : 0u; mine = (j == x) ? c : mine; }
        if (sum == G) break;
        __builtin_amdgcn_s_sleep(1);
        if ((++sp & 255u) == 0u) { if (xb_ld(&bar[XB_TMO])) break; if (sp > XB_SPIN_CAP) { atomicAdd(&bar[XB_TMO], 1u); break; } }
    }
    nloc = mine > 0u ? mine : 1u; nx = cnt > 0u ? cnt : 1u;
}

__device__ __forceinline__ void xcd_barrier(const XcdBarrier& b) {
    asm volatile("s_waitcnt vmcnt(0)" ::: "memory");
    __syncthreads();
    if (threadIdx.x == 0) {
        unsigned* bar = b.bar;
        __builtin_amdgcn_s_waitcnt(0);
        unsigned nloc = b.st[0], nx = b.st[1];
        if (nloc == 0u) { xcd_barrier_complete(bar, b.x, nloc, nx); b.st[0] = nloc; b.st[1] = nx; }
        const unsigned old = xb_add(&bar[XB_XSUB(b.x)], 1u);
        const unsigned gen = old / nloc;
        if (old + 1u == (gen + 1u) * nloc) {
            __builtin_amdgcn_fence(__ATOMIC_RELEASE, "agent");
            asm volatile("s_waitcnt vmcnt(0)" ::: "memory");
            const unsigned og = xb_add(&bar[XB_TOP], 1u);
            const unsigned tg = og / nx;
            if (og + 1u == (tg + 1u) * nx) xb_add(&bar[XB_TOPGEN], 1u);
            else XB_SPIN(xb_ld(&bar[XB_TOPGEN]) == tg, bar);
            __builtin_amdgcn_fence(__ATOMIC_ACQUIRE, "agent");
            xb_add(&bar[XB_XGEN(b.x)], 1u);
            asm volatile("s_waitcnt vmcnt(0)" ::: "memory");
        } else {
            XB_SPIN(xb_ld(&bar[XB_XGEN(b.x)]) == gen, bar);
            __builtin_amdgcn_fence(__ATOMIC_ACQUIRE, "agent");
            asm volatile("s_waitcnt vmcnt(0)" ::: "memory");
        }
    }
    __syncthreads();
}

__device__ __forceinline__ const float* launder_p(const float* p) { const GAS float* g = (const GAS float*)p; asm volatile("" : "+s"(g)); return (const float*)g; }
#ifndef MK_TWICE
#define MK_TWICE -1
#endif
#define REPS(k, l_) ((MK_TWICE == (k) && (l_) == 0) ? 2 : 1)
#ifndef TP_MODE
#define TP_MODE 0
#endif
#ifndef TP_K
#define TP_K 8
#endif
#define TP_BEGIN(c) do { if (TP_MODE != 0 && (c) && threadIdx.x == 0) MISC[25] = (unsigned)__builtin_amdgcn_s_memrealtime(); } while (0)
#define TP_END(c)   do { if (TP_MODE != 0 && (c) && threadIdx.x == 0) MISC[24] = MISC[24] + ((unsigned)__builtin_amdgcn_s_memrealtime() - MISC[25]); } while (0)
constexpr int CONV_I_IN = (DM / 64) * (NC / 64), CONV_I_MEM = (DM / 64) * (2048 / 64), CONV_I_BR = (4 * BW / 64) * (DM / 64), CONV_I_OUT = (DM / 64) * (DM / 64);
constexpr int CONV_PER_L = CONV_I_IN + CONV_I_MEM + CONV_I_BR + CONV_I_OUT;
#define CONV_DECODE(t_, l_, it_) do { int r_ = (it_); \
    if (r_ < CONV_I_IN) { t_.W = INP(3) + (size_t)(l_) * DM * NC; t_.g = INP(2) + (size_t)(l_) * DM; t_.WT = (bf16_t*)(ws + WS_WIN) + (size_t)(l_) * NC * DM; t_.K = DM; t_.N = NC; } \
    else if ((r_ -= CONV_I_IN) < CONV_I_MEM) { t_.W = INP(5) + (size_t)(l_) * DM * 2048; t_.g = INP(4) + (size_t)(l_) * DM; t_.WT = (bf16_t*)(ws + WS_WMEM) + (size_t)(l_) * 2048 * DM; t_.K = DM; t_.N = 2048; } \
    else if ((r_ -= CONV_I_MEM) < CONV_I_BR) { t_.W = INP(15) + (size_t)(l_) * 4 * BW * DM; t_.g = nullptr; t_.WT = (bf16_t*)(ws + WS_WBR) + (size_t)(l_) * DM * 4 * BW; t_.K = 4 * BW; t_.N = DM; } \
    else { r_ -= CONV_I_BR; t_.W = INP(16) + (size_t)(l_) * DM * DM; t_.g = nullptr; t_.WT = (bf16_t*)(ws + WS_WOUT) + (size_t)(l_) * DM * DM; t_.K = DM; t_.N = DM; } \
    t_.idx = r_; t_.nt = ((l_) > 0 || (it_) >= CONV_P0_ITEMS) ? 1 : 0; } while (0)
#define CONV_RUN(l_, first_, stride_, end_, lane_) do { TPItem ta_, tb_; f32x4 va_[16], vb_[16]; float2 ga_[8], gb_[8]; int it_ = (first_); bool ha_ = it_ < (end_); \
    if (ha_) { CONV_DECODE(ta_, l_, it_); tp_load(ta_, va_, ga_, lane_); } \
    while (ha_) { const int itb_ = it_ + (stride_); const bool hb_ = itb_ < (end_); if (hb_) { CONV_DECODE(tb_, l_, itb_); tp_load(tb_, vb_, gb_, lane_); } \
        tp_store(ta_, va_, ga_, (LAS unsigned char*)wl, lane_); if (!hb_) break; \
        it_ = itb_ + (stride_); ha_ = it_ < (end_); if (ha_) { CONV_DECODE(ta_, l_, it_); tp_load(ta_, va_, ga_, lane_); } \
        tp_store(tb_, vb_, gb_, (LAS unsigned char*)wl, lane_); } } while (0)
static_assert(CONV_PER_L % 32 == 0, "conversion chunks of 32 items");
constexpr int CONV_P0_ITEMS = CONV_I_IN + CONV_I_MEM, CONV_D0 = (CONV_PER_L - CONV_P0_ITEMS) / 32, CONV_NCH = CONV_D0 + CONV_P0_ITEMS / 32;
static_assert(CONV_P0_ITEMS % 32 == 0 && (CONV_PER_L - CONV_P0_ITEMS) % 32 == 0, "chunk alignment");
#define CONV_CHUNK(ch_, lane_) do { if ((ch_) < CONV_D0) CONV_RUN4(0, CONV_P0_ITEMS + (ch_) * 32 + wave * 4, lane_); else CONV_RUN4(DEPTH - 1, ((ch_) - CONV_D0) * 32 + wave * 4, lane_); } while (0)
#define CONV_RUN4(l_, i0_, lane_) do { TPItem t0_, t1_, t2_, t3_; f32x4 va_[16], vb_[16]; float2 ga_[8], gb_[8]; \
    CONV_DECODE(t0_, l_, (i0_)); CONV_DECODE(t1_, l_, (i0_) + 1); tp_load(t0_, va_, ga_, lane_); tp_load(t1_, vb_, gb_, lane_); \
    tp_store(t0_, va_, ga_, (LAS unsigned char*)wl, lane_); CONV_DECODE(t2_, l_, (i0_) + 2); tp_load(t2_, va_, ga_, lane_); \
    tp_store(t1_, vb_, gb_, (LAS unsigned char*)wl, lane_); CONV_DECODE(t3_, l_, (i0_) + 3); tp_load(t3_, vb_, gb_, lane_); \
    tp_store(t2_, va_, ga_, (LAS unsigned char*)wl, lane_); tp_store(t3_, vb_, gb_, (LAS unsigned char*)wl, lane_); } while (0)
struct Args { const float* in[18]; float* out; unsigned char* ws; int ph_lo, ph_hi, li, pad; };
__global__ void __launch_bounds__(NWAVES * 64, 2) mega_fwd(Args args) {
    extern __shared__ __attribute__((aligned(16))) unsigned char lds_raw[];
    LAS unsigned char* lds = (LAS unsigned char*)lds_raw;
    volatile LAS unsigned* MISC = (volatile LAS unsigned*)(lds + MISC_OFF);
    const int G = (int)gridDim.x, NGW = G * NWAVES;
    for (int u = threadIdx.x; u < (LDS_BYTES - LDSCTL_OFF) / 4; u += NWAVES * 64) ((LAS unsigned*)(lds + LDSCTL_OFF))[u] = 0u;
    __syncthreads();
    XcdBarrier bar = xcd_barrier_post((unsigned*)((gu32*)(args.ws + WS_CTL) + CW_BAR) + args.li * XCD_BAR_WORDS, MISC + 8);
    const int lo = args.ph_lo, hi = args.ph_hi;
#define IN(k) (lo <= (k) && (k) < hi)
#define SEAM(k) do { if (IN(k) && IN((k) + 1)) { GRID_BAR(); } } while (0)
#define GRID_BAR() do { XcdBarrier bb_ = bar; GAS unsigned* gb_ = (GAS unsigned*)bar.bar; asm volatile("" : "+s"(gb_), "+s"(bb_.x)); bb_.bar = (unsigned*)gb_; xcd_barrier(bb_); } while (0)
#define PHASE_CTX() int tid_ = threadIdx.x; asm volatile("" : "+v"(tid_)); GAS unsigned char* wsg_ = (GAS unsigned char*)args.ws; asm volatile("" : "+s"(wsg_)); unsigned char* ws = (unsigned char*)wsg_; \
    const int tid = tid_, lane = tid & 63, wave = __builtin_amdgcn_readfirstlane(tid >> 6), gw = (int)blockIdx.x * NWAVES + wave; \
    LAS float* wl = (LAS float*)(lds + wave * 16384); (void)lane; (void)gw; (void)ws; (void)wl; (void)tid
#define INP(k) launder_p(args.in[k])

    if (IN(0)) for (int rep = 0; rep < REPS(0, 0); ++rep) {
        if (rep) GRID_BAR();
        PHASE_CTX();
        const float* x = INP(0); const float* mem = INP(1);
        CONV_RUN(0, gw, NGW, CONV_P0_ITEMS, lane);
        for (int r = gw; r < MT; r += NGW) row_item(x, (bf16_t*)(ws + WS_XB), (float*)(ws + WS_SS0), r, lane);
        for (int r = gw; r < MEMR; r += NGW) row_item(mem, (bf16_t*)(ws + WS_MEMB), (float*)(ws + WS_MEMSS), r, lane);
    }
    SEAM(0);

    for (int l = 0; l < DEPTH; ++l) {
        const int pb = 1 + 5 * l;
        if (IN(pb)) for (int rep = 0; rep < REPS(1, l); ++rep) {
            if (rep) GRID_BAR();
            { PHASE_CTX();
            { pg8::Gemm g{(const bf16_t*)(ws + WS_MEMB), (const bf16_t*)(ws + WS_WMEM) + (size_t)l * 2048 * DM, MEMR, 2048, DM}; pg8::StaticOrder S; S.init(MEMR, 2048, G, (int)((blockIdx.x + G / 2) % G));
              pg8::EpiMem E{(bf16_t*)(ws + WS_MKV) + (size_t)l * MEMR * 2048, (const float*)(ws + WS_MEMSS), (bf16_t*)(ws + WS_MVT) + (size_t)l * MEMR * 1024}; pg8::gemm_phase<pg8::EpiMem, pg8::StaticOrder, true, true>(lds, g, S, E); }
            }
            { PHASE_CTX();
              pg8::Gemm g{(const bf16_t*)(ws + WS_XB), (const bf16_t*)(ws + WS_WIN) + (size_t)l * NC * DM, MT, NC, DM}; pg8::StaticOrder S; S.init(MT, NC, G, (int)blockIdx.x);
              pg8::EpiProj E{(bf16_t*)(ws + WS_PROJ), (const float*)(ws + (l == 0 ? WS_SS0 : WS_CTL + CTL_SS1)), ws + WS_G8, (float*)(ws + WS_KMEAN), (float*)(ws + WS_KN), (float*)(ws + WS_STATS), 0,
                             (unsigned*)((gu32*)(ws + WS_CTL) + CW_RDY + 64 * l), (LAS unsigned*)(MISC + 26), (unsigned)(l + 1)}; pg8::gemm_phase<pg8::EpiProj, pg8::StaticOrder, true, true>(lds, g, S, E); }
            if (l + 1 < DEPTH) {
                if ((int)blockIdx.x >= G / 2 + MEMR / 256 * 8 && 3712 % G != 0) {
                    PHASE_CTX();
                    gu32* chead = (gu32*)(ws + WS_CTL) + CW_CONV;
                    for (int k = 0; k < 7; ++k) {
                        if (tid == 0) MISC[17] = __hip_atomic_fetch_add(chead, 1u, RLX_AGENT);
                        __syncthreads(); const int cu = (int)MISC[17]; __syncthreads();
                        if (cu >= CONV_NCH) break;
                        CONV_CHUNK(cu, lane);
                    }
                }
            } else {
                PHASE_CTX();
                gu32* chead = (gu32*)(ws + WS_CTL) + CW_CONV + 64;
                for (;;) {
                    if (tid == 0) MISC[17] = __hip_atomic_fetch_add(chead, 1u, RLX_AGENT);
                    __syncthreads(); const int cu = (int)MISC[17]; __syncthreads();
                    if (cu >= CONV_D0) break;
                    CONV_RUN4(DEPTH - 1, CONV_P0_ITEMS + cu * 32 + wave * 4, lane);
                }
            }
        }
        { PHASE_CTX(); gu32* rdy = (gu32*)(ws + WS_CTL) + CW_RDY + 64 * l;
          if (threadIdx.x == 0) { unsigned* tb_ = (unsigned*)bar.bar; XB_SPIN(xb_ld((unsigned*)rdy) < (unsigned)G, tb_); }
          __syncthreads();
          __builtin_amdgcn_fence(__ATOMIC_ACQUIRE, "agent"); }
        TP_BEGIN((TP_MODE == 1 || TP_MODE == 6) && l == 1);
        if (IN(pb + 2)) for (int rep = 0; rep < REPS(3, l); ++rep) {
            if (rep) GRID_BAR();
            { PHASE_CTX();
            const bf16_t* PROJ = (const bf16_t*)(ws + WS_PROJ); bf16_t* Y = (bf16_t*)(ws + WS_Y);
            const bf16_t* mkv = (const bf16_t*)(ws + WS_MKV) + (size_t)l * MEMR * 2048;
            gu32* qhead = (gu32*)(ws + WS_CTL) + CW_Q + 64 * (l + 2 * rep);
            const float lam_init = l == 0 ? 0.2f : 0.35550907f;
            for (;;) {
                if (tid == 0) MISC[16] = __hip_atomic_fetch_add(qhead, 1u, RLX_AGENT);
                __syncthreads(); const int uq = (int)MISC[16]; __syncthreads();
                int lane_u = lane; asm volatile("" : "+v"(lane_u));
                constexpr int NCONV = CONV_NCH;
                int u = uq; bool xtra = false; (void)xtra;
                if (l + 1 < DEPTH) {
                    if (uq >= 1024 + NCONV) break;
                    int cu = -1;
                    if (uq < 2048) { if (uq & 1) cu = uq >> 1; else u = uq >> 1; } else cu = uq - 1024;
                    if (cu >= 0) {
                        if (tid == 0) MISC[17] = __hip_atomic_fetch_add((gu32*)(ws + WS_CTL) + CW_CONV, 1u, RLX_AGENT);
                        __syncthreads(); const int ch = (int)MISC[17]; __syncthreads();
                        if (ch < NCONV) CONV_CHUNK(ch, lane_u);
                        continue; }
                } else {
#ifndef MQ_PROBE
#define MQ_PROBE 0
#endif
                    constexpr int MQX = MQ_PROBE == 1 ? 256 : (MQ_PROBE == 2 || MQ_PROBE == 5) ? 128 : MQ_PROBE == 3 ? 128 : MQ_PROBE == 4 ? 512 : 0;
                    if (uq >= 1024 + MQX) break;
                    if (uq < MQX) { xtra = true; if (MQ_PROBE == 1) u = (uq / 32) * 48 + 16 + uq % 32; else if (MQ_PROBE == 2 || MQ_PROBE == 5) u = (uq / 16) * 48 + uq % 16; else if (MQ_PROBE == 3) u = 384 + uq; else u = 512 + uq; }
                    else u = uq - MQX;
                }
                if (u < 128) u = (u >> 4) * 48 + (u & 15);
                else if (u < 384) { const int e_ = u - 128; u = (e_ >> 5) * 48 + 16 + (e_ & 31); }
                if (u >= 512) {
                    TP_BEGIN(TP_MODE == 8 && l == 1 && u == 512);
                    sgu::unit(PROJ, (const float*)(ws + WS_STATS), INP(11) + l * BW, INP(12) + l * BW, INP(13) + (size_t)l * 8 * 128 * 128, INP(14) + l * 8 * 128, Y + 2 * BW, u - 512, lds);
                    TP_END(TP_MODE == 8 && l == 1 && u == 512);
                    continue; }
                if (u >= 384) {
                    TP_BEGIN(TP_MODE == 7 && l == 1 && u == 384);
                    memat::unit(PROJ, mkv, (const bf16_t*)(ws + WS_MVT) + (size_t)l * MEMR * 1024, Y + 3 * BW, u - 384, lds);
                    TP_END(TP_MODE == 7 && l == 1 && u == 384);
                    continue; }
                const int L = 7 - u / 48, v = u % 48;
                att::f32x16 o[4]; float rli[16];
                TP_BEGIN((TP_MODE == 2 && l == 1 && u == 3) || (TP_MODE == 4 && l == 1 && u == 16));
                if (v < 16) {
                    const int b = v >> 2, h = v & 3;
                    float* S1 = (float*)(ws + WS_BSCR) + (size_t)blockIdx.x * 65536; float* S2 = S1 + 32768;
#pragma nounroll
                    for (int ps = 0; ps < 4; ++ps) { const int mp = ps & 1, vh = ps >> 1;
                        att::UnitDesc U; U.Q = PROJ + (size_t)(b * SEQ + L * 256) * NC + C_QB + h * 256 + mp * 128; U.K = PROJ + (size_t)(b * SEQ) * NC + C_KB + h * 256 + mp * 128;
                        U.V = PROJ + (size_t)(b * SEQ) * NC + C_VB + h * 256 + vh * 128; U.q0 = L * 256; U.nt = 4 * (L + 1); U.slopeL = exp2f(-8.0f * (float)(h + 1) / 12.0f) * att::LOG2E; U.moba_j = -1; U.kmean = nullptr;
                        U.knorm = (const float*)(ws + WS_KN) + ((b * 4 + h) * 2 + mp) * 128;
                        U.kt0_out = (LAS unsigned*)(MISC + 20 + mp); U.kt0_in = vh == 0 ? -1 : (int)MISC[20 + mp];
                        TP_BEGIN(TP_MODE == 3 && l == 1 && u == 3 && ps == 0);
                        att::run_unit<false>(U, lds, o, rli);
                        TP_END(TP_MODE == 3 && l == 1 && u == 3 && ps == 0);
                        if (MQ_PROBE == 5 && xtra) { S1[(size_t)ps * 512 + threadIdx.x] = o[0][0] + o[1][1] + o[2][2] + o[3][3] + rli[0]; continue; }
                        int lane_p = threadIdx.x & 63; asm volatile("" : "+v"(lane_p)); const int r32 = lane_p & 31, hi = lane_p >> 5;
                        float* sp = S1 + (size_t)(wave * 64 + lane_p) * 64;
                        if (mp == 0) {
#pragma unroll
                            for (int r = 0; r < 16; ++r) *(f32x4*)(sp + r * 4) = (f32x4){o[0][r], o[1][r], o[2][r], o[3][r]} * rli[r];
                        } else {
                            const float* q1 = INP(6) + l * 128; const float* k1 = INP(7) + l * 128; const float* q2 = INP(8) + l * 128; const float* k2 = INP(9) + l * 128;
                            const float s1 = wave_sum(q1[lane_p] * k1[lane_p] + q1[lane_p + 64] * k1[lane_p + 64]), s2 = wave_sum(q2[lane_p] * k2[lane_p] + q2[lane_p + 64] * k2[lane_p + 64]);
                            const float lam = expf(s1) - expf(s2) + lam_init;
                            asm volatile("s_waitcnt vmcnt(0)" ::: "memory");
                            { f32x4 t[16];
#pragma unroll
                              for (int r = 0; r < 16; ++r) t[r] = *(const f32x4*)(sp + r * 4);
                              asm volatile("" ::: "memory");
#pragma unroll
                              for (int r = 0; r < 16; ++r) { const float a_ = lam * rli[r];
#pragma unroll
                                  for (int d0 = 0; d0 < 4; ++d0) o[d0][r] = t[r][d0] - a_ * o[d0][r]; } }
                            float* sq = S2 + (size_t)(wave * 64 + lane_p) * 64;
                            if (vh == 0) {
#pragma unroll
                                for (int r = 0; r < 16; ++r) *(f32x4*)(sq + r * 4) = (f32x4){o[0][r], o[1][r], o[2][r], o[3][r]};
                            } else { const float* subg = INP(10) + l * 256;
                                asm volatile("s_waitcnt vmcnt(0)" ::: "memory");
                                float sg[8];
#pragma unroll
                                for (int i = 0; i < 8; ++i) sg[i] = subg[(i >> 2) * 128 + (i & 3) * 32 + r32];
                                { f32x4 t[16];
#pragma unroll
                                  for (int r = 0; r < 16; ++r) t[r] = *(const f32x4*)(sq + r * 4);
                                  asm volatile("" ::: "memory");
#pragma unroll
                                  for (int r = 0; r < 16; ++r) { float ssq = 0.f;
#pragma unroll
                                      for (int d0 = 0; d0 < 4; ++d0) ssq += t[r][d0] * t[r][d0] + o[d0][r] * o[d0][r];
#pragma unroll
                                      for (int off = 1; off < 32; off <<= 1) ssq += __shfl_xor(ssq, off);
                                      rli[r] = __builtin_amdgcn_rsqf(ssq * (1.0f / 256.0f) + RMS_EPS) * (1.0f - lam_init); } }
#pragma unroll
                                for (int hv = 0; hv < 2; ++hv)
#pragma unroll
                                  for (int rq = 0; rq < 4; ++rq) { unsigned zz[16]; f32x4 t[4];
                                    int wv_ = wave; asm volatile("" : "+s"(wv_));
#pragma unroll
                                    for (int rr = 0; rr < 4; ++rr) { const int r = rq * 4 + rr; const bf16_t* zp = PROJ + (size_t)(b * SEQ + L * 256 + wv_ * 32 + att::crow(r, hi)) * NC + C_ZB + h * 256 + hv * 128 + (r32 & ~1);
#pragma unroll
                                        for (int d0 = 0; d0 < 4; ++d0) zz[rr * 4 + d0] = *(const unsigned*)(zp + d0 * 32);
                                        if (hv == 0) t[rr] = *(const f32x4*)(sq + r * 4); else t[rr] = (f32x4){o[0][r], o[1][r], o[2][r], o[3][r]}; }
                                    asm volatile("" ::: "memory");
#pragma unroll
                                    for (int rr = 0; rr < 4; ++rr) { const int r = rq * 4 + rr; bf16_t* yp = Y + (size_t)(b * SEQ + L * 256 + wv_ * 32 + att::crow(r, hi)) * YS + BW + h * 256 + hv * 128 + r32;
#pragma unroll
                                        for (int d0 = 0; d0 < 4; ++d0) { const float val = t[rr][d0] * rli[r] * sg[hv * 4 + d0], vn = __shfl_xor(val, 1);
                                            if ((r32 & 1) == 0) *(unsigned*)(yp + d0 * 32) = pk2(val * bflo(zz[rr * 4 + d0]), vn * bfhi(zz[rr * 4 + d0])); } } }
                            }
                        }
                    }
                    TP_END(TP_MODE == 2 && l == 1 && u == 3);
                } else {
                    const int bh = v - 16, b = bh >> 3, h = bh & 7;
                    att::UnitDesc U; U.Q = PROJ + (size_t)(b * SEQ + L * 256) * NC + C_QA + h * 128; U.K = PROJ + (size_t)(b * SEQ) * NC + C_KA + h * 128;
                    U.V = PROJ + (size_t)(b * SEQ) * NC + C_VA + h * 128; U.q0 = L * 256; U.nt = 4 * (L + 1); U.slopeL = exp2f(-8.0f * (float)(h + 5) / 12.0f) * att::LOG2E; U.moba_j = L;
                    U.kmean = (const float*)(ws + WS_KMEAN) + (size_t)(b * 8 + h) * 8 * 256; U.knorm = nullptr; U.kt0_out = nullptr; U.kt0_in = -1;
                    att::run_unit<true>(U, lds, o, rli);
                    int lane_p = threadIdx.x & 63; asm volatile("" : "+v"(lane_p)); const int r32 = lane_p & 31, hi = lane_p >> 5;
                    { unsigned zz[64];
#pragma unroll
                      for (int r = 0; r < 16; ++r) { const int bt = b * SEQ + L * 256 + wave * 32 + att::crow(r, hi);
#pragma unroll
                          for (int d0 = 0; d0 < 4; ++d0) zz[r * 4 + d0] = *(const unsigned*)(PROJ + (size_t)bt * NC + C_ZA + h * 128 + d0 * 32 + (r32 & ~1)); }
                      asm volatile("" ::: "memory");
#pragma unroll
                      for (int r = 0; r < 16; ++r) { const int bt = b * SEQ + L * 256 + wave * 32 + att::crow(r, hi);
#pragma unroll
                          for (int d0 = 0; d0 < 4; ++d0) { const float val = o[d0][r] * rli[r], vn = __shfl_xor(val, 1); const int col = h * 128 + d0 * 32 + r32;
                              if ((r32 & 1) == 0) *(unsigned*)(Y + (size_t)bt * YS + col) = pk2(val * bflo(zz[r * 4 + d0]), vn * bfhi(zz[r * 4 + d0])); } } }
                }
                TP_END(TP_MODE == 4 && l == 1 && u == 16);
            }
            }
        }
        TP_END(TP_MODE == 6 && l == 1);
        SEAM(pb + 2);
        TP_END(TP_MODE == 1 && l == 1);
        if (IN(pb + 3)) for (int rep = 0; rep < REPS(4, l); ++rep) {
            if (rep) GRID_BAR();
            PHASE_CTX();
            pg8::Gemm g{(const bf16_t*)(ws + WS_Y), (const bf16_t*)(ws + WS_WBR) + (size_t)l * DM * 4 * BW, MT, DM, 4 * BW}; pg8::StaticOrder S; S.init(MT, DM, G, (int)blockIdx.x);
            pg8::EpiGate2 E{ws + WS_G8, (bf16_t*)(ws + WS_MERGED)}; pg8::gemm_phase<pg8::EpiGate2, pg8::StaticOrder, true, true>(lds, g, S, E);
        }
        SEAM(pb + 3);
        if (IN(pb + 4)) for (int rep = 0; rep < REPS(5, l); ++rep) {
            if (rep) GRID_BAR();
            PHASE_CTX();
            pg8::Gemm g{(const bf16_t*)(ws + WS_MERGED), (const bf16_t*)(ws + WS_WOUT) + (size_t)l * DM * DM, MT, DM, DM}; pg8::StaticOrder S; S.init(MT, DM, G, (int)blockIdx.x);
            { typedef pg8::EpiResid<true, false, true> ER; ER E{nullptr, (const bf16_t*)(ws + WS_XB), nullptr, (bf16_t*)(ws + WS_XB), (float*)(ws + WS_CTL + (l == 0 ? CTL_SS1 : CTL_SS2)), (LAS float*)(lds + MISC_OFF + 1024)}; pg8::gemm_phase<ER, pg8::StaticOrder, true, true>(lds, g, S, E); }
        }
        SEAM(pb + 4);
    }
    if (IN(11)) { PHASE_CTX(); const float* fg = INP(17); float* outp = args.out; final_rows((const bf16_t*)(ws + WS_XB), (const float*)(ws + WS_CTL + CTL_SS2), fg, outp, gw, NGW, lane); }
    if (TP_MODE != 0) { __syncthreads(); if (threadIdx.x == 0) { const unsigned w_ = MISC[24] * (unsigned)TP_K; const unsigned t0_ = (unsigned)__builtin_amdgcn_s_memrealtime();
        while ((unsigned)__builtin_amdgcn_s_memrealtime() - t0_ < w_) __builtin_amdgcn_s_sleep(8); } __syncthreads(); }
#undef IN
#undef SEAM
}

extern "C" void kernel_launch(void* const* d_in, const int* in_sizes, int n_in, void* d_out, int out_size, void* d_ws, size_t ws_size, hipStream_t stream) {
    static int grid = 0;
    if (grid == 0) {
        if (n_in != 18 || in_sizes[0] != MT * DM || out_size != MT * DM || ws_size < WS_END) { fprintf(stderr, "kernel_launch: unexpected shapes (n_in %d in0 %d out %d ws %zu need %zu)\n", n_in, n_in > 0 ? in_sizes[0] : -1, out_size, ws_size, (size_t)WS_END); grid = -1; return; }
        int dev = 0, cus = 0, per_cu = 0;
        if (hipGetDevice(&dev) != hipSuccess || hipDeviceGetAttribute(&cus, hipDeviceAttributeMultiprocessorCount, dev) != hipSuccess) { fprintf(stderr, "kernel_launch: device query failed\n"); grid = -1; return; }
        if (hipFuncSetAttribute((const void*)mega_fwd, hipFuncAttributeMaxDynamicSharedMemorySize, LDS_BYTES) != hipSuccess) { fprintf(stderr, "kernel_launch: hipFuncSetAttribute failed\n"); grid = -1; return; }
        if (hipOccupancyMaxActiveBlocksPerMultiprocessor(&per_cu, (const void*)mega_fwd, NWAVES * 64, LDS_BYTES) != hipSuccess || per_cu < 1) fprintf(stderr, "kernel_launch: occupancy query reports %d workgroups per CU\n", per_cu);
        (void)hipGetLastError();
        grid = cus;
        if (grid != 256) fprintf(stderr, "kernel_launch: %d CUs (built and tuned for 256)\n", grid);
    }
    if (grid < 0) return;
    if (hipMemsetAsync((char*)d_ws + WS_CTL, 0, CTL_ZERO_BYTES, stream) != hipSuccess) { fprintf(stderr, "kernel_launch: memset failed\n"); return; }
    Args a{};
    for (int i = 0; i < 18; ++i) a.in[i] = (const float*)d_in[i];
    a.out = (float*)d_out; a.ws = (unsigned char*)d_ws;
#ifndef MK_SPLIT
    a.ph_lo = 0; a.ph_hi = 12; a.li = 0;
    hipLaunchKernelGGL(mega_fwd, dim3(grid), dim3(NWAVES * 64), LDS_BYTES, stream, a);
#else
    for (int p = 0; p < 12; ++p) { a.ph_lo = p; a.ph_hi = p + 1; a.li = p; hipLaunchKernelGGL(mega_fwd, dim3(grid), dim3(NWAVES * 64), LDS_BYTES, stream, a); }
#endif
    const hipError_t le = hipPeekAtLastError();
    if (le != hipSuccess) fprintf(stderr, "kernel_launch: launch failed: %s\n", hipGetErrorName(le));
}
```
